# Optimizing an MI355X kernel written in HIP

```python
import functools
import jax, jax.numpy as jnp
from jax import lax
import numpy as np

D_MODEL = 1024
BATCH = 2
SEQ = 8192
DEPTH = 1
DEC_BATCH = 32
DEC_SEQ = 1
PAST_LEN = 8192
PAGE_SIZE = 128

N_META = 16
D_RWKV = D_MODEL // 2
RWKV_HEAD = 64
H_RWKV = D_RWKV // RWKV_HEAD
LORA_DECAY = 64
LORA_A = 64
LORA_GATE = 128
D_FOX = D_MODEL // 2
FOX_HEAD = 64
H_FOX = D_FOX // FOX_HEAD
D_FF = 4 * D_MODEL
Q_BLOCK = 128
D_SHIFT = 3 * D_RWKV + LORA_DECAY + LORA_A + LORA_GATE
D_FOX_IN = 3 * D_FOX + H_FOX
D_GATES = 2 * D_MODEL
D_IN = D_SHIFT + D_FOX_IN + D_GATES
RMS_EPS = 1e-6
GN_EPS = 64e-5

kernel_name = 'rwkv7_fox_gated_hybrid_step'


def rms_norm(x, g):
    xf = x.astype(jnp.float32)
    y = xf * lax.rsqrt(jnp.mean(xf * xf, axis=-1, keepdims=True) + RMS_EPS)
    return (y * g.astype(jnp.float32)).astype(x.dtype)


def wkv_scan(r, decay, k, v, kk, a, state0):
    def step(state, inp):
        r_t, w_t, k_t, v_t, kk_t, a_t = inp
        s_kk = jnp.einsum('bhvk,bhk->bhv', state, kk_t)
        state = (state * w_t[:, :, None, :]
                 - s_kk[..., None] * (kk_t * a_t)[:, :, None, :]
                 + v_t[..., None] * k_t[:, :, None, :])
        return state, jnp.einsum('bhvk,bhk->bhv', state, r_t)
    xs = tuple(jnp.moveaxis(z, 1, 0) for z in (r, decay, k, v, kk, a))
    state, ys = lax.scan(step, state0, xs)
    return jnp.moveaxis(ys, 0, 1), state


def rwkv_time_mix(u_r, shift_prev, wkv0, lw):
    f32 = jnp.float32
    bsz, t = u_r.shape[:2]
    prev = jnp.concatenate([shift_prev[:, None, :].astype(u_r.dtype), u_r[:, :-1]], axis=1)
    us = u_r + lw['mu_shift'] * (prev - u_r)
    cuts = [D_RWKV, 2 * D_RWKV, 3 * D_RWKV, 3 * D_RWKV + LORA_DECAY, 3 * D_RWKV + LORA_DECAY + LORA_A]
    r, k, v, zw, za, zg = jnp.split(us, cuts, axis=-1)
    w_raw = -jax.nn.softplus(-(lw['w0'] + jnp.tanh(zw) @ lw['w_decay_up']).astype(f32)) - 0.5
    decay = jnp.exp(-jnp.exp(w_raw))
    a = jax.nn.sigmoid((lw['a0'] + za @ lw['w_a_up']).astype(f32))
    g = (jax.nn.sigmoid(zg) @ lw['w_g_up']).astype(f32)
    heads = lambda z: z.astype(f32).reshape(bsz, t, H_RWKV, RWKV_HEAD)
    r, k, v, decay, a = heads(r), heads(k), heads(v), heads(decay), heads(a)
    k_k = lw['k_k'].astype(f32).reshape(H_RWKV, RWKV_HEAD)
    k_a = lw['k_a'].astype(f32).reshape(H_RWKV, RWKV_HEAD)
    kk = k * k_k
    kk = kk / jnp.maximum(jnp.sqrt(jnp.sum(kk * kk, axis=-1, keepdims=True)), 1e-12)
    k = k * (1.0 + (a - 1.0) * k_a)
    y, wkv = wkv_scan(r, decay, k, v, kk, a, wkv0.astype(f32))
    mu = jnp.mean(y, axis=-1, keepdims=True)
    var = jnp.mean(jnp.square(y - mu), axis=-1, keepdims=True)
    y = ((y - mu) * lax.rsqrt(var + GN_EPS)).reshape(bsz, t, D_RWKV)
    y = y * lw['ln_x_w'].astype(f32) + lw['ln_x_b'].astype(f32)
    bonus = jnp.sum(r * k * lw['r_k'].astype(f32), axis=-1, keepdims=True) * v
    out = (y + bonus.reshape(bsz, t, D_RWKV)) * g
    return out.astype(u_r.dtype), u_r[:, -1], wkv.astype(wkv0.dtype)


def _fox_block(q, cq, pq, k, v, ck, pk):
    s = jnp.einsum('bhqd,bhkd->bhqk', q, k).astype(jnp.float32) * (FOX_HEAD ** -0.5)
    s = s + cq[..., :, None] - ck[..., None, :]
    s = jnp.where(pk[None, :] <= pq[:, None], s, -jnp.inf)
    p = jax.nn.softmax(s, axis=-1)
    return jnp.einsum('bhqk,bhkd->bhqd', p.astype(v.dtype), v)


def fox_attention(q, cq, pq, k, v, ck, pk):
    bsz, nh, nq, dh = q.shape
    if nq <= Q_BLOCK:
        return _fox_block(q, cq, pq, k, v, ck, pk)
    nb = -(-nq // Q_BLOCK)
    pad = nb * Q_BLOCK - nq
    qb = jnp.pad(q, ((0, 0), (0, 0), (0, pad), (0, 0))).reshape(bsz, nh, nb, Q_BLOCK, dh).transpose(2, 0, 1, 3, 4)
    cqb = jnp.pad(cq, ((0, 0), (0, 0), (0, pad))).reshape(bsz, nh, nb, Q_BLOCK).transpose(2, 0, 1, 3)
    pqb = jnp.pad(pq, (0, pad)).reshape(nb, Q_BLOCK)
    out = lax.map(lambda blk: _fox_block(blk[0], blk[1], blk[2], k, v, ck, pk), (qb, cqb, pqb))
    out = out.transpose(1, 2, 0, 3, 4).reshape(bsz, nh, nb * Q_BLOCK, dh)
    return out[:, :, :nq]


def attend_prompt(q, k, v, lf):
    bsz, t = q.shape[:2]
    pos = jnp.arange(t, dtype=jnp.int32)
    c = jnp.cumsum(lf, axis=1).transpose(0, 2, 1)
    qh, kh, vh = q.transpose(0, 2, 1, 3), k.transpose(0, 2, 1, 3), v.transpose(0, 2, 1, 3)
    m = N_META
    o_meta = fox_attention(qh[:, :, :m], c[:, :, :m], pos[:m], kh[:, :, :m], vh[:, :, :m], c[:, :, :m], pos[:m])
    o_real = fox_attention(qh[:, :, m:], c[:, :, m:], pos[m:], kh, vh, c, pos)
    o = jnp.concatenate([o_meta, o_real], axis=2)
    return o.transpose(0, 2, 1, 3).reshape(bsz, t, D_FOX)


def attend_sample(k_pool, v_pool, lf_pool, page_table, q, k, v, lf):
    nb, n_pages = page_table.shape
    past = n_pages * k_pool.shape[1]
    t = q.shape[1]
    k_past = k_pool[page_table].reshape(nb, past, H_FOX, FOX_HEAD)
    v_past = v_pool[page_table].reshape(nb, past, H_FOX, FOX_HEAD)
    lf_past = lf_pool[page_table].reshape(nb, past, H_FOX).astype(jnp.float32)
    k_all = jnp.concatenate([k_past, k.astype(k_past.dtype)], axis=1).transpose(0, 2, 1, 3)
    v_all = jnp.concatenate([v_past, v.astype(v_past.dtype)], axis=1).transpose(0, 2, 1, 3)
    c = jnp.cumsum(jnp.concatenate([lf_past, lf], axis=1), axis=1).transpose(0, 2, 1)
    pos = jnp.arange(past + t, dtype=jnp.int32)
    o = fox_attention(q.transpose(0, 2, 1, 3).astype(k_all.dtype), c[:, :, past:], pos[past:], k_all, v_all, c, pos)
    return o.transpose(0, 2, 1, 3).reshape(nb, t, D_FOX).astype(q.dtype)


def decoder_layer(x, shift_prev, wkv0, attend, lw):
    bsz, t = x.shape[:2]
    h = rms_norm(x, lw['norm_mix'])
    u = h @ lw['w_in']
    u_r, u_f, u_g = jnp.split(u, [D_SHIFT, D_SHIFT + D_FOX_IN], axis=-1)
    o_r, new_shift, new_wkv = rwkv_time_mix(u_r, shift_prev, wkv0, lw)
    q, k, v, f_logit = jnp.split(u_f, [D_FOX, 2 * D_FOX, 3 * D_FOX], axis=-1)
    q = q.reshape(bsz, t, H_FOX, FOX_HEAD)
    k = k.reshape(bsz, t, H_FOX, FOX_HEAD)
    v = v.reshape(bsz, t, H_FOX, FOX_HEAD)
    lf = jax.nn.log_sigmoid((f_logit + lw['b_forget']).astype(jnp.float32))
    o_f = attend(q, k, v, lf)
    g_r, g_f = jnp.split(u_g, 2, axis=-1)
    merged = jax.nn.sigmoid(g_r) * (o_r @ lw['w_br_rwkv']) + jax.nn.sigmoid(g_f) * (o_f @ lw['w_br_fox'])
    x = x + merged @ lw['w_out']
    h2 = rms_norm(x, lw['norm_ffn'])
    x = x + jnp.square(jax.nn.relu(h2 @ lw['w_ffn_up'])) @ lw['w_ffn_down']
    return x, (new_shift, new_wkv, k, v, lf.astype(x.dtype))


def setup_inputs(seed: int = 0) -> dict:
    key = jax.random.key(seed)
    ks = jax.random.split(key, 32)
    f32 = jnp.float32
    nrm = lambda kk, shape, s: s * jax.random.normal(kk, shape, f32)
    n_pages = PAST_LEN // PAGE_SIZE
    n_used = DEC_BATCH * n_pages
    n_pool = n_used + max(1, n_used // 4)
    perm = jax.random.permutation(ks[0], n_pool)
    page_table = perm[:n_used].reshape(DEC_BATCH, n_pages).astype(jnp.int32)
    L = DEPTH
    return {
        'x_prompt': nrm(ks[1], (BATCH, SEQ, D_MODEL), 1.0),
        'x_sample': nrm(ks[2], (DEC_BATCH, DEC_SEQ, D_MODEL), 1.0),
        'state_shift': nrm(ks[3], (L, DEC_BATCH, D_SHIFT), 1.0),
        'state_wkv': nrm(ks[4], (L, DEC_BATCH, H_RWKV, RWKV_HEAD, RWKV_HEAD), 0.3),
        'cache_k': nrm(ks[5], (L, n_pool, PAGE_SIZE, H_FOX, FOX_HEAD), 1.0),
        'cache_v': nrm(ks[6], (L, n_pool, PAGE_SIZE, H_FOX, FOX_HEAD), 1.0),
        'cache_logf': jax.nn.log_sigmoid(3.0 + nrm(ks[7], (L, n_pool, PAGE_SIZE, H_FOX), 1.0)),
        'page_table': page_table,
        'meta_tokens': nrm(ks[8], (N_META, D_MODEL), 1.0),
        'norm_mix': 1.0 + nrm(ks[9], (L, D_MODEL), 0.02),
        'w_in': nrm(ks[10], (L, D_MODEL, D_IN), D_MODEL ** -0.5),
        'mu_shift': jax.random.uniform(ks[11], (L, D_SHIFT), f32),
        'w0': -2.0 + nrm(ks[12], (L, D_RWKV), 0.5),
        'w_decay_up': nrm(ks[13], (L, LORA_DECAY, D_RWKV), LORA_DECAY ** -0.5),
        'a0': nrm(ks[14], (L, D_RWKV), 0.1),
        'w_a_up': nrm(ks[15], (L, LORA_A, D_RWKV), LORA_A ** -0.5),
        'w_g_up': nrm(ks[16], (L, LORA_GATE, D_RWKV), LORA_GATE ** -0.5),
        'k_k': 0.85 + nrm(ks[17], (L, D_RWKV), 0.05),
        'k_a': 1.0 + nrm(ks[18], (L, D_RWKV), 0.05),
        'r_k': nrm(ks[19], (L, H_RWKV, RWKV_HEAD), 0.1),
        'ln_x_w': 1.0 + nrm(ks[20], (L, D_RWKV), 0.02),
        'ln_x_b': nrm(ks[21], (L, D_RWKV), 0.02),
        'b_forget': jax.random.uniform(ks[22], (L, H_FOX), f32, 1.0, 5.0),
        'w_br_rwkv': nrm(ks[23], (L, D_RWKV, D_MODEL), D_RWKV ** -0.5),
        'w_br_fox': nrm(ks[24], (L, D_FOX, D_MODEL), D_FOX ** -0.5),
        'w_out': nrm(ks[25], (L, D_MODEL, D_MODEL), D_MODEL ** -0.5),
        'norm_ffn': 1.0 + nrm(ks[26], (L, D_MODEL), 0.02),
        'w_ffn_up': nrm(ks[27], (L, D_MODEL, D_FF), D_MODEL ** -0.5),
        'w_ffn_down': nrm(ks[28], (L, D_FF, D_MODEL), D_FF ** -0.5),
        'norm_final': 1.0 + nrm(ks[29], (D_MODEL,), 0.02),
    }


def reference(x_prompt, x_sample, state_shift, state_wkv, cache_k, cache_v, cache_logf, page_table,
              meta_tokens, norm_mix, w_in, mu_shift, w0, w_decay_up, a0, w_a_up, w_g_up, k_k, k_a, r_k,
              ln_x_w, ln_x_b, b_forget, w_br_rwkv, w_br_fox, w_out, norm_ffn, w_ffn_up, w_ffn_down,
              norm_final):
    bsz = x_prompt.shape[0]
    meta = jnp.broadcast_to(meta_tokens[None].astype(x_prompt.dtype), (bsz, N_META, D_MODEL))
    xp = jnp.concatenate([meta, x_prompt], axis=1)
    xs = x_sample
    p_shift, p_wkv, p_k, p_v, p_lf = [], [], [], [], []
    s_shift, s_wkv, s_k, s_v, s_lf = [], [], [], [], []
    for l in range(DEPTH):
        lw = {
            'norm_mix': norm_mix[l], 'w_in': w_in[l], 'mu_shift': mu_shift[l], 'w0': w0[l],
            'w_decay_up': w_decay_up[l], 'a0': a0[l], 'w_a_up': w_a_up[l], 'w_g_up': w_g_up[l],
            'k_k': k_k[l], 'k_a': k_a[l], 'r_k': r_k[l], 'ln_x_w': ln_x_w[l], 'ln_x_b': ln_x_b[l],
            'b_forget': b_forget[l], 'w_br_rwkv': w_br_rwkv[l], 'w_br_fox': w_br_fox[l],
            'w_out': w_out[l], 'norm_ffn': norm_ffn[l], 'w_ffn_up': w_ffn_up[l],
            'w_ffn_down': w_ffn_down[l],
        }
        shift0 = jnp.zeros((bsz, D_SHIFT), xp.dtype)
        wkv0 = jnp.zeros((bsz, H_RWKV, RWKV_HEAD, RWKV_HEAD), xp.dtype)
        xp, (sh, wk, kr, vr, lr) = decoder_layer(xp, shift0, wkv0, attend_prompt, lw)
        p_shift.append(sh); p_wkv.append(wk); p_k.append(kr); p_v.append(vr); p_lf.append(lr)
        attend = functools.partial(attend_sample, cache_k[l], cache_v[l], cache_logf[l], page_table)
        xs, (sh, wk, kr, vr, lr) = decoder_layer(xs, state_shift[l], state_wkv[l], attend, lw)
        s_shift.append(sh); s_wkv.append(wk); s_k.append(kr); s_v.append(vr); s_lf.append(lr)
    y_prompt = rms_norm(xp[:, N_META:], norm_final)
    y_sample = rms_norm(xs, norm_final)
    return (y_prompt, y_sample,
            jnp.stack(p_shift), jnp.stack(p_wkv), jnp.stack(p_k), jnp.stack(p_v), jnp.stack(p_lf),
            jnp.stack(s_shift), jnp.stack(s_wkv), jnp.stack(s_k), jnp.stack(s_v), jnp.stack(s_lf))
```

```cpp
#include <hip/hip_runtime.h>
#include <hip/hip_bf16.h>
#include <cstdio>
#include <cstdint>
#include <cmath>
__device__ __forceinline__ int tid_fresh() { int t = (int)threadIdx.x; asm volatile("" : "+v"(t)); return t; }
namespace pg8 {
#define PG8_LAS __attribute__((address_space(3)))
typedef unsigned short bf16_t;
typedef short bf16x8 __attribute__((ext_vector_type(8)));
typedef float f32x4 __attribute__((ext_vector_type(4)));
typedef unsigned u32x4 __attribute__((ext_vector_type(4)));
constexpr int BM = 256, BK = 64, HALF = 128, HTB = HALF * BK * 2  , STAGE_BYTES = 8 * HTB, NXCD = 8, WGM = 8;

__host__ __device__ __forceinline__ int lds_byte(int r, int c) { const int st = (r >> 4) * 2 + (c >> 5), rr = r & 15, cc = c & 31, ob = rr * 64 + cc * 2; return st * 1024 + (ob ^ (((ob >> 9) & 1) << 5)); }
__host__ __device__ __forceinline__ void stage_rc(int b, int& R, int& C) { const int st = b / 1024, sb = b % 1024, swz = sb ^ (((sb >> 9) & 1) << 5); R = (st >> 1) * 16 + swz / 64; C = (st & 1) * 32 + (swz % 64) / 2; }
__host__ __device__ __forceinline__ int perm32(int rho) { const int n = rho >> 4, i = rho & 15; return 8 * (i >> 2) + 4 * n + (i & 3); }

struct Unit { int pm, pn; };
struct Gemm { const bf16_t* A; const bf16_t* Bt; int M, N, K, ld; };

struct StaticOrder {
    int nM, nN, nwg, G, c;
    __host__ __device__ void init(int M, int N, int G_, int c_) { nM = M / BM; nN = N / BM; nwg = nM * nN; G = G_; c = c_; }
    __host__ __device__ bool next(int i, Unit& u) const {
        const long L = (long)i * G + c; if (L >= nwg) return false;
        int wgid = (int)L; { const int q = nwg / NXCD, r = nwg % NXCD, xcd = wgid % NXCD, off = wgid / NXCD; wgid = (xcd < r ? xcd * (q + 1) : r * (q + 1) + (xcd - r) * q) + off; }
        const int nig = WGM * nN, gid = wgid / nig, fm = gid * WGM, gsz = (nM - fm) < WGM ? (nM - fm) : WGM;
        u.pm = fm + ((wgid % nig) % gsz); u.pn = (wgid % nig) / gsz; return true;
    }
    __device__ __forceinline__ void a_ready(const Unit&) const {}
    __device__ __forceinline__ void done(const Unit&) const {}
};

__device__ __forceinline__ unsigned cvt_pk_bf16(float lo, float hi) { unsigned r; asm volatile("v_cvt_pk_bf16_f32 %0, %1, %2" : "=v"(r) : "v"(lo), "v"(hi)); return r; }
typedef float f32x2 __attribute__((ext_vector_type(2)));
template <class Epi, class Sched, bool ALIGN_EPI = false, bool SP2 = false>
__device__ __forceinline__ void gemm_phase(PG8_LAS unsigned char* lds, const Gemm g, const Sched& S, const Epi& E) {
    const int tid = tid_fresh(), wid = __builtin_amdgcn_readfirstlane(tid >> 6), lane = tid & 63, wr = wid >> 2, wc = wid & 3, fr = lane & 15, fq = lane >> 4;
    const int K = g.K, nt = K / BK, LD = g.ld;
    unsigned voffA[2], voffB[2];
#pragma unroll
    for (int i = 0; i < 2; ++i) { int R, C; stage_rc(tid * 16 + i * 8192, R, C); const int Rb = Epi::PERM ? ((R & ~31) + perm32(R & 31)) : R;
        voffA[i] = (unsigned)(R * LD + C) * 2u; voffB[i] = (unsigned)(Rb * LD + C) * 2u; }
    const size_t kstep = (size_t)(BK * 2);
    const size_t hstep = (size_t)HALF * LD * 2;
    const size_t tstep = 2 * hstep;
    const unsigned ldsw = (unsigned)wid * 1024u;
    const int aoff = lds_byte(wr * 64 + fr, fq * 8), boff = lds_byte(wc * 32 + fr, fq * 8);
#define PG8_SA(b, h) (((b) * 2 + (h)) * HTB)
#define PG8_SB(b, h) ((4 + (b) * 2 + (h)) * HTB)
#define PG8_STAGE(bufoff, gbase, voff) do { _Pragma("unroll") for (int _i = 0; _i < 2; ++_i) \
        __builtin_amdgcn_global_load_lds((const unsigned*)((const char*)(gbase) + (voff)[_i]), (PG8_LAS unsigned*)(lds + (bufoff) + ldsw + _i * 8192), 16, 0, 0); } while (0)
#define PG8_LDA(dst, b, h) do { _Pragma("unroll") for (int m = 0; m < 4; ++m) _Pragma("unroll") for (int k = 0; k < 2; ++k) dst[m][k] = *(const PG8_LAS bf16x8*)(lds + PG8_SA(b, h) + aoff + m * 2048 + k * 1024); } while (0)
#define PG8_LDB(dst, b, h) do { _Pragma("unroll") for (int n = 0; n < 2; ++n) _Pragma("unroll") for (int k = 0; k < 2; ++k) dst[n][k] = *(const PG8_LAS bf16x8*)(lds + PG8_SB(b, h) + boff + n * 2048 + k * 1024); } while (0)
#define PG8_MMA(ai, bj, At, Bt) do { __builtin_amdgcn_s_setprio(1); _Pragma("unroll") for (int m = 0; m < 4; ++m) _Pragma("unroll") for (int n = 0; n < 2; ++n) _Pragma("unroll") for (int k = 0; k < 2; ++k) \
        acc[ai][bj][m][n] = __builtin_amdgcn_mfma_f32_16x16x32_bf16(Bt[n][k], At[m][k], acc[ai][bj][m][n], 0, 0, 0); __builtin_amdgcn_s_setprio(0); } while (0)
#define PG8_WAIT_V(n) asm volatile("s_waitcnt vmcnt(" #n ")" ::: "memory")
#define PG8_WAIT_L(n) asm volatile("s_waitcnt lgkmcnt(" #n ")" ::: "memory")
#define PG8_BAR __builtin_amdgcn_s_barrier()
#define PG8_SCHED __builtin_amdgcn_sched_barrier(0)
    Unit cur, nxt; int ui = 0;
    if (!S.next(0, cur)) return;
    f32x4 acc[2][2][4][2];
#pragma unroll
    for (int a = 0; a < 2; ++a)
#pragma unroll
        for (int b = 0; b < 2; ++b)
#pragma unroll
            for (int m = 0; m < 4; ++m)
#pragma unroll
                for (int n = 0; n < 2; ++n) acc[a][b][m][n] = (f32x4){0.f, 0.f, 0.f, 0.f};
    bf16x8 At[4][2], B0[2][2], B1[2][2];
    const char* cA = (const char*)g.A + (size_t)cur.pm * tstep; const char* cB = (const char*)g.Bt + (size_t)cur.pn * tstep;
    S.a_ready(cur);
    if constexpr (SP2) {
        PG8_STAGE(PG8_SB(0, 0), cB, voffB); PG8_STAGE(PG8_SB(0, 1), cB + hstep, voffB); PG8_STAGE(PG8_SA(0, 0), cA, voffA); PG8_STAGE(PG8_SA(0, 1), cA + hstep, voffA);
        if (wr == 1) PG8_BAR;
        PG8_WAIT_V(2); PG8_BAR;
        PG8_STAGE(PG8_SB(1, 0), cB + kstep, voffB); PG8_STAGE(PG8_SA(1, 0), cA + kstep, voffA); PG8_STAGE(PG8_SB(1, 1), cB + hstep + kstep, voffB);
        PG8_WAIT_V(6); PG8_BAR;
    } else {
        PG8_STAGE(PG8_SB(0, 0), cB, voffB); PG8_STAGE(PG8_SA(0, 0), cA, voffA); PG8_STAGE(PG8_SB(0, 1), cB + hstep, voffB); PG8_STAGE(PG8_SA(0, 1), cA + hstep, voffA);
        if (wr == 1) PG8_BAR;
        PG8_WAIT_V(4); PG8_BAR;
        PG8_STAGE(PG8_SB(1, 0), cB + kstep, voffB); PG8_STAGE(PG8_SA(1, 0), cA + kstep, voffA); PG8_STAGE(PG8_SB(1, 1), cB + hstep + kstep, voffB);
        PG8_WAIT_V(6); PG8_BAR;
    }
    for (;;) {
        const bool has_next = S.next(ui + 1, nxt);
        const char* nA = has_next ? (const char*)g.A + (size_t)nxt.pm * tstep : cA; const char* nB = has_next ? (const char*)g.Bt + (size_t)nxt.pn * tstep : cB;
        for (int t = 0; t < nt; t += 2) {
            const bool last = (t == nt - 2);
            const char* a1 = cA + (size_t)(t + 1) * kstep;
            const char* a2 = last ? nA : cA + (size_t)(t + 2) * kstep; const char* b2 = last ? nB : cB + (size_t)(t + 2) * kstep;
            const char* a3 = a2 + kstep; const char* b3 = b2 + kstep;
            if (last && has_next) S.a_ready(nxt);
            if constexpr (SP2) {
            PG8_LDB(B0, 0, 0); PG8_LDB(B1, 0, 1); PG8_SCHED; PG8_LDA(At, 0, 0); PG8_STAGE(PG8_SA(1, 1), a1 + hstep, voffA);
            PG8_WAIT_V(8); PG8_WAIT_L(0); PG8_BAR; PG8_MMA(0, 0, At, B0); PG8_MMA(0, 1, At, B1); PG8_BAR; PG8_SCHED;
            PG8_LDA(At, 0, 1); PG8_STAGE(PG8_SB(0, 0), b2, voffB); PG8_STAGE(PG8_SB(0, 1), b2 + hstep, voffB); PG8_STAGE(PG8_SA(0, 0), a2, voffA);
            PG8_WAIT_V(8); PG8_WAIT_L(0); PG8_BAR; PG8_MMA(1, 0, At, B0); PG8_MMA(1, 1, At, B1); PG8_BAR; PG8_SCHED;
            PG8_LDB(B0, 1, 0); PG8_LDB(B1, 1, 1); PG8_SCHED; PG8_LDA(At, 1, 0); PG8_STAGE(PG8_SA(0, 1), a2 + hstep, voffA);
            PG8_WAIT_V(8); PG8_WAIT_L(0); PG8_BAR; PG8_MMA(0, 0, At, B0); PG8_MMA(0, 1, At, B1); PG8_BAR; PG8_SCHED;
            PG8_LDA(At, 1, 1); PG8_STAGE(PG8_SB(1, 0), b3, voffB); PG8_STAGE(PG8_SB(1, 1), b3 + hstep, voffB); PG8_STAGE(PG8_SA(1, 0), a3, voffA);
            PG8_WAIT_V(8); PG8_WAIT_L(0); PG8_BAR; PG8_MMA(1, 0, At, B0); PG8_MMA(1, 1, At, B1); PG8_BAR; PG8_SCHED;
            } else {
            PG8_LDB(B0, 0, 0); PG8_SCHED; PG8_LDA(At, 0, 0); PG8_STAGE(PG8_SA(1, 1), a1 + hstep, voffA);
            PG8_WAIT_L(8); PG8_BAR; PG8_WAIT_L(0); PG8_MMA(0, 0, At, B0); PG8_BAR; PG8_SCHED;
            PG8_LDB(B1, 0, 1); PG8_STAGE(PG8_SB(0, 0), b2, voffB);
            PG8_BAR; PG8_WAIT_L(0); PG8_MMA(0, 1, At, B1); PG8_BAR;
            PG8_LDA(At, 0, 1); PG8_STAGE(PG8_SA(0, 0), a2, voffA);
            PG8_BAR; PG8_WAIT_L(0); PG8_MMA(1, 0, At, B0); PG8_BAR; PG8_SCHED;
            PG8_STAGE(PG8_SB(0, 1), b2 + hstep, voffB);
            PG8_WAIT_V(6); PG8_BAR; PG8_MMA(1, 1, At, B1); PG8_BAR;
            PG8_LDB(B0, 1, 0); PG8_SCHED; PG8_LDA(At, 1, 0); PG8_STAGE(PG8_SA(0, 1), a2 + hstep, voffA);
            PG8_WAIT_L(8); PG8_BAR; PG8_WAIT_L(0); PG8_MMA(0, 0, At, B0); PG8_BAR; PG8_SCHED;
            PG8_LDB(B1, 1, 1); PG8_STAGE(PG8_SB(1, 0), b3, voffB);
            PG8_BAR; PG8_WAIT_L(0); PG8_MMA(0, 1, At, B1); PG8_BAR;
            PG8_LDA(At, 1, 1); PG8_STAGE(PG8_SA(1, 0), a3, voffA);
            PG8_BAR; PG8_WAIT_L(0); PG8_MMA(1, 0, At, B0); PG8_BAR; PG8_SCHED;
            PG8_STAGE(PG8_SB(1, 1), b3 + hstep, voffB);
            PG8_WAIT_V(6); PG8_BAR; PG8_MMA(1, 1, At, B1); PG8_BAR;
            }
        }
        if constexpr (ALIGN_EPI) { if (wr == 0) PG8_BAR; }
        if constexpr (!Epi::AFTER_DRAIN) { E(acc, cur, wr, wc, fr, fq); S.done(cur); }
        if (!has_next) break;
#pragma unroll
        for (int a = 0; a < 2; ++a)
#pragma unroll
            for (int b = 0; b < 2; ++b)
#pragma unroll
                for (int m = 0; m < 4; ++m)
#pragma unroll
                    for (int n = 0; n < 2; ++n) acc[a][b][m][n] = (f32x4){0.f, 0.f, 0.f, 0.f};
        cur = nxt; cA = nA; cB = nB; ++ui;
        if constexpr (ALIGN_EPI) { if (wr == 1) PG8_BAR; }
    }
    PG8_WAIT_V(0);
    if constexpr (!ALIGN_EPI) { if (wr == 0) PG8_BAR; }
    PG8_BAR;
    if constexpr (Epi::AFTER_DRAIN) { E.fused(acc, cur, wr, wc, fr, fq, lds, wid, lane); S.done(cur); }
#undef PG8_SA
#undef PG8_SB
#undef PG8_STAGE
#undef PG8_LDA
#undef PG8_LDB
#undef PG8_MMA
#undef PG8_WAIT_V
#undef PG8_WAIT_L
#undef PG8_BAR
#undef PG8_SCHED
}
}
#define PG8_SP2 true
#define PG8_ALIGN true
namespace attn_body {
using bf16=__hip_bfloat16;
using bf16x8=__attribute__((ext_vector_type(8)))short;
using s16x4=__attribute__((ext_vector_type(4)))short;
using f32x16=__attribute__((ext_vector_type(16)))float;
using u32x4=__attribute__((ext_vector_type(4)))unsigned;
using f32x4=__attribute__((ext_vector_type(4)))float;
constexpr int BATCH=2,NHEAD=8,SEQ=8192,D=64,DM=NHEAD*D,OPITCH=1024,OCOL0=512,METAROW=16384,BIASN=8320;
constexpr int NW=8,QBLK=32,QB=QBLK*NW,KVBLK=64,NQB=SEQ/QB;
constexpr int ATTN_PITCH=DM, ATTN_UNIT_ROWS=QB;
__device__ __forceinline__ int crow(int r,int hi){return (r&3)+8*(r>>2)+4*hi;}
#define SBAR() __builtin_amdgcn_sched_barrier(0)
__device__ __forceinline__ void cmask(f32x16&p0,f32x16&p1,int jb,int qrel,int hi){
  const float NEG=-INFINITY; int kb=64*jb+4*hi;
  #pragma unroll
  for(int r=0;r<16;++r){int kv=kb+(r&3)+8*(r>>2); if(kv>qrel)p0[r]=NEG; if(kv+32>qrel)p1[r]=NEG;}
}

constexpr int NSLOT=3, SLOTB=8192;
constexpr int LDS_K=0, LDS_V=NSLOT*SLOTB, LDS_WS=2*NSLOT*SLOTB, LDS_OST=LDS_WS+NW*64*4, LDS_BIAS=LDS_OST+NW*4096, LDS_BYTES=LDS_BIAS+BIASN*4;
constexpr float C2=0.125f*1.4426950408889634f;
__device__ __forceinline__ void glds16(const void*gsrc,unsigned lds_dst){unsigned keep;
  asm volatile("s_mov_b32 %0, m0\n\ts_mov_b32 m0, %2\n\ts_nop 0\n\tglobal_load_lds_dwordx4 %1, off\n\ts_mov_b32 m0, %0":"=&s"(keep):"v"(gsrc),"s"(lds_dst):"memory");}
__device__ __forceinline__ float max3f(float a,float b,float c){float r;asm("v_max3_f32 %0, %1, %2, %3":"=v"(r):"v"(a),"v"(b),"v"(c));return r;}
__device__ __forceinline__ float max2f(float a,float b){float r;asm("v_max_f32_e32 %0, %1, %2":"=v"(r):"v"(a),"v"(b));return r;}
__device__ __forceinline__ float fadd_s(float a,float b){float r;asm("v_add_f32_e32 %0, %1, %2":"=v"(r):"v"(a),"v"(b));return r;}
__device__ __forceinline__ float fsub_s(float a,float b){float r;asm("v_sub_f32_e32 %0, %1, %2":"=v"(r):"v"(a),"v"(b));return r;}
typedef float f32x2_t __attribute__((ext_vector_type(2))); typedef __bf16 bf16x2_t __attribute__((ext_vector_type(2)));
__device__ __forceinline__ unsigned cvtpk_s(float lo,float hi){f32x2_t v={lo,hi};bf16x2_t b=__builtin_convertvector(v,bf16x2_t);return __builtin_bit_cast(unsigned,b);}
#define WAIT_BAR(N) asm volatile("s_waitcnt vmcnt(" #N ") lgkmcnt(0)\n\ts_barrier":::"memory")

__device__ __forceinline__ void qkt(f32x16&p0,f32x16&p1,const char*Kslot,const bf16x8*qr,const f32x16&cb0,const f32x16&cb1,int r32,int hi){
  const char*kb=Kslot+hi*1024+r32*16;
  #pragma unroll
  for(int d0=0;d0<4;++d0){
    const bf16x8 b0=*reinterpret_cast<const bf16x8*>(kb+d0*2048);
    const bf16x8 b1=*reinterpret_cast<const bf16x8*>(kb+d0*2048+512);
    if(d0==0){p0=__builtin_amdgcn_mfma_f32_32x32x16_bf16(b0,qr[0],cb0,0,0,0);p1=__builtin_amdgcn_mfma_f32_32x32x16_bf16(b1,qr[0],cb1,0,0,0);}
    else{p0=__builtin_amdgcn_mfma_f32_32x32x16_bf16(b0,qr[d0],p0,0,0,0);p1=__builtin_amdgcn_mfma_f32_32x32x16_bf16(b1,qr[d0],p1,0,0,0);}}
}
typedef __attribute__((address_space(3))) const char* lds_cptr;
typedef short v4i16_t __attribute__((ext_vector_type(4)));
__device__ __forceinline__ void kload8(bf16x8*kf,lds_cptr kp){
  kf[0]=*(const __attribute__((address_space(3))) bf16x8*)(kp);      kf[1]=*(const __attribute__((address_space(3))) bf16x8*)(kp+512);
  kf[2]=*(const __attribute__((address_space(3))) bf16x8*)(kp+2048); kf[3]=*(const __attribute__((address_space(3))) bf16x8*)(kp+2560);
  kf[4]=*(const __attribute__((address_space(3))) bf16x8*)(kp+4096); kf[5]=*(const __attribute__((address_space(3))) bf16x8*)(kp+4608);
  kf[6]=*(const __attribute__((address_space(3))) bf16x8*)(kp+6144); kf[7]=*(const __attribute__((address_space(3))) bf16x8*)(kp+6656);
}
__device__ __forceinline__ void kload2(bf16x8*kf,lds_cptr kp,int j){ kf[2*j]=*(const __attribute__((address_space(3))) bf16x8*)(kp+j*2048); kf[2*j+1]=*(const __attribute__((address_space(3))) bf16x8*)(kp+j*2048+512); }
__device__ __forceinline__ s16x4 vtr(lds_cptr p){ return __builtin_bit_cast(s16x4,__builtin_amdgcn_ds_read_tr16_b64_v4i16((__attribute__((address_space(3))) v4i16_t*)p)); }
__device__ __forceinline__ float rowmax(const f32x16&p0,const f32x16&p1){
  float a=max3f(p0[0],p0[1],p1[0]),b=max3f(p0[2],p0[3],p1[1]);a=max3f(a,p1[2],p1[3]);
  #pragma unroll
  for(int r=4;r<16;r+=4){a=max3f(a,p0[r],p0[r+1]);b=max3f(b,p0[r+2],p0[r+3]);a=max3f(a,p1[r],p1[r+1]);b=max3f(b,p1[r+2],p1[r+3]);}
  const float m=max2f(a,b);
  auto rr=__builtin_amdgcn_permlane32_swap(__float_as_uint(m),__float_as_uint(m),false,false);
  return max2f(__uint_as_float(rr[0]),__uint_as_float(rr[1]));
}
__device__ __forceinline__ void pv(f32x16*o,int vb,bf16x8 pa0,bf16x8 pa1,bf16x8 pa2,bf16x8 pa3){
  #pragma unroll
  for(int d0=0;d0<2;++d0){s16x4 lo[4],hi[4];
    #pragma unroll
    for(int ks=0;ks<4;++ks){
      asm volatile("ds_read_b64_tr_b16 %0,%1 offset:%c2":"=&v"(lo[ks]):"v"(vb),"i"(d0*4096+ks*1024):"memory");
      asm volatile("ds_read_b64_tr_b16 %0,%1 offset:%c2":"=&v"(hi[ks]):"v"(vb),"i"(d0*4096+ks*1024+512):"memory");}
    asm volatile("s_waitcnt lgkmcnt(0)":::"memory");SBAR();
    #define PK(k) (bf16x8){lo[k][0],lo[k][1],lo[k][2],lo[k][3],hi[k][0],hi[k][1],hi[k][2],hi[k][3]}
    o[d0]=__builtin_amdgcn_mfma_f32_32x32x16_bf16(pa0,PK(0),o[d0],0,0,0);
    o[d0]=__builtin_amdgcn_mfma_f32_32x32x16_bf16(pa1,PK(1),o[d0],0,0,0);
    o[d0]=__builtin_amdgcn_mfma_f32_32x32x16_bf16(pa2,PK(2),o[d0],0,0,0);
    o[d0]=__builtin_amdgcn_mfma_f32_32x32x16_bf16(pa3,PK(3),o[d0],0,0,0);
    #undef PK
  }
}

#ifndef ATTN_STORE16
#define ATTN_STORE16(p,v) (*(u32x4*)(p)=(v))
#endif
template<int THRL> __device__ __forceinline__ void attn_unit(int b,int h,int qb,const bf16*Q,const bf16*__restrict__ K,const bf16*__restrict__ V,bf16*O,const float*__restrict__ NCL,char*shm){
  const int tid=tid_fresh(),lane=tid&63,r32=lane&31,hi=lane>>5; const int wid=__builtin_amdgcn_readfirstlane(tid>>6);
  const long rowbase=(long)b*SEQ; const int q0=qb*QB;
  const bf16*Qw=Q+(rowbase+q0+wid*QBLK)*DM+h*D;
  const bf16*Kh=K+(rowbase-128)*DM+h*D,*Vh=V+(rowbase-128)*DM+h*D;
  const bf16*Khm=K+(long)METAROW*DM+h*D,*Vhm=V+(long)METAROW*DM+h*D;
  const unsigned lds0=(unsigned)(uintptr_t)shm;
  float*wsf=(float*)(shm+LDS_WS)+wid*64;
  const bf16*ksrc=Kh+(long)lane*DM+wid*8;
  const bf16*vsrc=Vh+(long)(16*(wid&3)+(lane>>2))*DM+(wid>>2)*32+(lane&3)*8;
  const bf16*ksrcm=Khm+(long)lane*DM+wid*8;
  const bf16*vsrcm=Vhm+(long)(16*(wid&3)+(lane>>2))*DM+(wid>>2)*32+(lane&3)*8;
  const unsigned kdst=lds0+LDS_K+wid*1024, vdst=lds0+LDS_V+wid*1024;
  #define DMA_K(t,slot) glds16(ksrc+(long)(t)*KVBLK*DM,(unsigned)__builtin_amdgcn_readfirstlane(kdst+(slot)))
  #define DMA_V(t,slot) glds16(vsrc+(long)(t)*KVBLK*DM,(unsigned)__builtin_amdgcn_readfirstlane(vdst+(slot)))
  #define DMA_KM(slot) glds16(ksrcm,(unsigned)__builtin_amdgcn_readfirstlane(kdst+(slot)))
  #define DMA_VM(slot) glds16(vsrcm,(unsigned)__builtin_amdgcn_readfirstlane(vdst+(slot)))
  const int vb0=(int)(lds0+LDS_V)+((lane>>4)&1)*32+(lane&3)*8+(4*hi+((lane&15)>>2))*64;
  const char*Kbase=shm+LDS_K; bf16x8 kf[8];
  const lds_cptr shm3=(lds_cptr)shm; const lds_cptr kp0=shm3+LDS_K+hi*1024+r32*16; const lds_cptr vp0=shm3+LDS_V+((lane>>4)&1)*32+(lane&3)*8+(4*hi+((lane&15)>>2))*64;
  const int NT=(q0+QB)/KVBLK+2;
  { float*BLw=(float*)(shm+LDS_BIAS); const float ref=NCL[128+q0]; for(int j=tid;j<NT*KVBLK;j+=NW*64) BLw[j]=NCL[j]-ref; }
  const __attribute__((address_space(3))) f32x4*BLp=(const __attribute__((address_space(3))) f32x4*)((lds_cptr)shm+LDS_BIAS)+hi;
  DMA_KM(0);DMA_VM(0);DMA_KM(SLOTB);
  bf16x8 qr[4];
  #pragma unroll
  for(int d0=0;d0<4;++d0)qr[d0]=*reinterpret_cast<const bf16x8*>(&Qw[(long)r32*DM+d0*16+hi*8]);
  float mhat=0.f,l_reg=0.f;f32x16 o[2];o[0]=f32x16{};o[1]=f32x16{};float nm=0.f;
  const int qrel=wid*QBLK+r32;
  #define CMASK(P0,P1,t) do{int jb_=(t)-(NT-4); if(jb_>=0)cmask(P0,P1,jb_,qrel,hi);}while(0)
  bool resc=false;
  #define START(P0,P1) do{ const float rm=rowmax(P0,P1); resc=false; \
    { const float dl=rm; mhat=fadd_s(mhat,dl); \
      _Pragma("unroll") for(int r=0;r<16;++r){P0[r]=fsub_s(P0[r],dl);P1[r]=fsub_s(P1[r],dl);} \
      nm=-mhat; } \
    _Pragma("unroll") for(int r=0;r<16;++r)P0[r]=__builtin_amdgcn_exp2f(P0[r]); }while(0)
  #define RESC() do{ if(resc){ asm volatile("s_waitcnt lgkmcnt(0)":::"memory"); \
      _Pragma("unroll") for(int d_=0;d_<2;++d_) _Pragma("unroll") for(int r=0;r<16;++r)o[d_][r]*=wsf[crow(r,hi)]; } }while(0)
  f32x16 pA0,pA1,pB0,pB1;
  int sl_prev=0,sl_cur=0,sl_next=SLOTB;
  #define ROT() do{sl_prev=sl_cur;sl_cur=sl_next;sl_next=(sl_next==(NSLOT-1)*SLOTB)?0:sl_next+SLOTB;}while(0)
  DMA_K(2,2*SLOTB);
  WAIT_BAR(3);
  #define CBIAS(X0,X1,t) do{ _Pragma("unroll") for(int g_=0;g_<4;++g_){ const f32x4 a_=BLp[16*(t)+2*g_], b_=BLp[16*(t)+8+2*g_]; \
      X0[4*g_]=a_[0]+nm;X0[4*g_+1]=a_[1]+nm;X0[4*g_+2]=a_[2]+nm;X0[4*g_+3]=a_[3]+nm; X1[4*g_]=b_[0]+nm;X1[4*g_+1]=b_[1]+nm;X1[4*g_+2]=b_[2]+nm;X1[4*g_+3]=b_[3]+nm; } }while(0)
  { f32x16 cb0,cb1; CBIAS(cb0,cb1,0); qkt(pA0,pA1,Kbase,qr,cb0,cb1,r32,hi); }asm volatile("s_nop 15\n\ts_nop 7":"+v"(pA0),"+v"(pA1));CMASK(pA0,pA1,0);
  START(pA0,pA1);
  _Pragma("unroll") for(int r=0;r<16;++r)pA1[r]=__builtin_amdgcn_exp2f(pA1[r]);
  WAIT_BAR(0);
  DMA_K(3,0);DMA_VM(SLOTB);
  ROT();
  kload8(kf,kp0+sl_cur);
  WAIT_BAR(2);
  s16x4 vlo[8],vhi[8]; u32x4 pw0,pw1,pw2,pw3;
  #define PKW(P,B) cvtpk_s(P[B],P[B+1])
  #define PAF(k) __builtin_bit_cast(bf16x8,pw##k)
  #define VFR(i) (bf16x8){vlo[i][0],vlo[i][1],vlo[i][2],vlo[i][3],vhi[i][0],vhi[i][1],vhi[i][2],vhi[i][3]}
  #define PIN(x) asm volatile("":"+v"(x))
  #define MX3(a,b,c) __builtin_fmaxf(__builtin_fmaxf((a),(b)),(c))
  #define GAPA(MF,A0,A1,A2,A3,W0,W1,PW) do{ MF; sacc+=A0; sacc+=A1; sacc+=A2; sacc+=A3; PIN(sacc); W0; W1; PIN(PW); SBAR(); }while(0)
  #define EX(v) __builtin_amdgcn_exp2f(v)
  #define GAPB(MF,X,B) do{ MF; X[B]=EX(X[B]); X[B+1]=EX(X[B+1]); X[B+2]=EX(X[B+2]); X[B+3]=EX(X[B+3]); PIN(X); SBAR(); }while(0)
  #define VRD(i) do{ vlo[i]=vtr(vp_+(((i)>>2)*4096+((i)&3)*1024)); vhi[i]=vtr(vp_+(((i)>>2)*4096+((i)&3)*1024+512)); }while(0)
  #define KRD(G,j) do{ if(G){ kload2(kf,kp0+sl_next,j); SBAR(); } }while(0)
  #define STEP(C0,C1,P0,P1,t,GK,GV,GL) do{ SBAR(); \
    const lds_cptr vp_=vp0+sl_prev; CBIAS(C0,C1,t); SBAR(); \
    VRD(0); SBAR(); float sacc=(P0[0]+P0[1]); \
    GAPA(C0=__builtin_amdgcn_mfma_f32_32x32x16_bf16(kf[0],qr[0],C0,0,0,0), P0[2],P0[3],P0[4],P0[5],     pw0[0]=PKW(P0,0), pw0[1]=PKW(P0,2), pw0); \
    VRD(4); SBAR(); GAPA(C1=__builtin_amdgcn_mfma_f32_32x32x16_bf16(kf[1],qr[0],C1,0,0,0), P0[6],P0[7],P0[8],P0[9],     pw0[2]=PKW(P0,4), pw0[3]=PKW(P0,6), pw0); \
    VRD(1); SBAR(); GAPA(C0=__builtin_amdgcn_mfma_f32_32x32x16_bf16(kf[2],qr[1],C0,0,0,0),   P0[10],P0[11],P0[12],P0[13], pw1[0]=PKW(P0,8), pw1[1]=PKW(P0,10), pw1); \
    VRD(5); SBAR(); GAPA(C1=__builtin_amdgcn_mfma_f32_32x32x16_bf16(kf[3],qr[1],C1,0,0,0),   P0[14],P0[15],P1[0],P1[1],   pw1[2]=PKW(P0,12),pw1[3]=PKW(P0,14), pw1); \
    VRD(2); SBAR(); GAPA(C0=__builtin_amdgcn_mfma_f32_32x32x16_bf16(kf[4],qr[2],C0,0,0,0),   P1[2],P1[3],P1[4],P1[5],     pw2[0]=PKW(P1,0), pw2[1]=PKW(P1,2), pw2); \
    VRD(6); SBAR(); GAPA(C1=__builtin_amdgcn_mfma_f32_32x32x16_bf16(kf[5],qr[2],C1,0,0,0),   P1[6],P1[7],P1[8],P1[9],     pw2[2]=PKW(P1,4), pw2[3]=PKW(P1,6), pw2); \
    VRD(3); SBAR(); GAPA(C0=__builtin_amdgcn_mfma_f32_32x32x16_bf16(kf[6],qr[3],C0,0,0,0),   P1[10],P1[11],P1[12],P1[13], pw3[0]=PKW(P1,8), pw3[1]=PKW(P1,10), pw3); \
    VRD(7); SBAR(); GAPA(C1=__builtin_amdgcn_mfma_f32_32x32x16_bf16(kf[7],qr[3],C1,0,0,0),   P1[14],P1[15],0.f,0.f,       pw3[2]=PKW(P1,12),pw3[3]=PKW(P1,14), pw3); \
    l_reg+=sacc; \
    if(GK){DMA_K((t)+3,sl_cur);} if(GV){DMA_V((t)+1,sl_next);} \
    CMASK(C0,C1,t); \
    { float a=MX3(C0[0],C0[1],C1[0]),b=MX3(C0[2],C0[3],C1[1]); a=MX3(a,C1[2],C1[3]); \
      _Pragma("unroll") for(int r=4;r<16;r+=4){a=MX3(a,C0[r],C0[r+1]);b=MX3(b,C0[r+2],C0[r+3]);a=MX3(a,C1[r],C1[r+1]);b=MX3(b,C1[r+2],C1[r+3]);} \
      float rm=__builtin_fmaxf(a,b); { auto rr=__builtin_amdgcn_permlane32_swap(__float_as_uint(rm),__float_as_uint(rm),false,false); rm=__builtin_fmaxf(__uint_as_float(rr[0]),__uint_as_float(rr[1])); } \
      resc=false; \
      if(__builtin_expect(__any(rm>(float)THRL),0)){ const float dl=__builtin_fmaxf(rm,0.f); mhat+=dl; \
        _Pragma("unroll") for(int r=0;r<16;++r){C0[r]-=dl;C1[r]-=dl;} \
        nm=-mhat; \
        const float f=__builtin_amdgcn_exp2f(-dl); l_reg*=f; if(hi==0)wsf[r32]=f; resc=true; } } \
    SBAR(); \
    GAPB(o[0]=__builtin_amdgcn_mfma_f32_32x32x16_bf16(PAF(0),VFR(0),o[0],0,0,0), C0,0); \
    GAPB(o[1]=__builtin_amdgcn_mfma_f32_32x32x16_bf16(PAF(0),VFR(4),o[1],0,0,0), C0,4); \
    KRD(GL,0); GAPB(o[0]=__builtin_amdgcn_mfma_f32_32x32x16_bf16(PAF(1),VFR(1),o[0],0,0,0), C0,8); \
    KRD(GL,1); GAPB(o[1]=__builtin_amdgcn_mfma_f32_32x32x16_bf16(PAF(1),VFR(5),o[1],0,0,0), C0,12); \
    KRD(GL,2); GAPB(o[0]=__builtin_amdgcn_mfma_f32_32x32x16_bf16(PAF(2),VFR(2),o[0],0,0,0), C1,0); \
    KRD(GL,3); GAPB(o[1]=__builtin_amdgcn_mfma_f32_32x32x16_bf16(PAF(2),VFR(6),o[1],0,0,0), C1,4); \
    GAPB(o[0]=__builtin_amdgcn_mfma_f32_32x32x16_bf16(PAF(3),VFR(3),o[0],0,0,0), C1,8); \
    GAPB(o[1]=__builtin_amdgcn_mfma_f32_32x32x16_bf16(PAF(3),VFR(7),o[1],0,0,0), C1,12); \
    }while(0)
  int t=1;
  #undef CMASK
  #define CMASK(P0,P1,t) do{}while(0)
  for(;t+5<NT;t+=2){
    STEP(pB0,pB1,pA0,pA1,t,true,true,true);     WAIT_BAR(2); RESC(); ROT();
    STEP(pA0,pA1,pB0,pB1,t+1,true,true,true);   WAIT_BAR(2); RESC(); ROT();
  }
  #undef CMASK
  #define CMASK(P0,P1,t) do{int jb_=(t)-(NT-4); if(jb_>=0)cmask(P0,P1,jb_,qrel,hi);}while(0)
  #define ENDW(tt) do{ if((tt)+3<NT){WAIT_BAR(2);} else if((tt)+2<NT){WAIT_BAR(1);} else {WAIT_BAR(0);} }while(0)
  for(;t+1<NT;t+=2){
    STEP(pB0,pB1,pA0,pA1,t,(t+3<NT),(t+1<NT),(t+1<NT));       ENDW(t);   RESC(); ROT();
    STEP(pA0,pA1,pB0,pB1,t+1,(t+4<NT),(t+2<NT),(t+2<NT));     ENDW(t+1); RESC(); ROT();
  }
  STEP(pB0,pB1,pA0,pA1,NT-1,false,false,false); RESC();
  { float sacc=pB0[0]+pB0[1]; _Pragma("unroll") for(int r=2;r<16;++r)sacc+=pB0[r]; _Pragma("unroll") for(int r=0;r<16;++r)sacc+=pB1[r]; l_reg+=sacc;
    pw0=(u32x4){PKW(pB0,0),PKW(pB0,2),PKW(pB0,4),PKW(pB0,6)};pw1=(u32x4){PKW(pB0,8),PKW(pB0,10),PKW(pB0,12),PKW(pB0,14)};pw2=(u32x4){PKW(pB1,0),PKW(pB1,2),PKW(pB1,4),PKW(pB1,6)};pw3=(u32x4){PKW(pB1,8),PKW(pB1,10),PKW(pB1,12),PKW(pB1,14)};
    SBAR(); pv(o,vb0+sl_cur,PAF(0),PAF(1),PAF(2),PAF(3)); }
  #undef PKW
  #undef PAF
  #undef VFR
  #undef PIN
  #undef MX3
  #undef GAPA
  #undef GAPB
  #undef EX
  #undef VRD
  #undef KRD
  #undef STEP
  #undef ENDW
  {auto rr=__builtin_amdgcn_permlane32_swap(__float_as_uint(l_reg),__float_as_uint(l_reg),false,false);l_reg=__uint_as_float(rr[0])+__uint_as_float(rr[1]);}
  if(hi==0)wsf[32+r32]=l_reg;asm volatile("s_waitcnt lgkmcnt(0)":::"memory");
  float rli[16];
  #pragma unroll
  for(int r=0;r<16;++r)rli[r]=__builtin_amdgcn_rcpf(wsf[32+crow(r,hi)]);
  bf16*Ow=O+(rowbase+q0+wid*QBLK)*OPITCH+OCOL0+h*D;
  { bf16*stg=(bf16*)(shm+LDS_OST)+wid*2048;
    #pragma unroll
    for(int r=0;r<16;++r){const int orow=crow(r,hi);
      #pragma unroll
      for(int d0=0;d0<2;++d0)stg[orow*64+d0*32+r32]=__float2bfloat16(o[d0][r]*rli[r]);}
    asm volatile("s_waitcnt lgkmcnt(0)":::"memory");
    #pragma unroll
    for(int i=0;i<4;++i){const int row=i*8+(lane>>3),ch=lane&7; const u32x4 v=*(const u32x4*)(stg+row*64+ch*8); ATTN_STORE16(Ow+(long)row*OPITCH+ch*8,v);} }
  asm volatile("s_waitcnt lgkmcnt(0)\n\ts_barrier":::"memory");
  #undef DMA_K
  #undef DMA_V
  #undef DMA_KM
  #undef DMA_VM
  #undef CBIAS
  #undef CMASK
  #undef START
  #undef RESC
  #undef ROT
}
constexpr int ATTN_LDS_BYTES=LDS_BYTES;
struct AttnTensors { const bf16* Q; const bf16* K; const bf16* V; bf16* O; const float* NCL; };
struct AttnUnit { int bh; int qb; };
struct StaticOrder {
  int vcu;
  __device__ __forceinline__ explicit StaticOrder(int grid,int block):vcu((block%8)*(grid/8)+block/8){}
  __device__ __forceinline__ bool next(int i,AttnUnit&u)const{ if(i>=2)return false; const int s=vcu&15; u.bh=vcu>>4; u.qb=(i==0)?s:31-s; return true; }
  __device__ __forceinline__ void a_ready(const AttnUnit&)const{}
  __device__ __forceinline__ void done(const AttnUnit&)const{}
};
template<class Sched,int THRL=8> __device__ __forceinline__ void attn_phase(char*lds,const AttnTensors&T,const Sched&S){
  AttnUnit u;
  for(int i=0;S.next(i,u);++i){ S.a_ready(u); attn_unit<THRL>(u.bh/NHEAD,u.bh%NHEAD,u.qb,T.Q,T.K,T.V,T.O,T.NCL+(long)u.bh*BIASN,lds); S.done(u); }
}
#undef SBAR
#undef WAIT_BAR
}
#define GAS __attribute__((address_space(1)))
#define LAS __attribute__((address_space(3)))
typedef unsigned short bf16;
typedef unsigned v4u __attribute__((ext_vector_type(4)));
typedef float f32x4 __attribute__((ext_vector_type(4)));
typedef short bf16x8 __attribute__((ext_vector_type(8)));
typedef GAS unsigned gu32;
typedef GAS unsigned long long gu64;
#define RLX_AGENT __ATOMIC_RELAXED, __HIP_MEMORY_SCOPE_AGENT
#define LDS_WAIT() asm volatile("s_waitcnt lgkmcnt(0)" ::: "memory")
#define VM_WAIT() asm volatile("s_waitcnt vmcnt(0)" ::: "memory")
__device__ __forceinline__ unsigned long long rt() { return __builtin_amdgcn_s_memrealtime(); }
__device__ __forceinline__ unsigned f2bf(float f) { unsigned u = __builtin_bit_cast(unsigned, f); return (u + 0x7fffu + ((u >> 16) & 1u)) >> 16; }
__device__ __forceinline__ unsigned pk2(float lo, float hi) { return f2bf(lo) | (f2bf(hi) << 16); }

#define XB_TMO      128
#define XB_XCNT(j)  (256  + 64 * (j))
#define XB_XSUB(j)  (1280 + 64 * (j))
#define XB_XGEN(j)  (2304 + 64 * (j))
#define XB_TOP      3328
#define XB_TOPGEN   3392
#define XCD_BAR_WORDS 3456
#define XB_SPIN_CAP (1u << 18)

__device__ __forceinline__ unsigned xb_ld(unsigned* p)              { return __hip_atomic_load(p, __ATOMIC_RELAXED, __HIP_MEMORY_SCOPE_AGENT); }
__device__ __forceinline__ unsigned xb_add(unsigned* p, unsigned v) { return __hip_atomic_fetch_add(p, v, __ATOMIC_RELAXED, __HIP_MEMORY_SCOPE_AGENT); }
__device__ __forceinline__ unsigned xb_xcc_id() { return (unsigned)__builtin_amdgcn_s_getreg((3 << 11) | 20) & 0xFu; }
#define XB_SPIN(cond, bar) do { unsigned _sp = 0; while (cond) { __builtin_amdgcn_s_sleep(1); \
    if ((++_sp & 255u) == 0u) { if (xb_ld(&(bar)[XB_TMO])) break; if (_sp > XB_SPIN_CAP) { atomicAdd(&(bar)[XB_TMO], 1u); break; } } } } while (0)

struct XcdBarrier {
    unsigned* bar; unsigned x;
    volatile LAS unsigned* st;
};

__device__ __forceinline__ XcdBarrier xcd_barrier_post(unsigned* bar, volatile LAS unsigned* st) {
    XcdBarrier b; b.bar = bar; b.x = xb_xcc_id(); b.st = st;
    if (threadIdx.x == 0) (void)xb_add(&bar[XB_XCNT(b.x)], 1u);
    return b;
}
__device__ __forceinline__ void xcd_barrier_complete(unsigned* bar, unsigned x, unsigned& nloc, unsigned& nx) {
    const unsigned G = gridDim.x * gridDim.y * gridDim.z;
    unsigned sum, cnt, mine, sp = 0u;
    for (;;) {
        sum = 0u; cnt = 0u; mine = 0u;
#pragma unroll
        for (unsigned j = 0; j < 16; ++j) { const unsigned c = xb_ld(&bar[XB_XCNT(j)]); sum += c; cnt += (c > 0u) ? 1u : 0u; mine = (j == x) ? c : mine; }
        if (sum == G) break;
        __builtin_amdgcn_s_sleep(1);
        if ((++sp & 255u) == 0u) { if (xb_ld(&bar[XB_TMO])) break; if (sp > XB_SPIN_CAP) { atomicAdd(&bar[XB_TMO], 1u); break; } }
    }
    nloc = mine > 0u ? mine : 1u; nx = cnt > 0u ? cnt : 1u;
}

__device__ __forceinline__ void xcd_barrier(const XcdBarrier& b) {
    asm volatile("s_waitcnt vmcnt(0)" ::: "memory");
    __syncthreads();
    if (threadIdx.x == 0) {
        unsigned* bar = b.bar;
        __builtin_amdgcn_s_waitcnt(0);
        unsigned nloc = b.st[0], nx = b.st[1];
        if (nloc == 0u) { xcd_barrier_complete(bar, b.x, nloc, nx); b.st[0] = nloc; b.st[1] = nx; }
        const unsigned old = xb_add(&bar[XB_XSUB(b.x)], 1u);
        const unsigned gen = old / nloc;
        if (old + 1u == (gen + 1u) * nloc) {
            __builtin_amdgcn_fence(__ATOMIC_RELEASE, "agent");
            asm volatile("s_waitcnt vmcnt(0)" ::: "memory");
            const unsigned og = xb_add(&bar[XB_TOP], 1u);
            const unsigned tg = og / nx;
            if (og + 1u == (tg + 1u) * nx) xb_add(&bar[XB_TOPGEN], 1u);
            else XB_SPIN(xb_ld(&bar[XB_TOPGEN]) == tg, bar);
            __builtin_amdgcn_fence(__ATOMIC_ACQUIRE, "agent");
            xb_add(&bar[XB_XGEN(b.x)], 1u);
            asm volatile("s_waitcnt vmcnt(0)" ::: "memory");
        } else {
            XB_SPIN(xb_ld(&bar[XB_XGEN(b.x)]) == gen, bar);
            __builtin_amdgcn_fence(__ATOMIC_ACQUIRE, "agent");
            asm volatile("s_waitcnt vmcnt(0)" ::: "memory");
        }
    }
    __syncthreads();
}

constexpr int NWAVES = 8, NTHR = NWAVES * 64;
constexpr int DMOD = 1024, TREAL = 8192, NBATCH = 2, NMETA = 16, TPOS = TREAL + NMETA, NSAMP = 32;
constexpr int M_REAL = NBATCH * TREAL, ROW_META = M_REAL, ROW_SAMP = ROW_META + NMETA, M_VALID = ROW_SAMP + NSAMP, M_PAD = 16640;
constexpr int DSHIFT = 1792, DIN = 5384, N1 = 5376, DR = 512, NH = 8, HD = 64, FF = 4096, DG = 2048;
constexpr int COL_Q = 1792, COL_K = 2304, COL_V = 2816, COL_F = 3328, COL_G = 3328;
constexpr int NPAGES = 64, PAGE = 128, NSPLIT = 8;
constexpr float RMS_EPS = 1e-6f, GN_EPS = 64e-5f, LOG2E = 1.4426950408889634f;
constexpr size_t O_YP = 0, O_YS = O_YP + (size_t)M_REAL * DMOD, O_SHP = O_YS + (size_t)NSAMP * DMOD, O_WKVP = O_SHP + 2 * DSHIFT, O_KP = O_WKVP + 2 * 8 * 64 * 64,
                 O_VP = O_KP + (size_t)2 * TPOS * 512, O_LFP = O_VP + (size_t)2 * TPOS * 512, O_SHS = O_LFP + (size_t)2 * TPOS * 8, O_WKVS = O_SHS + (size_t)NSAMP * DSHIFT,
                 O_KS = O_WKVS + (size_t)NSAMP * 8 * 64 * 64, O_VS = O_KS + NSAMP * 512, O_LFS = O_VS + NSAMP * 512, O_END = O_LFS + NSAMP * 8;
static_assert(O_END == 34959360, "d_out size");
constexpr size_t MiB = 1u << 20;
constexpr size_t al(size_t x) { return (x + MiB - 1) / MiB * MiB; }
constexpr size_t WS_CTL = 0, CTL_ZERO_BYTES = 1 * MiB;
constexpr size_t WS_WIN = 1 * MiB;
constexpr size_t WS_WBR = WS_WIN + al((size_t)N1 * 1024 * 2);
constexpr size_t WS_WOUT = WS_WBR + 2 * MiB;
constexpr size_t WS_WUP = WS_WOUT + 2 * MiB;
constexpr size_t WS_WDN = WS_WUP + 8 * MiB;
constexpr size_t WS_HN = WS_WDN + 8 * MiB;
constexpr size_t WS_UR = WS_HN + al((size_t)M_PAD * 1024 * 2);
constexpr size_t WS_QB = WS_UR + al((size_t)M_PAD * DSHIFT * 4);
constexpr size_t WS_KB = WS_QB + al((size_t)M_PAD * 512 * 2);
constexpr size_t WS_VB = WS_KB + al((size_t)M_PAD * 512 * 2);
constexpr size_t WS_GB = WS_VB + al((size_t)M_PAD * 512 * 2);
constexpr size_t WS_OC = WS_GB + al((size_t)M_PAD * DG * 2);
constexpr size_t WS_LF = WS_OC + al((size_t)M_PAD * 1024 * 2);
constexpr size_t WS_NCL = WS_LF + al((size_t)M_PAD * 8 * 4);
constexpr size_t WS_PR = WS_NCL + 1 * MiB;
constexpr size_t PSTRIDE = al((size_t)M_PAD * 512 * 4);
constexpr size_t WS_Y = WS_PR + 7 * PSTRIDE;
constexpr size_t WS_TMP = WS_Y + PSTRIDE;
constexpr size_t WS_MG = WS_TMP + al((size_t)M_PAD * 1024 * 4);
constexpr size_t WS_X1 = WS_MG + al((size_t)M_PAD * 1024 * 2);
constexpr size_t WS_HF = WS_X1 + al((size_t)M_PAD * 1024 * 4);
constexpr size_t WS_QS = WS_HF + al((size_t)M_PAD * FF * 2);
constexpr size_t WS_PART = WS_QS + 1 * MiB;
constexpr size_t WS_END = WS_PART + 1 * MiB;
constexpr int CW_BAR = 4096;
constexpr int CW_ZERO = 65536;
constexpr int RING_OFF = 0, RING_BYTES = 131072, LDSCTL_OFF = RING_BYTES, MISC_OFF = LDSCTL_OFF + 320, LDS_BYTES = 147456;

typedef unsigned v2u __attribute__((ext_vector_type(2)));
__device__ __forceinline__ float bflo(unsigned w) { return __uint_as_float(w << 16); }
__device__ __forceinline__ float bfhi(unsigned w) { return __uint_as_float(w & 0xffff0000u); }
__device__ __forceinline__ float wave_sum(float v) {
#pragma unroll
    for (int o = 1; o < 64; o <<= 1) v += __shfl_xor(v, o);
    return v;
}
__device__ __forceinline__ float wave_max(float v) {
#pragma unroll
    for (int o = 1; o < 64; o <<= 1) v = fmaxf(v, __shfl_xor(v, o));
    return v;
}
__device__ __forceinline__ float sigmoidf_(float x) { return 1.0f / (1.0f + __expf(-x)); }

struct Args { const float* in[30]; float* out; unsigned char* ws; };

struct Frame {
    LAS unsigned char* lds;
    volatile LAS unsigned* MISC;
    gu32* ctl;
    int vcu, G;
    const float* in[30]; float* out; unsigned char* ws;
};
#define INP(i) (F.in[i])
enum { I_XP = 0, I_XS, I_SSHIFT, I_SWKV, I_CK, I_CV, I_CLF, I_PT, I_META, I_NMIX, I_WIN, I_MU, I_W0, I_WDEC, I_A0, I_WA, I_WG, I_KK, I_KA, I_RK, I_LNW, I_LNB, I_BF, I_WBR, I_WBF, I_WOUT, I_NFFN, I_WUP, I_WDN, I_NFIN };

__device__ __forceinline__ const float* xrow(const Frame& F, int m) {
    if (m < M_REAL) return F.in[I_XP] + (size_t)m * DMOD;
    if (m < ROW_SAMP) return F.in[I_META] + (size_t)(m - ROW_META) * DMOD;
    if (m < M_VALID) return F.in[I_XS] + (size_t)(m - ROW_SAMP) * DMOD;
    return nullptr;
}

__device__ __forceinline__ void p0_transpose_item(const float* W, int ldw, int nblk, int K, bf16* WT, int ldt, int row_off, int col_off, LAS float* scr, int item, int lane) {
    const int kb = item / nblk, nb = item % nblk, k0 = 64 * kb, n0 = 32 * nb;
#pragma unroll 8
    for (int i = 0; i < 32; ++i) { const int kk = 2 * i + (lane >> 5); scr[kk * 33 + (lane & 31)] = W[(size_t)(k0 + kk) * ldw + n0 + (lane & 31)]; }
    LDS_WAIT(); asm volatile("" ::: "memory");
    const int c = lane & 7;
#pragma unroll
    for (int j = 0; j < 4; ++j) { const int n = (lane >> 3) + 8 * j; const LAS float* s = scr + (8 * c) * 33 + n;
        v4u o; o.x = pk2(s[0 * 33], s[1 * 33]); o.y = pk2(s[2 * 33], s[3 * 33]); o.z = pk2(s[4 * 33], s[5 * 33]); o.w = pk2(s[6 * 33], s[7 * 33]);
        *(GAS v4u*)(WT + (size_t)(row_off + n0 + n) * ldt + col_off + k0 + 8 * c) = o; }
    LDS_WAIT(); asm volatile("" ::: "memory");
    (void)K;
}
__device__ __forceinline__ float log_sigmoid_(float z) { return fminf(z, 0.f) - log1pf(expf(-fabsf(z))); }

__device__ __forceinline__ void p0_prologue(Frame& F) {
    const int tid_ = tid_fresh(), lane_ = tid_ & 63, wave_ = __builtin_amdgcn_readfirstlane(tid_ >> 6); (void)lane_; (void)wave_;
    LAS float* scr = (LAS float*)(F.lds + RING_OFF + wave_ * 16384);
    const int gw = F.vcu * NWAVES + wave_, NGW = F.G * NWAVES;
    unsigned char* ws = F.ws;
    constexpr int I_A = 16 * 104, I_B = 16 * 64, I_BR = 8 * 32, I_O = 16 * 32, I_U = 16 * 128, I_D = 64 * 32;
    constexpr int NITEMS = I_A + I_B + 2 * I_BR + I_O + I_U + I_D;
    for (int it = gw; it < NITEMS; it += NGW) {
        int r = it;
        if (r < I_A) { p0_transpose_item(INP(I_WIN), DIN, 104, 1024, (bf16*)(ws + WS_WIN), 1024, 0, 0, scr, r, lane_); continue; } r -= I_A;
        if (r < I_B) { p0_transpose_item(INP(I_WIN) + (COL_F + 8), DIN, 64, 1024, (bf16*)(ws + WS_WIN), 1024, COL_G, 0, scr, r, lane_); continue; } r -= I_B;
        if (r < I_BR) { p0_transpose_item(INP(I_WBR), 1024, 32, 512, (bf16*)(ws + WS_WBR), 1024, 0, 0, scr, r, lane_); continue; } r -= I_BR;
        if (r < I_BR) { p0_transpose_item(INP(I_WBF), 1024, 32, 512, (bf16*)(ws + WS_WBR), 1024, 0, 512, scr, r, lane_); continue; } r -= I_BR;
        if (r < I_O) { p0_transpose_item(INP(I_WOUT), 1024, 32, 1024, (bf16*)(ws + WS_WOUT), 1024, 0, 0, scr, r, lane_); continue; } r -= I_O;
        if (r < I_U) { p0_transpose_item(INP(I_WUP), FF, 128, 1024, (bf16*)(ws + WS_WUP), 1024, 0, 0, scr, r, lane_); continue; } r -= I_U;
        p0_transpose_item(INP(I_WDN), 1024, 32, FF, (bf16*)(ws + WS_WDN), FF, 0, 0, scr, r, lane_);
    }
    __syncthreads();
    LAS float* WF = (LAS float*)(F.lds + RING_OFF);
    for (int e = tid_; e < 8 * 1024; e += NTHR) { const int k = e >> 3, j = e & 7; WF[j * 1024 + k] = INP(I_NMIX)[k] * INP(I_WIN)[(size_t)k * DIN + COL_F + j]; }
    __syncthreads();
    f32x4 gm[4];
#pragma unroll
    for (int j = 0; j < 4; ++j) gm[j] = *((const GAS f32x4*)INP(I_NMIX) + lane_ + 64 * j);
    const float bfv = INP(I_BF)[lane_ & 7];
    bf16* HN = (bf16*)(ws + WS_HN); float* LF = (float*)(ws + WS_LF);
    for (int m = gw; m < M_PAD; m += NGW) {
        const float* xr_ = xrow(F, m);
        GAS unsigned long long* o8 = (GAS unsigned long long*)(HN + (size_t)m * DMOD) + lane_;
        if (xr_ == nullptr) {
#pragma unroll
            for (int j = 0; j < 4; ++j) o8[64 * j] = 0ull;
            if (lane_ < 8) LF[(size_t)m * 8 + lane_] = 0.f;
            continue;
        }
        const GAS f32x4* xr = (const GAS f32x4*)xr_ + lane_;
        f32x4 v[4]; float s2 = 0.f;
#pragma unroll
        for (int j = 0; j < 4; ++j) { v[j] = xr[64 * j]; s2 += (v[j].x * v[j].x + v[j].y * v[j].y) + (v[j].z * v[j].z + v[j].w * v[j].w); }
        const float rstd = 1.0f / sqrtf(wave_sum(s2) * (1.f / DMOD) + RMS_EPS);
        float fa[8];
#pragma unroll
        for (int q = 0; q < 8; ++q) { float a = 0.f;
#pragma unroll
            for (int j = 0; j < 4; ++j) { const f32x4 w = *((const LAS f32x4*)(WF + q * 1024) + lane_ + 64 * j); a += (v[j].x * w.x + v[j].y * w.y) + (v[j].z * w.z + v[j].w * w.w); }
            fa[q] = wave_sum(a); }
        float mine = fa[0];
#pragma unroll
        for (int q = 1; q < 8; ++q) mine = ((lane_ & 7) == q) ? fa[q] : mine;
        const float lf = log_sigmoid_(mine * rstd + bfv);
        if (lane_ < 8) {
            LF[(size_t)m * 8 + lane_] = lf;
            if (m < M_REAL) F.out[O_LFP + ((size_t)(m >> 13) * TPOS + NMETA + (m & 8191)) * 8 + lane_] = lf;
            else if (m < ROW_SAMP) { F.out[O_LFP + (size_t)(m - ROW_META) * 8 + lane_] = lf; F.out[O_LFP + ((size_t)TPOS + (m - ROW_META)) * 8 + lane_] = lf; }
            else F.out[O_LFS + (size_t)(m - ROW_SAMP) * 8 + lane_] = lf;
        }
#pragma unroll
        for (int j = 0; j < 4; ++j) { const f32x4 h = v[j] * rstd * gm[j]; o8[64 * j] = (unsigned long long)pk2(h.x, h.y) | ((unsigned long long)pk2(h.z, h.w) << 32); }
    }
}

__device__ __forceinline__ void p1_cumsum(Frame& F, int bh) {
    const int tid_ = tid_fresh(), lane_ = tid_ & 63, wave_ = __builtin_amdgcn_readfirstlane(tid_ >> 6); (void)lane_; (void)wave_;
    const float* LF = (const float*)(F.ws + WS_LF); float* NCL = (float*)(F.ws + WS_NCL) + (size_t)bh * attn_body::BIASN;
    const int b = bh >> 3, h = bh & 7; constexpr int PER = 17;
    LAS float* wt = (LAS float*)(F.lds + RING_OFF);
    const int i0 = tid_ * PER;
    float s = 0.f;
    for (int i = 0; i < PER; ++i) { const int p = i0 + i; if (p < TPOS) { const int row = p < NMETA ? ROW_META + p : b * TREAL + (p - NMETA); s += LF[(size_t)row * 8 + h]; } }
    float inc = s;
#pragma unroll
    for (int o = 1; o < 64; o <<= 1) { const float t = __shfl_up(inc, o); if (lane_ >= o) inc += t; }
    if (lane_ == 63) wt[wave_] = inc;
    __syncthreads();
    float base = inc - s;
    for (int w = 0; w < wave_; ++w) base += wt[w];
    float c = base;
    for (int i = 0; i < PER; ++i) { const int p = i0 + i; if (p < TPOS) { const int row = p < NMETA ? ROW_META + p : b * TREAL + (p - NMETA); c += LF[(size_t)row * 8 + h];
        NCL[p < NMETA ? p : 128 + (p - NMETA)] = -c * LOG2E; } }
    if (tid_ >= 16 && tid_ < 128) NCL[tid_] = -1e30f;
    __syncthreads();
}

namespace pg8 {
struct EpiIn {
    static constexpr bool PERM = true, AFTER_DRAIN = false;
    float* UR; bf16_t* QB; bf16_t* KB; bf16_t* VB; bf16_t* GB; float* QS; float* out;
    __device__ __forceinline__ void operator()(const f32x4 (&acc)[2][2][4][2], const Unit& u, int wr, int wc, int fr, int fq) const {
        const int row0 = u.pm * BM + wr * 64 + fr, col0 = u.pn * BM + wc * 32 + 8 * fq; const int pn = u.pn;
#pragma unroll
        for (int ai = 0; ai < 2; ++ai)
#pragma unroll
            for (int m = 0; m < 4; ++m) { const int r = row0 + ai * HALF + m * 16;
#pragma unroll
                for (int bj = 0; bj < 2; ++bj) { const int c = col0 + bj * HALF; const f32x4 v0 = acc[ai][bj][m][0], v1 = acc[ai][bj][m][1];
                    if (pn < 7) {
                        float* p = UR + (size_t)r * DSHIFT + c; *(f32x4*)p = v0; *(f32x4*)(p + 4) = v1;
                        if (r == TREAL - 1 || r == M_REAL - 1) { float* q = out + O_SHP + (size_t)(r >> 13) * DSHIFT + c; *(f32x4*)q = v0; *(f32x4*)(q + 4) = v1; }
                        if (r >= ROW_SAMP && r < M_VALID) { float* q = out + O_SHS + (size_t)(r - ROW_SAMP) * DSHIFT + c; *(f32x4*)q = v0; *(f32x4*)(q + 4) = v1; }
                    } else if (pn < 9) {
                        const int cc = c - COL_Q; const float sc = attn_body::C2;
                        u32x4 w; w.x = cvt_pk_bf16(v0[0] * sc, v0[1] * sc); w.y = cvt_pk_bf16(v0[2] * sc, v0[3] * sc); w.z = cvt_pk_bf16(v1[0] * sc, v1[1] * sc); w.w = cvt_pk_bf16(v1[2] * sc, v1[3] * sc);
                        *(u32x4*)(QB + (size_t)r * 512 + cc) = w;
                        if (r >= ROW_SAMP && r < M_VALID) { float* q = QS + (size_t)(r - ROW_SAMP) * 512 + cc; *(f32x4*)q = v0; *(f32x4*)(q + 4) = v1; }
                    } else if (pn < 13) {
                        const bool isk = pn < 11; const int cc = c - (isk ? COL_K : COL_V);
                        u32x4 w; w.x = cvt_pk_bf16(v0[0], v0[1]); w.y = cvt_pk_bf16(v0[2], v0[3]); w.z = cvt_pk_bf16(v1[0], v1[1]); w.w = cvt_pk_bf16(v1[2], v1[3]);
                        *(u32x4*)((isk ? KB : VB) + (size_t)r * 512 + cc) = w;
                        float* op = out + (isk ? O_KP : O_VP); float* os = out + (isk ? O_KS : O_VS);
                        if (r < M_REAL) { float* q = op + ((size_t)(r >> 13) * TPOS + NMETA + (r & 8191)) * 512 + cc; *(f32x4*)q = v0; *(f32x4*)(q + 4) = v1; }
                        else if (r < ROW_SAMP) { float* q = op + (size_t)(r - ROW_META) * 512 + cc; *(f32x4*)q = v0; *(f32x4*)(q + 4) = v1; q += (size_t)TPOS * 512; *(f32x4*)q = v0; *(f32x4*)(q + 4) = v1; }
                        else if (r < M_VALID) { float* q = os + (size_t)(r - ROW_SAMP) * 512 + cc; *(f32x4*)q = v0; *(f32x4*)(q + 4) = v1; }
                    } else {
                        const int cc = c - COL_G;
                        u32x4 w; w.x = cvt_pk_bf16(sigmoidf_(v0[0]), sigmoidf_(v0[1])); w.y = cvt_pk_bf16(sigmoidf_(v0[2]), sigmoidf_(v0[3]));
                        w.z = cvt_pk_bf16(sigmoidf_(v1[0]), sigmoidf_(v1[1])); w.w = cvt_pk_bf16(sigmoidf_(v1[2]), sigmoidf_(v1[3]));
                        *(u32x4*)(GB + (size_t)r * DG + cc) = w;
                    }
                } }
    }
};
struct EpiBrA {
    static constexpr bool PERM = true, AFTER_DRAIN = false;
    float* TMP; const bf16_t* GB;
    __device__ __forceinline__ void operator()(const f32x4 (&acc)[2][2][4][2], const Unit& u, int wr, int wc, int fr, int fq) const {
        const int row0 = u.pm * BM + wr * 64 + fr, col0 = u.pn * BM + wc * 32 + 8 * fq;
#pragma unroll
        for (int ai = 0; ai < 2; ++ai)
#pragma unroll
            for (int m = 0; m < 4; ++m) { const int r = row0 + ai * HALF + m * 16;
#pragma unroll
                for (int bj = 0; bj < 2; ++bj) { const int c = col0 + bj * HALF; const f32x4 v0 = acc[ai][bj][m][0], v1 = acc[ai][bj][m][1];
                    const u32x4 g = *(const u32x4*)(GB + (size_t)r * DG + c);
                    f32x4 o0 = {v0[0] * bflo(g.x), v0[1] * bfhi(g.x), v0[2] * bflo(g.y), v0[3] * bfhi(g.y)}, o1 = {v1[0] * bflo(g.z), v1[1] * bfhi(g.z), v1[2] * bflo(g.w), v1[3] * bfhi(g.w)};
                    float* p = TMP + (size_t)r * 1024 + c; *(f32x4*)p = o0; *(f32x4*)(p + 4) = o1; } }
    }
};
struct EpiBrB {
    static constexpr bool PERM = true, AFTER_DRAIN = false;
    const float* TMP; const bf16_t* GB; bf16_t* MG;
    __device__ __forceinline__ void operator()(const f32x4 (&acc)[2][2][4][2], const Unit& u, int wr, int wc, int fr, int fq) const {
        const int row0 = u.pm * BM + wr * 64 + fr, col0 = u.pn * BM + wc * 32 + 8 * fq;
#pragma unroll
        for (int ai = 0; ai < 2; ++ai)
#pragma unroll
            for (int m = 0; m < 4; ++m) { const int r = row0 + ai * HALF + m * 16;
#pragma unroll
                for (int bj = 0; bj < 2; ++bj) { const int c = col0 + bj * HALF; const f32x4 v0 = acc[ai][bj][m][0], v1 = acc[ai][bj][m][1];
                    const u32x4 g = *(const u32x4*)(GB + (size_t)r * DG + 1024 + c);
                    const float* p = TMP + (size_t)r * 1024 + c; const f32x4 t0 = *(const f32x4*)p, t1 = *(const f32x4*)(p + 4);
                    u32x4 w; w.x = cvt_pk_bf16(t0[0] + v0[0] * bflo(g.x), t0[1] + v0[1] * bfhi(g.x)); w.y = cvt_pk_bf16(t0[2] + v0[2] * bflo(g.y), t0[3] + v0[3] * bfhi(g.y));
                    w.z = cvt_pk_bf16(t1[0] + v1[0] * bflo(g.z), t1[1] + v1[1] * bfhi(g.z)); w.w = cvt_pk_bf16(t1[2] + v1[2] * bflo(g.w), t1[3] + v1[3] * bfhi(g.w));
                    *(u32x4*)(MG + (size_t)r * 1024 + c) = w; } }
    }
};
template <bool ADD> struct EpiRes {
    static constexpr bool PERM = true, AFTER_DRAIN = false;
    float* X1; const float* xp; const float* xm; const float* xs;
    __device__ __forceinline__ void operator()(const f32x4 (&acc)[2][2][4][2], const Unit& u, int wr, int wc, int fr, int fq) const {
        const int row0 = u.pm * BM + wr * 64 + fr, col0 = u.pn * BM + wc * 32 + 8 * fq;
#pragma unroll
        for (int ai = 0; ai < 2; ++ai)
#pragma unroll
            for (int m = 0; m < 4; ++m) { const int r = row0 + ai * HALF + m * 16;
                const float* xr; if (ADD) xr = X1 + (size_t)r * 1024; else xr = r < M_REAL ? xp + (size_t)r * 1024 : r < ROW_SAMP ? xm + (size_t)(r - ROW_META) * 1024 : r < M_VALID ? xs + (size_t)(r - ROW_SAMP) * 1024 : nullptr;
#pragma unroll
                for (int bj = 0; bj < 2; ++bj) { const int c = col0 + bj * HALF; f32x4 v0 = acc[ai][bj][m][0], v1 = acc[ai][bj][m][1];
                    if (xr) { v0 += *(const f32x4*)(xr + c); v1 += *(const f32x4*)(xr + c + 4); }
                    float* p = X1 + (size_t)r * 1024 + c; *(f32x4*)p = v0; *(f32x4*)(p + 4) = v1; } }
    }
};
struct EpiUp {
    static constexpr bool PERM = true, AFTER_DRAIN = false;
    bf16_t* HF;
    __device__ __forceinline__ void operator()(const f32x4 (&acc)[2][2][4][2], const Unit& u, int wr, int wc, int fr, int fq) const {
        const int row0 = u.pm * BM + wr * 64 + fr, col0 = u.pn * BM + wc * 32 + 8 * fq;
#pragma unroll
        for (int ai = 0; ai < 2; ++ai)
#pragma unroll
            for (int m = 0; m < 4; ++m) { const int r = row0 + ai * HALF + m * 16;
#pragma unroll
                for (int bj = 0; bj < 2; ++bj) { const int c = col0 + bj * HALF; f32x4 v0 = acc[ai][bj][m][0], v1 = acc[ai][bj][m][1];
                    v0 = __builtin_elementwise_max(v0, (f32x4){0.f, 0.f, 0.f, 0.f}); v1 = __builtin_elementwise_max(v1, (f32x4){0.f, 0.f, 0.f, 0.f}); v0 = v0 * v0; v1 = v1 * v1;
                    u32x4 w; w.x = cvt_pk_bf16(v0[0], v0[1]); w.y = cvt_pk_bf16(v0[2], v0[3]); w.z = cvt_pk_bf16(v1[0], v1[1]); w.w = cvt_pk_bf16(v1[2], v1[3]);
                    *(u32x4*)(HF + (size_t)r * FF + c) = w; } }
    }
};
}

__device__ __forceinline__ const float* prev_row(const Frame& F, const float* UR, int row) {
    if (row < M_REAL) return (row & 8191) ? UR + (size_t)(row - 1) * DSHIFT : UR + (size_t)(ROW_SAMP - 1) * DSHIFT;
    if (row < ROW_SAMP) return row > ROW_META ? UR + (size_t)(row - 1) * DSHIFT : (const float*)(F.ctl + CW_ZERO);
    return F.in[I_SSHIFT] + (size_t)(row - ROW_SAMP) * DSHIFT;
}
__device__ __forceinline__ void p2_prep(Frame& F) {
    const int tid_ = tid_fresh(), lane_ = tid_ & 63, wave_ = __builtin_amdgcn_readfirstlane(tid_ >> 6); (void)lane_; (void)wave_;
    const float* UR = (const float*)(F.ws + WS_UR);
    float* PR = (float*)(F.ws + WS_PR); constexpr size_t PS = PSTRIDE / 4;
    LAS float* ACT = (LAS float*)(F.lds + RING_OFF);
    const int c = tid_;
    const float* mu = INP(I_MU);
    const float mu_r = mu[c], mu_k = mu[512 + c], mu_v = mu[1024 + c];
    const float w0 = INP(I_W0)[c], a0 = INP(I_A0)[c], kkc = INP(I_KK)[c], kac = INP(I_KA)[c];
    const float* Wd = INP(I_WDEC) + c; const float* Wa = INP(I_WA) + c; const float* Wg = INP(I_WG) + c;
    constexpr int NTILE = M_VALID / 16;
    for (int tl = F.vcu; tl < NTILE; tl += F.G) {
        const int r0 = tl * 16;
        __syncthreads();
#pragma unroll
        for (int i = 0; i < 8; ++i) { const int e = tid_ + NTHR * i, rr = e >> 8, k = e & 255, row = r0 + rr;
            const float* cur = UR + (size_t)row * DSHIFT + 1536 + k; const float* prv = prev_row(F, UR, row) + 1536 + k;
            const float u = *cur, us = u + mu[1536 + k] * (*prv - u);
            ACT[k * 16 + rr] = k < 64 ? tanhf(us) : k < 128 ? us : sigmoidf_(us); }
        __syncthreads();
        float aw[16], aa[16], ag[16];
#pragma unroll
        for (int i = 0; i < 16; ++i) { aw[i] = 0.f; aa[i] = 0.f; ag[i] = 0.f; }
        for (int k = 0; k < 64; ++k) { const float wd = Wd[(size_t)k * 512], wa = Wa[(size_t)k * 512];
#pragma unroll
            for (int q = 0; q < 4; ++q) { const f32x4 x = *(const LAS f32x4*)(ACT + k * 16 + 4 * q), y = *(const LAS f32x4*)(ACT + (64 + k) * 16 + 4 * q);
                aw[4 * q] += x[0] * wd; aw[4 * q + 1] += x[1] * wd; aw[4 * q + 2] += x[2] * wd; aw[4 * q + 3] += x[3] * wd;
                aa[4 * q] += y[0] * wa; aa[4 * q + 1] += y[1] * wa; aa[4 * q + 2] += y[2] * wa; aa[4 * q + 3] += y[3] * wa; } }
        for (int k = 0; k < 128; ++k) { const float wg = Wg[(size_t)k * 512];
#pragma unroll
            for (int q = 0; q < 4; ++q) { const f32x4 x = *(const LAS f32x4*)(ACT + (128 + k) * 16 + 4 * q);
                ag[4 * q] += x[0] * wg; ag[4 * q + 1] += x[1] * wg; ag[4 * q + 2] += x[2] * wg; ag[4 * q + 3] += x[3] * wg; } }
#pragma unroll
        for (int i = 0; i < 16; ++i) { const int row = r0 + i;
            const float* cur = UR + (size_t)row * DSHIFT + c; const float* prv = prev_row(F, UR, row) + c;
            const float ur = cur[0], uk = cur[512], uv = cur[1024];
            const float r = ur + mu_r * (prv[0] - ur), k = uk + mu_k * (prv[512] - uk), v = uv + mu_v * (prv[1024] - uv);
            const float x = w0 + aw[i];
            const float sp = fmaxf(-x, 0.f) + log1pf(expf(-fabsf(x)));
            const float dec = expf(-expf(-sp - 0.5f));
            const float a = sigmoidf_(a0 + aa[i]);
            float kk = k * kkc; const float nrm = sqrtf(wave_sum(kk * kk)); kk = kk / fmaxf(nrm, 1e-12f);
            const float k2 = k * (1.0f + (a - 1.0f) * kac);
            const size_t o = (size_t)row * 512 + c;
            PR[o] = r; PR[PS + o] = dec; PR[2 * PS + o] = k2; PR[3 * PS + o] = v; PR[4 * PS + o] = kk; PR[5 * PS + o] = kk * a; PR[6 * PS + o] = ag[i]; }
    }
    __syncthreads();
}

__device__ __forceinline__ void p2_meta_attn(Frame& F) {
    const int tid_ = tid_fresh(), lane_ = tid_ & 63, wave_ = __builtin_amdgcn_readfirstlane(tid_ >> 6); (void)lane_; (void)wave_;
    const bf16* QB = (const bf16*)(F.ws + WS_QB); const bf16* KB = (const bf16*)(F.ws + WS_KB); const bf16* VB = (const bf16*)(F.ws + WS_VB); bf16* OC = (bf16*)(F.ws + WS_OC);
    const float* NCL = (const float*)(F.ws + WS_NCL);
    const int h = wave_, i = lane_ & 15, part = lane_ >> 4;
    float q[16];
    { const v4u* qp = (const v4u*)(QB + (size_t)(ROW_META + i) * 512 + h * 64 + part * 16); const v4u a = qp[0], b = qp[1];
      q[0] = bflo(a.x); q[1] = bfhi(a.x); q[2] = bflo(a.y); q[3] = bfhi(a.y); q[4] = bflo(a.z); q[5] = bfhi(a.z); q[6] = bflo(a.w); q[7] = bfhi(a.w);
      q[8] = bflo(b.x); q[9] = bfhi(b.x); q[10] = bflo(b.y); q[11] = bfhi(b.y); q[12] = bflo(b.z); q[13] = bfhi(b.z); q[14] = bflo(b.w); q[15] = bfhi(b.w); }
    float s[16]; const float nci = NCL[(size_t)h * attn_body::BIASN + i];
#pragma unroll
    for (int j = 0; j < 16; ++j) { const v4u* kp = (const v4u*)(KB + (size_t)(ROW_META + j) * 512 + h * 64 + part * 16); const v4u a = kp[0], b = kp[1];
        float d = q[0] * bflo(a.x) + q[1] * bfhi(a.x) + q[2] * bflo(a.y) + q[3] * bfhi(a.y) + q[4] * bflo(a.z) + q[5] * bfhi(a.z) + q[6] * bflo(a.w) + q[7] * bfhi(a.w)
                + q[8] * bflo(b.x) + q[9] * bfhi(b.x) + q[10] * bflo(b.y) + q[11] * bfhi(b.y) + q[12] * bflo(b.z) + q[13] * bfhi(b.z) + q[14] * bflo(b.w) + q[15] * bfhi(b.w);
        d += __shfl_xor(d, 16); d += __shfl_xor(d, 32);
        s[j] = (j <= i) ? d + NCL[(size_t)h * attn_body::BIASN + j] - nci : -INFINITY; }
    float mx = s[0];
#pragma unroll
    for (int j = 1; j < 16; ++j) mx = fmaxf(mx, s[j]);
    float l = 0.f; float o[16];
#pragma unroll
    for (int d = 0; d < 16; ++d) o[d] = 0.f;
#pragma unroll
    for (int j = 0; j < 16; ++j) { const float p = exp2f(s[j] - mx); l += p;
        const v4u* vp = (const v4u*)(VB + (size_t)(ROW_META + j) * 512 + h * 64 + part * 16); const v4u a = vp[0], b = vp[1];
        o[0] += p * bflo(a.x); o[1] += p * bfhi(a.x); o[2] += p * bflo(a.y); o[3] += p * bfhi(a.y); o[4] += p * bflo(a.z); o[5] += p * bfhi(a.z); o[6] += p * bflo(a.w); o[7] += p * bfhi(a.w);
        o[8] += p * bflo(b.x); o[9] += p * bfhi(b.x); o[10] += p * bflo(b.y); o[11] += p * bfhi(b.y); o[12] += p * bflo(b.z); o[13] += p * bfhi(b.z); o[14] += p * bflo(b.w); o[15] += p * bfhi(b.w); }
    const float rl = 1.0f / l;
    v4u w0, w1; w0.x = pk2(o[0] * rl, o[1] * rl); w0.y = pk2(o[2] * rl, o[3] * rl); w0.z = pk2(o[4] * rl, o[5] * rl); w0.w = pk2(o[6] * rl, o[7] * rl);
    w1.x = pk2(o[8] * rl, o[9] * rl); w1.y = pk2(o[10] * rl, o[11] * rl); w1.z = pk2(o[12] * rl, o[13] * rl); w1.w = pk2(o[14] * rl, o[15] * rl);
    v4u* op = (v4u*)(OC + (size_t)(ROW_META + i) * 1024 + 512 + h * 64 + part * 16); op[0] = w0; op[1] = w1;
}

constexpr int PART_STRIDE = 80;
__device__ __forceinline__ void p2_decode_split(Frame& F, int item) {
    const int tid_ = tid_fresh(), lane_ = tid_ & 63, wave_ = __builtin_amdgcn_readfirstlane(tid_ >> 6); (void)lane_; (void)wave_;
    const int bt = item >> 3, sp = item & 7, h = wave_, kq = lane_ & 15, g = lane_ >> 4;
    const float* QS = (const float*)(F.ws + WS_QS); float* PART = (float*)(F.ws + WS_PART) + (size_t)((bt * NSPLIT + sp) * NH + h) * PART_STRIDE;
    const int* PT = (const int*)INP(I_PT);
    f32x4 q4 = *(const f32x4*)(QS + (size_t)bt * 512 + h * 64 + 4 * kq); q4 = q4 * 0.125f;
    float m = -1e30f, l = 0.f, csum = 0.f; f32x4 o4 = {0.f, 0.f, 0.f, 0.f};
    for (int pg = 0; pg < 8; ++pg) {
        const int page = PT[bt * NPAGES + sp * 8 + pg];
        const float* Kp = INP(I_CK) + (size_t)page * (PAGE * 512) + h * 64 + 4 * kq; const float* Vp = INP(I_CV) + (size_t)page * (PAGE * 512) + h * 64 + 4 * kq;
        const float* LFp = INP(I_CLF) + (size_t)page * (PAGE * 8) + h;
#pragma unroll 1
        for (int ch = 0; ch < 2; ++ch) {
            const int pos0 = ch * 64;
            f32x4 kx[16], vx[16];
#pragma unroll
            for (int i = 0; i < 16; ++i) kx[i] = __builtin_nontemporal_load((const f32x4*)(Kp + (size_t)(pos0 + 4 * i + g) * 512));
            const float lfv = LFp[(size_t)(pos0 + lane_) * 8];
#pragma unroll
            for (int i = 0; i < 16; ++i) vx[i] = __builtin_nontemporal_load((const f32x4*)(Vp + (size_t)(pos0 + 4 * i + g) * 512));
            float smine = 0.f;
#pragma unroll
            for (int i = 0; i < 16; ++i) { float d = (kx[i][0] * q4[0] + kx[i][1] * q4[1]) + (kx[i][2] * q4[2] + kx[i][3] * q4[3]);
                d += __shfl_xor(d, 1); d += __shfl_xor(d, 2); d += __shfl_xor(d, 4); d += __shfl_xor(d, 8);
                smine = (kq == i) ? d : smine; }
            float inc = lfv;
#pragma unroll
            for (int o = 1; o < 64; o <<= 1) { const float t = __shfl_up(inc, o); if (lane_ >= o) inc += t; }
            const float cpos = __shfl(inc, 4 * kq + g), ctot = __shfl(inc, 63);
            const float s = smine - (csum + cpos);
            csum += ctot;
            const float mc = wave_max(s), mn = fmaxf(m, mc), alpha = __expf(m - mn), p = __expf(s - mn);
            l = l * alpha + wave_sum(p); m = mn; o4 = o4 * alpha;
#pragma unroll
            for (int i = 0; i < 16; ++i) { const float pi = __shfl(p, g * 16 + i); o4 += vx[i] * pi; }
        }
    }
#pragma unroll
    for (int e = 0; e < 4; ++e) { float t = o4[e]; t += __shfl_xor(t, 16); t += __shfl_xor(t, 32); o4[e] = t; }
    if (g == 0) *(f32x4*)(PART + 16 + 4 * kq) = o4;
    if (lane_ == 0) { PART[0] = m; PART[1] = l; PART[2] = csum; }
}

template <int CTRL> __device__ __forceinline__ float dpp_f(float x) { return __builtin_bit_cast(float, __builtin_amdgcn_update_dpp(0, __builtin_bit_cast(int, x), CTRL, 0xF, 0xF, true)); }
__device__ __forceinline__ float red16(float x) {
    x += dpp_f<0xB1>(x); x += dpp_f<0x4E>(x); x += dpp_f<0x141>(x); x += dpp_f<0x128>(x); return x;
}
constexpr int SCAN_BLK = 32, SCAN_STEP_F = 384, SCAN_BUF_F = SCAN_BLK * SCAN_STEP_F;
__device__ __forceinline__ int scan_row(int b, int s) { return s < NMETA ? ROW_META + s : b * TREAL + (s - NMETA); }
__device__ __forceinline__ void p2_scan_prompt(Frame& F, int item) {
    const int tid_ = tid_fresh(), lane_ = tid_ & 63, wave_ = __builtin_amdgcn_readfirstlane(tid_ >> 6); (void)lane_; (void)wave_;
    const int bh = item >> 2, b = bh >> 3, h = bh & 7, qd = item & 3;
    const float* PR = (const float*)(F.ws + WS_PR); constexpr size_t PS = PSTRIDE / 4;
    float* Y = (float*)(F.ws + WS_Y);
    LAS float* buf = (LAS float*)(F.lds + RING_OFF);
    constexpr int NBLK = (TPOS + SCAN_BLK - 1) / SCAN_BLK;
    const int lt = tid_ - 256;
#define SCAN_LOAD(blk) do { if (wave_ >= 4) { LAS float* dst = buf + ((blk) & 1) * SCAN_BUF_F; const int s0 = (blk) * SCAN_BLK; \
        _Pragma("unroll") for (int i = 0; i < 12; ++i) { const int e = lt + 256 * i, st = e / 96, rem = e - st * 96, vec = rem >> 4, q4 = rem & 15; const int s = s0 + st; \
            if (s < TPOS) { const size_t po = vec == 0 ? 4 * PS : vec == 1 ? PS : vec == 2 ? 5 * PS : vec == 3 ? 2 * PS : vec == 4 ? 0 : 3 * PS; \
                const f32x4 x = *(const f32x4*)(PR + po + (size_t)scan_row(b, s) * 512 + h * 64 + 4 * q4); *(LAS f32x4*)(dst + st * SCAN_STEP_F + vec * 64 + 4 * q4) = x; } } } } while (0)
    __syncthreads();
    SCAN_LOAD(0);
    __syncthreads();
    const int j = lane_ >> 4, kq = lane_ & 15, vrow = qd * 16 + wave_ * 4 + j;
    f32x4 S = {0.f, 0.f, 0.f, 0.f};
    for (int blk = 0; blk < NBLK; ++blk) {
        if (blk + 1 < NBLK) SCAN_LOAD(blk + 1);
        if (wave_ < 4) {
            const LAS float* src = buf + (blk & 1) * SCAN_BUF_F; const int s0 = blk * SCAN_BLK; const int ns = (TPOS - s0) < SCAN_BLK ? (TPOS - s0) : SCAN_BLK;
            for (int st = 0; st < ns; ++st) {
                const LAS float* p = src + st * SCAN_STEP_F;
                const f32x4 kk4 = *(const LAS f32x4*)(p + 4 * kq), w4 = *(const LAS f32x4*)(p + 64 + 4 * kq), b4 = *(const LAS f32x4*)(p + 128 + 4 * kq),
                            k4 = *(const LAS f32x4*)(p + 192 + 4 * kq), r4 = *(const LAS f32x4*)(p + 256 + 4 * kq);
                const float vv = p[320 + vrow];
                float u = (S[0] * kk4[0] + S[1] * kk4[1]) + (S[2] * kk4[2] + S[3] * kk4[3]);
                u = red16(u);
                S = S * w4 + k4 * vv - b4 * u;
                float y = (S[0] * r4[0] + S[1] * r4[1]) + (S[2] * r4[2] + S[3] * r4[3]);
                y = red16(y);
                if (kq == 0) Y[(size_t)scan_row(b, s0 + st) * 512 + h * 64 + vrow] = y;
            }
        }
        __syncthreads();
    }
    if (wave_ < 4) *(f32x4*)(F.out + O_WKVP + ((size_t)(bh * 64 + vrow) * 64 + 4 * kq)) = S;
#undef SCAN_LOAD
}
__device__ __forceinline__ void p2_scan_sample(Frame& F, int item) {
    const int tid_ = tid_fresh(), lane_ = tid_ & 63, wave_ = __builtin_amdgcn_readfirstlane(tid_ >> 6); (void)lane_; (void)wave_;
    const int bt = item >> 3, h = item & 7, v = tid_ >> 3, k8 = tid_ & 7;
    const float* PR = (const float*)(F.ws + WS_PR); constexpr size_t PS = PSTRIDE / 4;
    float* Y = (float*)(F.ws + WS_Y);
    const size_t ro = (size_t)(ROW_SAMP + bt) * 512 + h * 64, so = ((size_t)(bt * 8 + h) * 64 + v) * 64 + 8 * k8;
    const float vv = PR[3 * PS + ro + v];
    float u = 0.f; f32x4 S[2];
#pragma unroll
    for (int e = 0; e < 2; ++e) { S[e] = *(const f32x4*)(INP(I_SWKV) + so + 4 * e); const f32x4 kk4 = *(const f32x4*)(PR + 4 * PS + ro + 8 * k8 + 4 * e);
        u += (S[e][0] * kk4[0] + S[e][1] * kk4[1]) + (S[e][2] * kk4[2] + S[e][3] * kk4[3]); }
    u += __shfl_xor(u, 1); u += __shfl_xor(u, 2); u += __shfl_xor(u, 4);
    float y = 0.f;
#pragma unroll
    for (int e = 0; e < 2; ++e) { const f32x4 w4 = *(const f32x4*)(PR + PS + ro + 8 * k8 + 4 * e), b4 = *(const f32x4*)(PR + 5 * PS + ro + 8 * k8 + 4 * e),
                                              k4 = *(const f32x4*)(PR + 2 * PS + ro + 8 * k8 + 4 * e), r4 = *(const f32x4*)(PR + ro + 8 * k8 + 4 * e);
        S[e] = S[e] * w4 + k4 * vv - b4 * u;
        y += (S[e][0] * r4[0] + S[e][1] * r4[1]) + (S[e][2] * r4[2] + S[e][3] * r4[3]);
        *(f32x4*)(F.out + O_WKVS + so + 4 * e) = S[e]; }
    y += __shfl_xor(y, 1); y += __shfl_xor(y, 2); y += __shfl_xor(y, 4);
    if (k8 == 0) Y[ro + v] = y;
}

__device__ __forceinline__ void p2_post(Frame& F) {
    const int tid_ = tid_fresh(), lane_ = tid_ & 63, wave_ = __builtin_amdgcn_readfirstlane(tid_ >> 6); (void)lane_; (void)wave_;
    const float* PR = (const float*)(F.ws + WS_PR); constexpr size_t PS = PSTRIDE / 4;
    const float* Y = (const float*)(F.ws + WS_Y); bf16* OC = (bf16*)(F.ws + WS_OC);
    const int c = tid_;
    const float lw = INP(I_LNW)[c], lb = INP(I_LNB)[c], rk = INP(I_RK)[c];
    for (int row = F.vcu; row < M_VALID; row += F.G) {
        const size_t o = (size_t)row * 512 + c;
        const float y = Y[o], r = PR[o], k = PR[2 * PS + o], v = PR[3 * PS + o], g = PR[6 * PS + o];
        const float mu = wave_sum(y) * (1.f / 64.f), d = y - mu, var = wave_sum(d * d) * (1.f / 64.f);
        const float yn = d * (1.0f / sqrtf(var + GN_EPS)) * lw + lb;
        const float bonus = wave_sum(r * k * rk) * v;
        const float ov = (yn + bonus) * g;
        const float on = __shfl_down(ov, 1);
        if ((lane_ & 1) == 0) *(unsigned*)(OC + (size_t)row * 1024 + c) = pk2(ov, on);
    }
}
__device__ __forceinline__ void p2_decode_combine(Frame& F, int bt) {
    const int tid_ = tid_fresh(), lane_ = tid_ & 63, wave_ = __builtin_amdgcn_readfirstlane(tid_ >> 6); (void)lane_; (void)wave_;
    const int h = wave_, d = lane_;
    const float* QS = (const float*)(F.ws + WS_QS); const float* PART = (const float*)(F.ws + WS_PART) + (size_t)(bt * NSPLIT * NH + h) * PART_STRIDE;
    const float* LF = (const float*)(F.ws + WS_LF); bf16* OC = (bf16*)(F.ws + WS_OC);
    const float kn = F.out[O_KS + (size_t)bt * 512 + h * 64 + d], vn = F.out[O_VS + (size_t)bt * 512 + h * 64 + d], qn = QS[(size_t)bt * 512 + h * 64 + d];
    const float snew = wave_sum(qn * kn) * 0.125f;
    float off = LF[(size_t)(ROW_SAMP + bt) * 8 + h];
    float Ms[NSPLIT]; float M = snew;
#pragma unroll
    for (int sp = NSPLIT - 1; sp >= 0; --sp) { const float* P = PART + (size_t)sp * NH * PART_STRIDE; Ms[sp] = P[0] + P[2] + off; off += P[2]; M = fmaxf(M, Ms[sp]); }
    float w = __expf(snew - M), L = w, o = w * vn;
#pragma unroll
    for (int sp = 0; sp < NSPLIT; ++sp) { const float* P = PART + (size_t)sp * NH * PART_STRIDE; w = __expf(Ms[sp] - M); L += w * P[1]; o += w * P[16 + d]; }
    const float ov = o / L, on = __shfl_down(ov, 1);
    if ((d & 1) == 0) *(unsigned*)(OC + (size_t)(ROW_SAMP + bt) * 1024 + 512 + h * 64 + d) = pk2(ov, on);
}

__device__ __forceinline__ void p3_norm_ffn(Frame& F) {
    const int tid_ = tid_fresh(), lane_ = tid_ & 63, wave_ = __builtin_amdgcn_readfirstlane(tid_ >> 6); (void)lane_; (void)wave_;
    const int gw = F.vcu * NWAVES + wave_, NGW = F.G * NWAVES;
    const float* X1 = (const float*)(F.ws + WS_X1); bf16* HN = (bf16*)(F.ws + WS_HN);
    f32x4 gm[4];
#pragma unroll
    for (int j = 0; j < 4; ++j) gm[j] = *((const GAS f32x4*)INP(I_NFFN) + lane_ + 64 * j);
    for (int m = gw; m < M_VALID; m += NGW) {
        const GAS f32x4* xr = (const GAS f32x4*)(X1 + (size_t)m * DMOD) + lane_;
        f32x4 v[4]; float s2 = 0.f;
#pragma unroll
        for (int j = 0; j < 4; ++j) { v[j] = xr[64 * j]; s2 += (v[j].x * v[j].x + v[j].y * v[j].y) + (v[j].z * v[j].z + v[j].w * v[j].w); }
        const float rstd = 1.0f / sqrtf(wave_sum(s2) * (1.f / DMOD) + RMS_EPS);
        GAS unsigned long long* o8 = (GAS unsigned long long*)(HN + (size_t)m * DMOD) + lane_;
#pragma unroll
        for (int j = 0; j < 4; ++j) { const f32x4 h = v[j] * rstd * gm[j]; o8[64 * j] = (unsigned long long)pk2(h.x, h.y) | ((unsigned long long)pk2(h.z, h.w) << 32); }
    }
}
__device__ __forceinline__ void p6_norm_final(Frame& F) {
    const int tid_ = tid_fresh(), lane_ = tid_ & 63, wave_ = __builtin_amdgcn_readfirstlane(tid_ >> 6); (void)lane_; (void)wave_;
    const int gw = F.vcu * NWAVES + wave_, NGW = F.G * NWAVES;
    const float* X1 = (const float*)(F.ws + WS_X1);
    f32x4 gm[4];
#pragma unroll
    for (int j = 0; j < 4; ++j) gm[j] = *((const GAS f32x4*)INP(I_NFIN) + lane_ + 64 * j);
    for (int m = gw; m < M_VALID; m += NGW) {
        if (m >= M_REAL && m < ROW_SAMP) continue;
        const GAS f32x4* xr = (const GAS f32x4*)(X1 + (size_t)m * DMOD) + lane_;
        f32x4 v[4]; float s2 = 0.f;
#pragma unroll
        for (int j = 0; j < 4; ++j) { v[j] = xr[64 * j]; s2 += (v[j].x * v[j].x + v[j].y * v[j].y) + (v[j].z * v[j].z + v[j].w * v[j].w); }
        const float rstd = 1.0f / sqrtf(wave_sum(s2) * (1.f / DMOD) + RMS_EPS);
        GAS f32x4* o = (GAS f32x4*)(F.out + (m < M_REAL ? O_YP + (size_t)m * DMOD : O_YS + (size_t)(m - ROW_SAMP) * DMOD)) + lane_;
#pragma unroll
        for (int j = 0; j < 4; ++j) o[64 * j] = v[j] * rstd * gm[j];
    }
}

__global__ void __launch_bounds__(NTHR, 2) fwd_kernel(Args args) {
    extern __shared__ __attribute__((aligned(16))) unsigned char lds[];
    Frame F;
    F.lds = (LAS unsigned char*)lds;
    F.MISC = (volatile LAS unsigned*)(F.lds + MISC_OFF);
    F.G = gridDim.x; { const int bx = blockIdx.x; F.vcu = (F.G % 8 == 0) ? (bx % 8) * (F.G / 8) + bx / 8 : bx; }
    F.ws = args.ws; F.out = args.out; F.ctl = (gu32*)(args.ws + WS_CTL);
#pragma unroll
    for (int i = 0; i < 30; ++i) F.in[i] = args.in[i];
    for (int u = threadIdx.x; u < (LDS_BYTES - LDSCTL_OFF) / 4; u += NTHR) ((LAS unsigned*)(F.lds + LDSCTL_OFF))[u] = 0u;
    __syncthreads();
    XcdBarrier bar = xcd_barrier_post((unsigned*)(F.ctl + CW_BAR), F.MISC + 8);
    unsigned char* ws = args.ws;
    using namespace pg8;

    p0_prologue(F);
    xcd_barrier(bar);

    if (blockIdx.x < 16) p1_cumsum(F, blockIdx.x);
    {
        Gemm g{(const bf16_t*)(ws + WS_HN), (const bf16_t*)(ws + WS_WIN), M_PAD, N1, 1024, 1024}; StaticOrder S; S.init(M_PAD, N1, F.G, (int)blockIdx.x);
        EpiIn E{(float*)(ws + WS_UR), (bf16_t*)(ws + WS_QB), (bf16_t*)(ws + WS_KB), (bf16_t*)(ws + WS_VB), (bf16_t*)(ws + WS_GB), (float*)(ws + WS_QS), F.out};
        gemm_phase<EpiIn, StaticOrder, PG8_ALIGN, PG8_SP2>(F.lds + RING_OFF, g, S, E);
    }
    xcd_barrier(bar);

    p2_prep(F);
    {
        const attn_body::AttnTensors AT{(const attn_body::bf16*)(ws + WS_QB), (const attn_body::bf16*)(ws + WS_KB), (const attn_body::bf16*)(ws + WS_VB), (attn_body::bf16*)(ws + WS_OC), (const float*)(ws + WS_NCL)};
        const attn_body::StaticOrder S((int)F.G, (int)blockIdx.x);
        attn_body::attn_phase<attn_body::StaticOrder>((char*)lds + RING_OFF, AT, S);
    }
    if (F.vcu == F.G - 1) p2_meta_attn(F);
    for (int it = F.vcu; it < NSAMP * NSPLIT; it += F.G) p2_decode_split(F, it);
    xcd_barrier(bar);

    if (F.vcu < 64) p2_scan_prompt(F, F.vcu);
    else for (int it = F.vcu - 64; it < NSAMP * NH; it += F.G - 64) p2_scan_sample(F, it);
    xcd_barrier(bar);

    p2_post(F);
    if (F.vcu < NSAMP) p2_decode_combine(F, F.vcu);
    xcd_barrier(bar);

    {
        Gemm g{(const bf16_t*)(ws + WS_OC), (const bf16_t*)(ws + WS_WBR), M_PAD, 1024, 512, 1024}; StaticOrder S; S.init(M_PAD, 1024, F.G, (int)blockIdx.x);
        EpiBrA E{(float*)(ws + WS_TMP), (const bf16_t*)(ws + WS_GB)};
        gemm_phase<EpiBrA, StaticOrder, PG8_ALIGN, PG8_SP2>(F.lds + RING_OFF, g, S, E);
    }
    {
        Gemm g{(const bf16_t*)(ws + WS_OC) + 512, (const bf16_t*)(ws + WS_WBR) + 512, M_PAD, 1024, 512, 1024}; StaticOrder S; S.init(M_PAD, 1024, F.G, (int)blockIdx.x);
        EpiBrB E{(const float*)(ws + WS_TMP), (const bf16_t*)(ws + WS_GB), (bf16_t*)(ws + WS_MG)};
        gemm_phase<EpiBrB, StaticOrder, PG8_ALIGN, PG8_SP2>(F.lds + RING_OFF, g, S, E);
    }
    xcd_barrier(bar);

    {
        Gemm g{(const bf16_t*)(ws + WS_MG), (const bf16_t*)(ws + WS_WOUT), M_PAD, 1024, 1024, 1024}; StaticOrder S; S.init(M_PAD, 1024, F.G, (int)blockIdx.x);
        EpiRes<false> E{(float*)(ws + WS_X1), INP(I_XP), INP(I_META), INP(I_XS)};
        gemm_phase<EpiRes<false>, StaticOrder, PG8_ALIGN, PG8_SP2>(F.lds + RING_OFF, g, S, E);
    }
    xcd_barrier(bar);

    p3_norm_ffn(F);
    xcd_barrier(bar);

    {
        Gemm g{(const bf16_t*)(ws + WS_HN), (const bf16_t*)(ws + WS_WUP), M_PAD, FF, 1024, 1024}; StaticOrder S; S.init(M_PAD, FF, F.G, (int)blockIdx.x);
        EpiUp E{(bf16_t*)(ws + WS_HF)};
        gemm_phase<EpiUp, StaticOrder, PG8_ALIGN, PG8_SP2>(F.lds + RING_OFF, g, S, E);
    }
    xcd_barrier(bar);

    {
        Gemm g{(const bf16_t*)(ws + WS_HF), (const bf16_t*)(ws + WS_WDN), M_PAD, 1024, FF, FF}; StaticOrder S; S.init(M_PAD, 1024, F.G, (int)blockIdx.x);
        EpiRes<true> E{(float*)(ws + WS_X1), nullptr, nullptr, nullptr};
        gemm_phase<EpiRes<true>, StaticOrder, PG8_ALIGN, PG8_SP2>(F.lds + RING_OFF, g, S, E);
    }
    xcd_barrier(bar);

    p6_norm_final(F);
}

extern "C" void kernel_launch(void* const* d_in, const int* in_sizes, int n_in, void* d_out, int out_size, void* d_ws, size_t ws_size, hipStream_t stream) {
    static int grid = 0;
    if (grid == 0) {
        if (n_in != 30 || (size_t)out_size != O_END || ws_size < WS_END) { fprintf(stderr, "kernel_launch: unexpected sizes: n_in %d out %d ws %zu (need %zu)\n", n_in, out_size, ws_size, (size_t)WS_END); grid = -1; return; }
        int dev = 0, cus = 0, per_cu = 0;
        if (hipGetDevice(&dev) != hipSuccess || hipDeviceGetAttribute(&cus, hipDeviceAttributeMultiprocessorCount, dev) != hipSuccess) { grid = -1; return; }
        if (hipFuncSetAttribute((const void*)fwd_kernel, hipFuncAttributeMaxDynamicSharedMemorySize, LDS_BYTES) != hipSuccess) { fprintf(stderr, "kernel_launch: hipFuncSetAttribute failed\n"); grid = -1; return; }
        if (hipOccupancyMaxActiveBlocksPerMultiprocessor(&per_cu, (const void*)fwd_kernel, NTHR, LDS_BYTES) != hipSuccess || per_cu < 1) { fprintf(stderr, "kernel_launch: occupancy query says %d\n", per_cu); }
        (void)hipGetLastError();
        grid = cus;
        if (grid != 256) fprintf(stderr, "kernel_launch: grid %d (built for 256)\n", grid);
    }
    if (grid < 0) return;
    (void)in_sizes;
    if (hipMemsetAsync((char*)d_ws + WS_CTL, 0, CTL_ZERO_BYTES, stream) != hipSuccess) return;
    Args a{};
    for (int i = 0; i < 30; ++i) a.in[i] = (const float*)d_in[i];
    a.out = (float*)d_out; a.ws = (unsigned char*)d_ws;
    hipLaunchKernelGGL(fwd_kernel, dim3(grid), dim3(NTHR), LDS_BYTES, stream, a);
}
```

```cpp
#include <hip/hip_runtime.h>
#include <hip/hip_bf16.h>
#include <cstdio>
#include <cstdint>
#include <cmath>
__device__ __forceinline__ int tid_fresh() { int t = (int)threadIdx.x; asm volatile("" : "+v"(t)); return t; }
namespace pg8 {
#define PG8_LAS __attribute__((address_space(3)))
typedef unsigned short bf16_t;
typedef short bf16x8 __attribute__((ext_vector_type(8)));
typedef float f32x4 __attribute__((ext_vector_type(4)));
typedef unsigned u32x4 __attribute__((ext_vector_type(4)));
constexpr int BM = 256, BK = 64, HALF = 128, HTB = HALF * BK * 2  , STAGE_BYTES = 8 * HTB, NXCD = 8, WGM = 8;

__host__ __device__ __forceinline__ int lds_byte(int r, int c) { const int st = (r >> 4) * 2 + (c >> 5), rr = r & 15, cc = c & 31, ob = rr * 64 + cc * 2; return st * 1024 + (ob ^ (((ob >> 9) & 1) << 5)); }
__host__ __device__ __forceinline__ void stage_rc(int b, int& R, int& C) { const int st = b / 1024, sb = b % 1024, swz = sb ^ (((sb >> 9) & 1) << 5); R = (st >> 1) * 16 + swz / 64; C = (st & 1) * 32 + (swz % 64) / 2; }
__host__ __device__ __forceinline__ int perm32(int rho) { const int n = rho >> 4, i = rho & 15; return 8 * (i >> 2) + 4 * n + (i & 3); }

struct Unit { int pm, pn; };
struct Gemm { const bf16_t* A; const bf16_t* Bt; int M, N, K, ld; };

struct StaticOrder {
    int nM, nN, nwg, G, c;
    __host__ __device__ void init(int M, int N, int G_, int c_) { nM = M / BM; nN = N / BM; nwg = nM * nN; G = G_; c = c_; }
    __host__ __device__ bool next(int i, Unit& u) const {
        const long L = (long)i * G + c; if (L >= nwg) return false;
        int wgid = (int)L; { const int q = nwg / NXCD, r = nwg % NXCD, xcd = wgid % NXCD, off = wgid / NXCD; wgid = (xcd < r ? xcd * (q + 1) : r * (q + 1) + (xcd - r) * q) + off; }
        const int nig = WGM * nN, gid = wgid / nig, fm = gid * WGM, gsz = (nM - fm) < WGM ? (nM - fm) : WGM;
        u.pm = fm + ((wgid % nig) % gsz); u.pn = (wgid % nig) / gsz; return true;
    }
    __device__ __forceinline__ void a_ready(const Unit&) const {}
    __device__ __forceinline__ void done(const Unit&) const {}
};

typedef float f32x2c __attribute__((ext_vector_type(2))); typedef __bf16 bf16x2c __attribute__((ext_vector_type(2)));
__device__ __forceinline__ unsigned cvt_pk_bf16(float lo, float hi) { const f32x2c v = {lo, hi}; return __builtin_bit_cast(unsigned, __builtin_convertvector(v, bf16x2c)); }
typedef float f32x2 __attribute__((ext_vector_type(2)));
template <class Epi, class Sched, bool ALIGN_EPI = false, bool SP2 = false>
__device__ __forceinline__ void gemm_phase(PG8_LAS unsigned char* lds, const Gemm g, const Sched& S, const Epi& E) {
    const int tid = tid_fresh(), wid = __builtin_amdgcn_readfirstlane(tid >> 6), lane = tid & 63, wr = wid >> 2, wc = wid & 3, fr = lane & 15, fq = lane >> 4;
    const int K = g.K, nt = K / BK, LD = g.ld;
    unsigned voffA[2], voffB[2];
#pragma unroll
    for (int i = 0; i < 2; ++i) { int R, C; stage_rc(tid * 16 + i * 8192, R, C); const int Rb = Epi::PERM ? ((R & ~31) + perm32(R & 31)) : R;
        voffA[i] = (unsigned)(R * LD + C) * 2u; voffB[i] = (unsigned)(Rb * LD + C) * 2u; }
    const size_t kstep = (size_t)(BK * 2);
    const size_t hstep = (size_t)HALF * LD * 2;
    const size_t tstep = 2 * hstep;
    const unsigned ldsw = (unsigned)wid * 1024u;
    const int aoff = lds_byte(wr * 64 + fr, fq * 8), boff = lds_byte(wc * 32 + fr, fq * 8);
#define PG8_SA(b, h) (((b) * 2 + (h)) * HTB)
#define PG8_SB(b, h) ((4 + (b) * 2 + (h)) * HTB)
#define PG8_STAGE(bufoff, gbase, voff) do { _Pragma("unroll") for (int _i = 0; _i < 2; ++_i) \
        __builtin_amdgcn_global_load_lds((const unsigned*)((const char*)(gbase) + (voff)[_i]), (PG8_LAS unsigned*)(lds + (bufoff) + ldsw + _i * 8192), 16, 0, 0); } while (0)
#define PG8_LDA(dst, b, h) do { _Pragma("unroll") for (int m = 0; m < 4; ++m) _Pragma("unroll") for (int k = 0; k < 2; ++k) dst[m][k] = *(const PG8_LAS bf16x8*)(lds + PG8_SA(b, h) + aoff + m * 2048 + k * 1024); } while (0)
#define PG8_LDB(dst, b, h) do { _Pragma("unroll") for (int n = 0; n < 2; ++n) _Pragma("unroll") for (int k = 0; k < 2; ++k) dst[n][k] = *(const PG8_LAS bf16x8*)(lds + PG8_SB(b, h) + boff + n * 2048 + k * 1024); } while (0)
#define PG8_MMA(ai, bj, At, Bt) do { __builtin_amdgcn_s_setprio(1); _Pragma("unroll") for (int m = 0; m < 4; ++m) _Pragma("unroll") for (int n = 0; n < 2; ++n) _Pragma("unroll") for (int k = 0; k < 2; ++k) \
        acc[ai][bj][m][n] = __builtin_amdgcn_mfma_f32_16x16x32_bf16(Bt[n][k], At[m][k], acc[ai][bj][m][n], 0, 0, 0); __builtin_amdgcn_s_setprio(0); } while (0)
#define PG8_WAIT_V(n) asm volatile("s_waitcnt vmcnt(" #n ")" ::: "memory")
#define PG8_WAIT_L(n) asm volatile("s_waitcnt lgkmcnt(" #n ")" ::: "memory")
#define PG8_BAR __builtin_amdgcn_s_barrier()
#define PG8_SCHED __builtin_amdgcn_sched_barrier(0)
    Unit cur, nxt; int ui = 0;
    if (!S.next(0, cur)) return;
    f32x4 acc[2][2][4][2];
#pragma unroll
    for (int a = 0; a < 2; ++a)
#pragma unroll
        for (int b = 0; b < 2; ++b)
#pragma unroll
            for (int m = 0; m < 4; ++m)
#pragma unroll
                for (int n = 0; n < 2; ++n) acc[a][b][m][n] = (f32x4){0.f, 0.f, 0.f, 0.f};
    bf16x8 At[4][2], B0[2][2], B1[2][2];
    const char* cA = (const char*)g.A + (size_t)cur.pm * tstep; const char* cB = (const char*)g.Bt + (size_t)cur.pn * tstep;
    S.a_ready(cur);
    if constexpr (SP2) {
        PG8_STAGE(PG8_SB(0, 0), cB, voffB); PG8_STAGE(PG8_SB(0, 1), cB + hstep, voffB); PG8_STAGE(PG8_SA(0, 0), cA, voffA); PG8_STAGE(PG8_SA(0, 1), cA + hstep, voffA);
        if (wr == 1) PG8_BAR;
        PG8_WAIT_V(2); PG8_BAR;
        PG8_STAGE(PG8_SB(1, 0), cB + kstep, voffB); PG8_STAGE(PG8_SA(1, 0), cA + kstep, voffA); PG8_STAGE(PG8_SB(1, 1), cB + hstep + kstep, voffB);
        PG8_WAIT_V(6); PG8_BAR;
    } else {
        PG8_STAGE(PG8_SB(0, 0), cB, voffB); PG8_STAGE(PG8_SA(0, 0), cA, voffA); PG8_STAGE(PG8_SB(0, 1), cB + hstep, voffB); PG8_STAGE(PG8_SA(0, 1), cA + hstep, voffA);
        if (wr == 1) PG8_BAR;
        PG8_WAIT_V(4); PG8_BAR;
        PG8_STAGE(PG8_SB(1, 0), cB + kstep, voffB); PG8_STAGE(PG8_SA(1, 0), cA + kstep, voffA); PG8_STAGE(PG8_SB(1, 1), cB + hstep + kstep, voffB);
        PG8_WAIT_V(6); PG8_BAR;
    }
    for (;;) {
        const bool has_next = S.next(ui + 1, nxt);
        const char* nA = has_next ? (const char*)g.A + (size_t)nxt.pm * tstep : cA; const char* nB = has_next ? (const char*)g.Bt + (size_t)nxt.pn * tstep : cB;
        for (int t = 0; t < nt; t += 2) {
            const bool last = (t == nt - 2);
            const char* a1 = cA + (size_t)(t + 1) * kstep;
            const char* a2 = last ? nA : cA + (size_t)(t + 2) * kstep; const char* b2 = last ? nB : cB + (size_t)(t + 2) * kstep;
            const char* a3 = a2 + kstep; const char* b3 = b2 + kstep;
            if (last && has_next) S.a_ready(nxt);
            if constexpr (SP2) {
            PG8_LDB(B0, 0, 0); PG8_LDB(B1, 0, 1); PG8_SCHED; PG8_LDA(At, 0, 0); PG8_STAGE(PG8_SA(1, 1), a1 + hstep, voffA);
            PG8_WAIT_V(8); PG8_WAIT_L(0); PG8_BAR; PG8_MMA(0, 0, At, B0); PG8_MMA(0, 1, At, B1); PG8_BAR; PG8_SCHED;
            PG8_LDA(At, 0, 1); PG8_STAGE(PG8_SB(0, 0), b2, voffB); PG8_STAGE(PG8_SB(0, 1), b2 + hstep, voffB); PG8_STAGE(PG8_SA(0, 0), a2, voffA);
            PG8_WAIT_V(8); PG8_WAIT_L(0); PG8_BAR; PG8_MMA(1, 0, At, B0); PG8_MMA(1, 1, At, B1); PG8_BAR; PG8_SCHED;
            PG8_LDB(B0, 1, 0); PG8_LDB(B1, 1, 1); PG8_SCHED; PG8_LDA(At, 1, 0); PG8_STAGE(PG8_SA(0, 1), a2 + hstep, voffA);
            PG8_WAIT_V(8); PG8_WAIT_L(0); PG8_BAR; PG8_MMA(0, 0, At, B0); PG8_MMA(0, 1, At, B1); PG8_BAR; PG8_SCHED;
            PG8_LDA(At, 1, 1); PG8_STAGE(PG8_SB(1, 0), b3, voffB); PG8_STAGE(PG8_SB(1, 1), b3 + hstep, voffB); PG8_STAGE(PG8_SA(1, 0), a3, voffA);
            PG8_WAIT_V(8); PG8_WAIT_L(0); PG8_BAR; PG8_MMA(1, 0, At, B0); PG8_MMA(1, 1, At, B1); PG8_BAR; PG8_SCHED;
            } else {
            PG8_LDB(B0, 0, 0); PG8_SCHED; PG8_LDA(At, 0, 0); PG8_STAGE(PG8_SA(1, 1), a1 + hstep, voffA);
            PG8_WAIT_L(8); PG8_BAR; PG8_WAIT_L(0); PG8_MMA(0, 0, At, B0); PG8_BAR; PG8_SCHED;
            PG8_LDB(B1, 0, 1); PG8_STAGE(PG8_SB(0, 0), b2, voffB);
            PG8_BAR; PG8_WAIT_L(0); PG8_MMA(0, 1, At, B1); PG8_BAR;
            PG8_LDA(At, 0, 1); PG8_STAGE(PG8_SA(0, 0), a2, voffA);
            PG8_BAR; PG8_WAIT_L(0); PG8_MMA(1, 0, At, B0); PG8_BAR; PG8_SCHED;
            PG8_STAGE(PG8_SB(0, 1), b2 + hstep, voffB);
            PG8_WAIT_V(6); PG8_BAR; PG8_MMA(1, 1, At, B1); PG8_BAR;
            PG8_LDB(B0, 1, 0); PG8_SCHED; PG8_LDA(At, 1, 0); PG8_STAGE(PG8_SA(0, 1), a2 + hstep, voffA);
            PG8_WAIT_L(8); PG8_BAR; PG8_WAIT_L(0); PG8_MMA(0, 0, At, B0); PG8_BAR; PG8_SCHED;
            PG8_LDB(B1, 1, 1); PG8_STAGE(PG8_SB(1, 0), b3, voffB);
            PG8_BAR; PG8_WAIT_L(0); PG8_MMA(0, 1, At, B1); PG8_BAR;
            PG8_LDA(At, 1, 1); PG8_STAGE(PG8_SA(1, 0), a3, voffA);
            PG8_BAR; PG8_WAIT_L(0); PG8_MMA(1, 0, At, B0); PG8_BAR; PG8_SCHED;
            PG8_STAGE(PG8_SB(1, 1), b3 + hstep, voffB);
            PG8_WAIT_V(6); PG8_BAR; PG8_MMA(1, 1, At, B1); PG8_BAR;
            }
        }
        if constexpr (ALIGN_EPI) { if (wr == 0) PG8_BAR; }
        if constexpr (!Epi::AFTER_DRAIN) { E(acc, cur, wr, wc, fr, fq); S.done(cur); }
        if (!has_next) break;
#pragma unroll
        for (int a = 0; a < 2; ++a)
#pragma unroll
            for (int b = 0; b < 2; ++b)
#pragma unroll
                for (int m = 0; m < 4; ++m)
#pragma unroll
                    for (int n = 0; n < 2; ++n) acc[a][b][m][n] = (f32x4){0.f, 0.f, 0.f, 0.f};
        cur = nxt; cA = nA; cB = nB; ++ui;
        if constexpr (ALIGN_EPI) { if (wr == 1) PG8_BAR; }
    }
    PG8_WAIT_V(0);
    if constexpr (!ALIGN_EPI) { if (wr == 0) PG8_BAR; }
    PG8_BAR;
    if constexpr (Epi::AFTER_DRAIN) { E.fused(acc, cur, wr, wc, fr, fq, lds, wid, lane); S.done(cur); }
#undef PG8_SA
#undef PG8_SB
#undef PG8_STAGE
#undef PG8_LDA
#undef PG8_LDB
#undef PG8_MMA
#undef PG8_WAIT_V
#undef PG8_WAIT_L
#undef PG8_BAR
#undef PG8_SCHED
}
}
#define PG8_SP2 true
#define PG8_ALIGN true
namespace attn_body {
using bf16=__hip_bfloat16;
using bf16x8=__attribute__((ext_vector_type(8)))short;
using s16x4=__attribute__((ext_vector_type(4)))short;
using f32x16=__attribute__((ext_vector_type(16)))float;
using u32x4=__attribute__((ext_vector_type(4)))unsigned;
using f32x4=__attribute__((ext_vector_type(4)))float;
constexpr int BATCH=2,NHEAD=8,SEQ=8192,D=64,DM=NHEAD*D,OPITCH=1024,OCOL0=512,METAROW=16384,BIASN=8320;
constexpr int NW=8,QBLK=32,QB=QBLK*NW,KVBLK=64,NQB=SEQ/QB;
constexpr int ATTN_PITCH=DM, ATTN_UNIT_ROWS=QB;
__device__ __forceinline__ int crow(int r,int hi){return (r&3)+8*(r>>2)+4*hi;}
#define SBAR() __builtin_amdgcn_sched_barrier(0)
__device__ __forceinline__ void cmask(f32x16&p0,f32x16&p1,int jb,int qrel,int hi){
  const float NEG=-INFINITY; int kb=64*jb+4*hi;
  #pragma unroll
  for(int r=0;r<16;++r){int kv=kb+(r&3)+8*(r>>2); if(kv>qrel)p0[r]=NEG; if(kv+32>qrel)p1[r]=NEG;}
}

constexpr int NSLOT=3, SLOTB=8192;
constexpr int LDS_K=0, LDS_V=NSLOT*SLOTB, LDS_WS=2*NSLOT*SLOTB, LDS_OST=LDS_WS+NW*64*4, LDS_BIAS=LDS_OST+NW*4096, LDS_BYTES=LDS_BIAS+BIASN*4;
constexpr float C2=0.125f*1.4426950408889634f;
__device__ __forceinline__ void glds16(const void*gsrc,unsigned lds_dst){unsigned keep;
  asm volatile("s_mov_b32 %0, m0\n\ts_mov_b32 m0, %2\n\ts_nop 0\n\tglobal_load_lds_dwordx4 %1, off\n\ts_mov_b32 m0, %0":"=&s"(keep):"v"(gsrc),"s"(lds_dst):"memory");}
__device__ __forceinline__ float max3f(float a,float b,float c){float r;asm("v_max3_f32 %0, %1, %2, %3":"=v"(r):"v"(a),"v"(b),"v"(c));return r;}
__device__ __forceinline__ float max2f(float a,float b){float r;asm("v_max_f32_e32 %0, %1, %2":"=v"(r):"v"(a),"v"(b));return r;}
__device__ __forceinline__ float fadd_s(float a,float b){float r;asm("v_add_f32_e32 %0, %1, %2":"=v"(r):"v"(a),"v"(b));return r;}
__device__ __forceinline__ float fsub_s(float a,float b){float r;asm("v_sub_f32_e32 %0, %1, %2":"=v"(r):"v"(a),"v"(b));return r;}
typedef float f32x2_t __attribute__((ext_vector_type(2))); typedef __bf16 bf16x2_t __attribute__((ext_vector_type(2)));
__device__ __forceinline__ unsigned cvtpk_s(float lo,float hi){f32x2_t v={lo,hi};bf16x2_t b=__builtin_convertvector(v,bf16x2_t);return __builtin_bit_cast(unsigned,b);}
#define WAIT_BAR(N) asm volatile("s_waitcnt vmcnt(" #N ") lgkmcnt(0)\n\ts_barrier":::"memory")

__device__ __forceinline__ void qkt(f32x16&p0,f32x16&p1,const char*Kslot,const bf16x8*qr,const f32x16&cb0,const f32x16&cb1,int r32,int hi){
  const char*kb=Kslot+hi*1024+r32*16;
  #pragma unroll
  for(int d0=0;d0<4;++d0){
    const bf16x8 b0=*reinterpret_cast<const bf16x8*>(kb+d0*2048);
    const bf16x8 b1=*reinterpret_cast<const bf16x8*>(kb+d0*2048+512);
    if(d0==0){p0=__builtin_amdgcn_mfma_f32_32x32x16_bf16(b0,qr[0],cb0,0,0,0);p1=__builtin_amdgcn_mfma_f32_32x32x16_bf16(b1,qr[0],cb1,0,0,0);}
    else{p0=__builtin_amdgcn_mfma_f32_32x32x16_bf16(b0,qr[d0],p0,0,0,0);p1=__builtin_amdgcn_mfma_f32_32x32x16_bf16(b1,qr[d0],p1,0,0,0);}}
}
typedef __attribute__((address_space(3))) const char* lds_cptr;
typedef short v4i16_t __attribute__((ext_vector_type(4)));
__device__ __forceinline__ void kload8(bf16x8*kf,lds_cptr kp){
  kf[0]=*(const __attribute__((address_space(3))) bf16x8*)(kp);      kf[1]=*(const __attribute__((address_space(3))) bf16x8*)(kp+512);
  kf[2]=*(const __attribute__((address_space(3))) bf16x8*)(kp+2048); kf[3]=*(const __attribute__((address_space(3))) bf16x8*)(kp+2560);
  kf[4]=*(const __attribute__((address_space(3))) bf16x8*)(kp+4096); kf[5]=*(const __attribute__((address_space(3))) bf16x8*)(kp+4608);
  kf[6]=*(const __attribute__((address_space(3))) bf16x8*)(kp+6144); kf[7]=*(const __attribute__((address_space(3))) bf16x8*)(kp+6656);
}
__device__ __forceinline__ void kload2(bf16x8*kf,lds_cptr kp,int j){ kf[2*j]=*(const __attribute__((address_space(3))) bf16x8*)(kp+j*2048); kf[2*j+1]=*(const __attribute__((address_space(3))) bf16x8*)(kp+j*2048+512); }
__device__ __forceinline__ s16x4 vtr(lds_cptr p){ return __builtin_bit_cast(s16x4,__builtin_amdgcn_ds_read_tr16_b64_v4i16((__attribute__((address_space(3))) v4i16_t*)p)); }
__device__ __forceinline__ float rowmax(const f32x16&p0,const f32x16&p1){
  float a=max3f(p0[0],p0[1],p1[0]),b=max3f(p0[2],p0[3],p1[1]);a=max3f(a,p1[2],p1[3]);
  #pragma unroll
  for(int r=4;r<16;r+=4){a=max3f(a,p0[r],p0[r+1]);b=max3f(b,p0[r+2],p0[r+3]);a=max3f(a,p1[r],p1[r+1]);b=max3f(b,p1[r+2],p1[r+3]);}
  const float m=max2f(a,b);
  auto rr=__builtin_amdgcn_permlane32_swap(__float_as_uint(m),__float_as_uint(m),false,false);
  return max2f(__uint_as_float(rr[0]),__uint_as_float(rr[1]));
}
__device__ __forceinline__ void pv(f32x16*o,int vb,bf16x8 pa0,bf16x8 pa1,bf16x8 pa2,bf16x8 pa3){
  #pragma unroll
  for(int d0=0;d0<2;++d0){s16x4 lo[4],hi[4];
    #pragma unroll
    for(int ks=0;ks<4;++ks){
      asm volatile("ds_read_b64_tr_b16 %0,%1 offset:%c2":"=&v"(lo[ks]):"v"(vb),"i"(d0*4096+ks*1024):"memory");
      asm volatile("ds_read_b64_tr_b16 %0,%1 offset:%c2":"=&v"(hi[ks]):"v"(vb),"i"(d0*4096+ks*1024+512):"memory");}
    asm volatile("s_waitcnt lgkmcnt(0)":::"memory");SBAR();
    #define PK(k) (bf16x8){lo[k][0],lo[k][1],lo[k][2],lo[k][3],hi[k][0],hi[k][1],hi[k][2],hi[k][3]}
    o[d0]=__builtin_amdgcn_mfma_f32_32x32x16_bf16(pa0,PK(0),o[d0],0,0,0);
    o[d0]=__builtin_amdgcn_mfma_f32_32x32x16_bf16(pa1,PK(1),o[d0],0,0,0);
    o[d0]=__builtin_amdgcn_mfma_f32_32x32x16_bf16(pa2,PK(2),o[d0],0,0,0);
    o[d0]=__builtin_amdgcn_mfma_f32_32x32x16_bf16(pa3,PK(3),o[d0],0,0,0);
    #undef PK
  }
}

#ifndef ATTN_STORE16
#define ATTN_STORE16(p,v) (*(u32x4*)(p)=(v))
#endif
template<int THRL> __device__ __forceinline__ void attn_unit(int b,int h,int qb,const bf16*Q,const bf16*__restrict__ K,const bf16*__restrict__ V,bf16*O,const float*__restrict__ NCL,char*shm){
  const int tid=tid_fresh(),lane=tid&63,r32=lane&31,hi=lane>>5; const int wid=__builtin_amdgcn_readfirstlane(tid>>6);
  const long rowbase=(long)b*SEQ; const int q0=qb*QB;
  const bf16*Qw=Q+(rowbase+q0+wid*QBLK)*DM+h*D;
  const bf16*Kh=K+(rowbase-128)*DM+h*D,*Vh=V+(rowbase-128)*DM+h*D;
  const bf16*Khm=K+(long)METAROW*DM+h*D,*Vhm=V+(long)METAROW*DM+h*D;
  const unsigned lds0=(unsigned)(uintptr_t)shm;
  float*wsf=(float*)(shm+LDS_WS)+wid*64;
  const bf16*ksrc=Kh+(long)lane*DM+wid*8;
  const bf16*vsrc=Vh+(long)(16*(wid&3)+(lane>>2))*DM+(wid>>2)*32+(lane&3)*8;
  const bf16*ksrcm=Khm+(long)lane*DM+wid*8;
  const bf16*vsrcm=Vhm+(long)(16*(wid&3)+(lane>>2))*DM+(wid>>2)*32+(lane&3)*8;
  const unsigned kdst=lds0+LDS_K+wid*1024, vdst=lds0+LDS_V+wid*1024;
  #define DMA_K(t,slot) glds16(ksrc+(long)(t)*KVBLK*DM,(unsigned)__builtin_amdgcn_readfirstlane(kdst+(slot)))
  #define DMA_V(t,slot) glds16(vsrc+(long)(t)*KVBLK*DM,(unsigned)__builtin_amdgcn_readfirstlane(vdst+(slot)))
  #define DMA_KM(slot) glds16(ksrcm,(unsigned)__builtin_amdgcn_readfirstlane(kdst+(slot)))
  #define DMA_VM(slot) glds16(vsrcm,(unsigned)__builtin_amdgcn_readfirstlane(vdst+(slot)))
  const int vb0=(int)(lds0+LDS_V)+((lane>>4)&1)*32+(lane&3)*8+(4*hi+((lane&15)>>2))*64;
  const char*Kbase=shm+LDS_K; bf16x8 kf[8];
  const lds_cptr shm3=(lds_cptr)shm; const lds_cptr kp0=shm3+LDS_K+hi*1024+r32*16; const lds_cptr vp0=shm3+LDS_V+((lane>>4)&1)*32+(lane&3)*8+(4*hi+((lane&15)>>2))*64;
  const int NT=(q0+QB)/KVBLK+2;
  { float*BLw=(float*)(shm+LDS_BIAS); const float ref=NCL[128+q0]; for(int j=tid;j<NT*KVBLK;j+=NW*64) BLw[j]=NCL[j]-ref; }
  const __attribute__((address_space(3))) f32x4*BLp=(const __attribute__((address_space(3))) f32x4*)((lds_cptr)shm+LDS_BIAS)+hi;
  DMA_KM(0);DMA_VM(0);DMA_KM(SLOTB);
  bf16x8 qr[4];
  #pragma unroll
  for(int d0=0;d0<4;++d0)qr[d0]=*reinterpret_cast<const bf16x8*>(&Qw[(long)r32*DM+d0*16+hi*8]);
  float mhat=0.f,l_reg=0.f;f32x16 o[2];o[0]=f32x16{};o[1]=f32x16{};float nm=0.f;
  const int qrel=wid*QBLK+r32;
  #define CMASK(P0,P1,t) do{int jb_=(t)-(NT-4); if(jb_>=0)cmask(P0,P1,jb_,qrel,hi);}while(0)
  bool resc=false;
  #define START(P0,P1) do{ const float rm=rowmax(P0,P1); resc=false; \
    { const float dl=rm; mhat=fadd_s(mhat,dl); \
      _Pragma("unroll") for(int r=0;r<16;++r){P0[r]=fsub_s(P0[r],dl);P1[r]=fsub_s(P1[r],dl);} \
      nm=-mhat; } \
    _Pragma("unroll") for(int r=0;r<16;++r)P0[r]=__builtin_amdgcn_exp2f(P0[r]); }while(0)
  #define RESC() do{ if(resc){ asm volatile("s_waitcnt lgkmcnt(0)":::"memory"); \
      _Pragma("unroll") for(int d_=0;d_<2;++d_) _Pragma("unroll") for(int r=0;r<16;++r)o[d_][r]*=wsf[crow(r,hi)]; } }while(0)
  f32x16 pA0,pA1,pB0,pB1;
  int sl_prev=0,sl_cur=0,sl_next=SLOTB;
  #define ROT() do{sl_prev=sl_cur;sl_cur=sl_next;sl_next=(sl_next==(NSLOT-1)*SLOTB)?0:sl_next+SLOTB;}while(0)
  DMA_K(2,2*SLOTB);
  WAIT_BAR(3);
  #define CBIAS(X0,X1,t) do{ _Pragma("unroll") for(int g_=0;g_<4;++g_){ const f32x4 a_=BLp[16*(t)+2*g_], b_=BLp[16*(t)+8+2*g_]; \
      X0[4*g_]=a_[0]+nm;X0[4*g_+1]=a_[1]+nm;X0[4*g_+2]=a_[2]+nm;X0[4*g_+3]=a_[3]+nm; X1[4*g_]=b_[0]+nm;X1[4*g_+1]=b_[1]+nm;X1[4*g_+2]=b_[2]+nm;X1[4*g_+3]=b_[3]+nm; } }while(0)
  { f32x16 cb0,cb1; CBIAS(cb0,cb1,0); qkt(pA0,pA1,Kbase,qr,cb0,cb1,r32,hi); }asm volatile("s_nop 15\n\ts_nop 7":"+v"(pA0),"+v"(pA1));CMASK(pA0,pA1,0);
  START(pA0,pA1);
  _Pragma("unroll") for(int r=0;r<16;++r)pA1[r]=__builtin_amdgcn_exp2f(pA1[r]);
  WAIT_BAR(0);
  DMA_K(3,0);DMA_VM(SLOTB);
  ROT();
  kload8(kf,kp0+sl_cur);
  WAIT_BAR(2);
  s16x4 vlo[8],vhi[8]; u32x4 pw0,pw1,pw2,pw3;
  #define PKW(P,B) cvtpk_s(P[B],P[B+1])
  #define PAF(k) __builtin_bit_cast(bf16x8,pw##k)
  #define VFR(i) (bf16x8){vlo[i][0],vlo[i][1],vlo[i][2],vlo[i][3],vhi[i][0],vhi[i][1],vhi[i][2],vhi[i][3]}
  #define PIN(x) asm volatile("":"+v"(x))
  #define MX3(a,b,c) __builtin_fmaxf(__builtin_fmaxf((a),(b)),(c))
  #define GAPA(MF,A0,A1,A2,A3,W0,W1,PW) do{ MF; sacc+=A0; sacc+=A1; sacc+=A2; sacc+=A3; PIN(sacc); W0; W1; PIN(PW); SBAR(); }while(0)
  #define EX(v) __builtin_amdgcn_exp2f(v)
  #define GAPB(MF,X,B) do{ MF; X[B]=EX(X[B]); X[B+1]=EX(X[B+1]); X[B+2]=EX(X[B+2]); X[B+3]=EX(X[B+3]); PIN(X); SBAR(); }while(0)
  #define VRD(i) do{ vlo[i]=vtr(vp_+(((i)>>2)*4096+((i)&3)*1024)); vhi[i]=vtr(vp_+(((i)>>2)*4096+((i)&3)*1024+512)); }while(0)
  #define KRD(G,j) do{ if(G){ kload2(kf,kp0+sl_next,j); SBAR(); } }while(0)
  #define STEP(C0,C1,P0,P1,t,GK,GV,GL) do{ SBAR(); \
    const lds_cptr vp_=vp0+sl_prev; CBIAS(C0,C1,t); SBAR(); \
    VRD(0); SBAR(); float sacc=(P0[0]+P0[1]); \
    GAPA(C0=__builtin_amdgcn_mfma_f32_32x32x16_bf16(kf[0],qr[0],C0,0,0,0), P0[2],P0[3],P0[4],P0[5],     pw0[0]=PKW(P0,0), pw0[1]=PKW(P0,2), pw0); \
    VRD(4); SBAR(); GAPA(C1=__builtin_amdgcn_mfma_f32_32x32x16_bf16(kf[1],qr[0],C1,0,0,0), P0[6],P0[7],P0[8],P0[9],     pw0[2]=PKW(P0,4), pw0[3]=PKW(P0,6), pw0); \
    VRD(1); SBAR(); GAPA(C0=__builtin_amdgcn_mfma_f32_32x32x16_bf16(kf[2],qr[1],C0,0,0,0),   P0[10],P0[11],P0[12],P0[13], pw1[0]=PKW(P0,8), pw1[1]=PKW(P0,10), pw1); \
    VRD(5); SBAR(); GAPA(C1=__builtin_amdgcn_mfma_f32_32x32x16_bf16(kf[3],qr[1],C1,0,0,0),   P0[14],P0[15],P1[0],P1[1],   pw1[2]=PKW(P0,12),pw1[3]=PKW(P0,14), pw1); \
    VRD(2); SBAR(); GAPA(C0=__builtin_amdgcn_mfma_f32_32x32x16_bf16(kf[4],qr[2],C0,0,0,0),   P1[2],P1[3],P1[4],P1[5],     pw2[0]=PKW(P1,0), pw2[1]=PKW(P1,2), pw2); \
    VRD(6); SBAR(); GAPA(C1=__builtin_amdgcn_mfma_f32_32x32x16_bf16(kf[5],qr[2],C1,0,0,0),   P1[6],P1[7],P1[8],P1[9],     pw2[2]=PKW(P1,4), pw2[3]=PKW(P1,6), pw2); \
    VRD(3); SBAR(); GAPA(C0=__builtin_amdgcn_mfma_f32_32x32x16_bf16(kf[6],qr[3],C0,0,0,0),   P1[10],P1[11],P1[12],P1[13], pw3[0]=PKW(P1,8), pw3[1]=PKW(P1,10), pw3); \
    VRD(7); SBAR(); GAPA(C1=__builtin_amdgcn_mfma_f32_32x32x16_bf16(kf[7],qr[3],C1,0,0,0),   P1[14],P1[15],0.f,0.f,       pw3[2]=PKW(P1,12),pw3[3]=PKW(P1,14), pw3); \
    l_reg+=sacc; \
    if(GK){DMA_K((t)+3,sl_cur);} if(GV){DMA_V((t)+1,sl_next);} \
    CMASK(C0,C1,t); \
    { float a=MX3(C0[0],C0[1],C1[0]),b=MX3(C0[2],C0[3],C1[1]); a=MX3(a,C1[2],C1[3]); \
      _Pragma("unroll") for(int r=4;r<16;r+=4){a=MX3(a,C0[r],C0[r+1]);b=MX3(b,C0[r+2],C0[r+3]);a=MX3(a,C1[r],C1[r+1]);b=MX3(b,C1[r+2],C1[r+3]);} \
      float rm=__builtin_fmaxf(a,b); { auto rr=__builtin_amdgcn_permlane32_swap(__float_as_uint(rm),__float_as_uint(rm),false,false); rm=__builtin_fmaxf(__uint_as_float(rr[0]),__uint_as_float(rr[1])); } \
      resc=false; \
      if(__builtin_expect(__any(rm>(float)THRL),0)){ const float dl=__builtin_fmaxf(rm,0.f); mhat+=dl; \
        _Pragma("unroll") for(int r=0;r<16;++r){C0[r]-=dl;C1[r]-=dl;} \
        nm=-mhat; \
        const float f=__builtin_amdgcn_exp2f(-dl); l_reg*=f; if(hi==0)wsf[r32]=f; resc=true; } } \
    SBAR(); \
    GAPB(o[0]=__builtin_amdgcn_mfma_f32_32x32x16_bf16(PAF(0),VFR(0),o[0],0,0,0), C0,0); \
    GAPB(o[1]=__builtin_amdgcn_mfma_f32_32x32x16_bf16(PAF(0),VFR(4),o[1],0,0,0), C0,4); \
    KRD(GL,0); GAPB(o[0]=__builtin_amdgcn_mfma_f32_32x32x16_bf16(PAF(1),VFR(1),o[0],0,0,0), C0,8); \
    KRD(GL,1); GAPB(o[1]=__builtin_amdgcn_mfma_f32_32x32x16_bf16(PAF(1),VFR(5),o[1],0,0,0), C0,12); \
    KRD(GL,2); GAPB(o[0]=__builtin_amdgcn_mfma_f32_32x32x16_bf16(PAF(2),VFR(2),o[0],0,0,0), C1,0); \
    KRD(GL,3); GAPB(o[1]=__builtin_amdgcn_mfma_f32_32x32x16_bf16(PAF(2),VFR(6),o[1],0,0,0), C1,4); \
    GAPB(o[0]=__builtin_amdgcn_mfma_f32_32x32x16_bf16(PAF(3),VFR(3),o[0],0,0,0), C1,8); \
    GAPB(o[1]=__builtin_amdgcn_mfma_f32_32x32x16_bf16(PAF(3),VFR(7),o[1],0,0,0), C1,12); \
    }while(0)
  int t=1;
  #undef CMASK
  #define CMASK(P0,P1,t) do{}while(0)
  for(;t+5<NT;t+=2){
    STEP(pB0,pB1,pA0,pA1,t,true,true,true);     WAIT_BAR(2); RESC(); ROT();
    STEP(pA0,pA1,pB0,pB1,t+1,true,true,true);   WAIT_BAR(2); RESC(); ROT();
  }
  #undef CMASK
  #define CMASK(P0,P1,t) do{int jb_=(t)-(NT-4); if(jb_>=0)cmask(P0,P1,jb_,qrel,hi);}while(0)
  #define ENDW(tt) do{ if((tt)+3<NT){WAIT_BAR(2);} else if((tt)+2<NT){WAIT_BAR(1);} else {WAIT_BAR(0);} }while(0)
  for(;t+1<NT;t+=2){
    STEP(pB0,pB1,pA0,pA1,t,(t+3<NT),(t+1<NT),(t+1<NT));       ENDW(t);   RESC(); ROT();
    STEP(pA0,pA1,pB0,pB1,t+1,(t+4<NT),(t+2<NT),(t+2<NT));     ENDW(t+1); RESC(); ROT();
  }
  STEP(pB0,pB1,pA0,pA1,NT-1,false,false,false); RESC();
  { float sacc=pB0[0]+pB0[1]; _Pragma("unroll") for(int r=2;r<16;++r)sacc+=pB0[r]; _Pragma("unroll") for(int r=0;r<16;++r)sacc+=pB1[r]; l_reg+=sacc;
    pw0=(u32x4){PKW(pB0,0),PKW(pB0,2),PKW(pB0,4),PKW(pB0,6)};pw1=(u32x4){PKW(pB0,8),PKW(pB0,10),PKW(pB0,12),PKW(pB0,14)};pw2=(u32x4){PKW(pB1,0),PKW(pB1,2),PKW(pB1,4),PKW(pB1,6)};pw3=(u32x4){PKW(pB1,8),PKW(pB1,10),PKW(pB1,12),PKW(pB1,14)};
    SBAR(); pv(o,vb0+sl_cur,PAF(0),PAF(1),PAF(2),PAF(3)); }
  #undef PKW
  #undef PAF
  #undef VFR
  #undef PIN
  #undef MX3
  #undef GAPA
  #undef GAPB
  #undef EX
  #undef VRD
  #undef KRD
  #undef STEP
  #undef ENDW
  {auto rr=__builtin_amdgcn_permlane32_swap(__float_as_uint(l_reg),__float_as_uint(l_reg),false,false);l_reg=__uint_as_float(rr[0])+__uint_as_float(rr[1]);}
  if(hi==0)wsf[32+r32]=l_reg;asm volatile("s_waitcnt lgkmcnt(0)":::"memory");
  float rli[16];
  #pragma unroll
  for(int r=0;r<16;++r)rli[r]=__builtin_amdgcn_rcpf(wsf[32+crow(r,hi)]);
  bf16*Ow=O+(rowbase+q0+wid*QBLK)*OPITCH+OCOL0+h*D;
  { bf16*stg=(bf16*)(shm+LDS_OST)+wid*2048;
    #pragma unroll
    for(int r=0;r<16;++r){const int orow=crow(r,hi);
      #pragma unroll
      for(int d0=0;d0<2;++d0)stg[orow*64+d0*32+r32]=__float2bfloat16(o[d0][r]*rli[r]);}
    asm volatile("s_waitcnt lgkmcnt(0)":::"memory");
    #pragma unroll
    for(int i=0;i<4;++i){const int row=i*8+(lane>>3),ch=lane&7; const u32x4 v=*(const u32x4*)(stg+row*64+ch*8); ATTN_STORE16(Ow+(long)row*OPITCH+ch*8,v);} }
  asm volatile("s_waitcnt lgkmcnt(0)\n\ts_barrier":::"memory");
  #undef DMA_K
  #undef DMA_V
  #undef DMA_KM
  #undef DMA_VM
  #undef CBIAS
  #undef CMASK
  #undef START
  #undef RESC
  #undef ROT
}
constexpr int ATTN_LDS_BYTES=LDS_BYTES;
struct AttnTensors { const bf16* Q; const bf16* K; const bf16* V; bf16* O; const float* NCL; };
struct AttnUnit { int bh; int qb; };
struct StaticOrder {
  int vcu;
  __device__ __forceinline__ explicit StaticOrder(int grid,int block):vcu((block%8)*(grid/8)+block/8){}
  __device__ __forceinline__ bool next(int i,AttnUnit&u)const{ if(i>=2)return false; const int s=vcu&15; u.bh=vcu>>4; u.qb=(i==0)?s:31-s; return true; }
  __device__ __forceinline__ void a_ready(const AttnUnit&)const{}
  __device__ __forceinline__ void done(const AttnUnit&)const{}
};
template<class Sched,int THRL=8> __device__ __forceinline__ void attn_phase(char*lds,const AttnTensors&T,const Sched&S){
  AttnUnit u;
  for(int i=0;S.next(i,u);++i){ S.a_ready(u); attn_unit<THRL>(u.bh/NHEAD,u.bh%NHEAD,u.qb,T.Q,T.K,T.V,T.O,T.NCL+(long)u.bh*BIASN,lds); S.done(u); }
}
#undef SBAR
#undef WAIT_BAR
}
#define GAS __attribute__((address_space(1)))
#define LAS __attribute__((address_space(3)))
typedef unsigned short bf16;
typedef unsigned v4u __attribute__((ext_vector_type(4)));
typedef float f32x4 __attribute__((ext_vector_type(4)));
typedef short bf16x8 __attribute__((ext_vector_type(8)));
typedef GAS unsigned gu32;
typedef GAS unsigned long long gu64;
#define RLX_AGENT __ATOMIC_RELAXED, __HIP_MEMORY_SCOPE_AGENT
#define LDS_WAIT() asm volatile("s_waitcnt lgkmcnt(0)" ::: "memory")
#define VM_WAIT() asm volatile("s_waitcnt vmcnt(0)" ::: "memory")
__device__ __forceinline__ unsigned long long rt() { return __builtin_amdgcn_s_memrealtime(); }
__device__ __forceinline__ unsigned f2bf(float f) { unsigned u = __builtin_bit_cast(unsigned, f); return (u + 0x7fffu + ((u >> 16) & 1u)) >> 16; }
__device__ __forceinline__ unsigned pk2(float lo, float hi) { return f2bf(lo) | (f2bf(hi) << 16); }

#define XB_TMO      128
#define XB_XCNT(j)  (256  + 64 * (j))
#define XB_XSUB(j)  (1280 + 64 * (j))
#define XB_XGEN(j)  (2304 + 64 * (j))
#define XB_TOP      3328
#define XB_TOPGEN   3392
#define XCD_BAR_WORDS 3456
#define XB_SPIN_CAP (1u << 18)

__device__ __forceinline__ unsigned xb_ld(unsigned* p)              { return __hip_atomic_load(p, __ATOMIC_RELAXED, __HIP_MEMORY_SCOPE_AGENT); }
__device__ __forceinline__ unsigned xb_add(unsigned* p, unsigned v) { return __hip_atomic_fetch_add(p, v, __ATOMIC_RELAXED, __HIP_MEMORY_SCOPE_AGENT); }
__device__ __forceinline__ unsigned xb_xcc_id() { return (unsigned)__builtin_amdgcn_s_getreg((3 << 11) | 20) & 0xFu; }
#define XB_SPIN(cond, bar) do { unsigned _sp = 0; while (cond) { __builtin_amdgcn_s_sleep(1); \
    if ((++_sp & 255u) == 0u) { if (xb_ld(&(bar)[XB_TMO])) break; if (_sp > XB_SPIN_CAP) { atomicAdd(&(bar)[XB_TMO], 1u); break; } } } } while (0)

struct XcdBarrier {
    unsigned* bar; unsigned x;
    volatile LAS unsigned* st;
};

__device__ __forceinline__ XcdBarrier xcd_barrier_post(unsigned* bar, volatile LAS unsigned* st) {
    XcdBarrier b; b.bar = bar; b.x = xb_xcc_id(); b.st = st;
    if (threadIdx.x == 0) (void)xb_add(&bar[XB_XCNT(b.x)], 1u);
    return b;
}
__device__ __forceinline__ void xcd_barrier_complete(unsigned* bar, unsigned x, unsigned& nloc, unsigned& nx) {
    const unsigned G = gridDim.x * gridDim.y * gridDim.z;
    unsigned sum, cnt, mine, sp = 0u;
    for (;;) {
        sum = 0u; cnt = 0u; mine = 0u;
#pragma unroll
        for (unsigned j = 0; j < 16; ++j) { const unsigned c = xb_ld(&bar[XB_XCNT(j)]); sum += c; cnt += (c > 0u) ? 1u : 0u; mine = (j == x) ? c : mine; }
        if (sum == G) break;
        __builtin_amdgcn_s_sleep(1);
        if ((++sp & 255u) == 0u) { if (xb_ld(&bar[XB_TMO])) break; if (sp > XB_SPIN_CAP) { atomicAdd(&bar[XB_TMO], 1u); break; } }
    }
    nloc = mine > 0u ? mine : 1u; nx = cnt > 0u ? cnt : 1u;
}

__device__ __forceinline__ void xcd_barrier(const XcdBarrier& b) {
    asm volatile("s_waitcnt vmcnt(0)" ::: "memory");
    __syncthreads();
    if (threadIdx.x == 0) {
        unsigned* bar = b.bar;
        __builtin_amdgcn_s_waitcnt(0);
        unsigned nloc = b.st[0], nx = b.st[1];
        if (nloc == 0u) { xcd_barrier_complete(bar, b.x, nloc, nx); b.st[0] = nloc; b.st[1] = nx; }
        const unsigned old = xb_add(&bar[XB_XSUB(b.x)], 1u);
        const unsigned gen = old / nloc;
        if (old + 1u == (gen + 1u) * nloc) {
            __builtin_amdgcn_fence(__ATOMIC_RELEASE, "agent");
            asm volatile("s_waitcnt vmcnt(0)" ::: "memory");
            const unsigned og = xb_add(&bar[XB_TOP], 1u);
            const unsigned tg = og / nx;
            if (og + 1u == (tg + 1u) * nx) xb_add(&bar[XB_TOPGEN], 1u);
            else XB_SPIN(xb_ld(&bar[XB_TOPGEN]) == tg, bar);
            __builtin_amdgcn_fence(__ATOMIC_ACQUIRE, "agent");
            xb_add(&bar[XB_XGEN(b.x)], 1u);
            asm volatile("s_waitcnt vmcnt(0)" ::: "memory");
        } else {
            XB_SPIN(xb_ld(&bar[XB_XGEN(b.x)]) == gen, bar);
            __builtin_amdgcn_fence(__ATOMIC_ACQUIRE, "agent");
            asm volatile("s_waitcnt vmcnt(0)" ::: "memory");
        }
    }
    __syncthreads();
}

constexpr int NWAVES = 8, NTHR = NWAVES * 64;
constexpr int DMOD = 1024, TREAL = 8192, NBATCH = 2, NMETA = 16, TPOS = TREAL + NMETA, NSAMP = 32;
constexpr int M_REAL = NBATCH * TREAL, ROW_META = M_REAL, ROW_SAMP = ROW_META + NMETA, M_VALID = ROW_SAMP + NSAMP, M_PAD = 16640;
constexpr int DSHIFT = 1792, DIN = 5384, N1 = 5376, DR = 512, NH = 8, HD = 64, FF = 4096, DG = 2048;
constexpr int COL_Q = 1792, COL_K = 2304, COL_V = 2816, COL_F = 3328, COL_G = 3328;
constexpr int NPAGES = 64, PAGE = 128, NSPLIT = 8;
constexpr float RMS_EPS = 1e-6f, GN_EPS = 64e-5f, LOG2E = 1.4426950408889634f;
constexpr size_t O_YP = 0, O_YS = O_YP + (size_t)M_REAL * DMOD, O_SHP = O_YS + (size_t)NSAMP * DMOD, O_WKVP = O_SHP + 2 * DSHIFT, O_KP = O_WKVP + 2 * 8 * 64 * 64,
                 O_VP = O_KP + (size_t)2 * TPOS * 512, O_LFP = O_VP + (size_t)2 * TPOS * 512, O_SHS = O_LFP + (size_t)2 * TPOS * 8, O_WKVS = O_SHS + (size_t)NSAMP * DSHIFT,
                 O_KS = O_WKVS + (size_t)NSAMP * 8 * 64 * 64, O_VS = O_KS + NSAMP * 512, O_LFS = O_VS + NSAMP * 512, O_END = O_LFS + NSAMP * 8;
static_assert(O_END == 34959360, "d_out size");
constexpr size_t MiB = 1u << 20;
constexpr size_t al(size_t x) { return (x + MiB - 1) / MiB * MiB; }
constexpr size_t WS_CTL = 0, CTL_ZERO_BYTES = 1 * MiB;
constexpr size_t WS_WIN = 1 * MiB;
constexpr size_t WS_WBR = WS_WIN + al((size_t)N1 * 1024 * 2);
constexpr size_t WS_WOUT = WS_WBR + 2 * MiB;
constexpr size_t WS_WUP = WS_WOUT + 2 * MiB;
constexpr size_t WS_WDN = WS_WUP + 8 * MiB;
constexpr size_t WS_HN = WS_WDN + 8 * MiB;
constexpr size_t WS_UR = WS_HN + al((size_t)M_PAD * 1024 * 2);
constexpr size_t WS_QB = WS_UR + al((size_t)M_PAD * DSHIFT * 4);
constexpr size_t WS_KB = WS_QB + al((size_t)M_PAD * 512 * 2);
constexpr size_t WS_VB = WS_KB + al((size_t)M_PAD * 512 * 2);
constexpr size_t WS_GB = WS_VB + al((size_t)M_PAD * 512 * 2);
constexpr size_t WS_OC = WS_GB + al((size_t)M_PAD * DG * 2);
constexpr size_t WS_LF = WS_OC + al((size_t)M_PAD * 1024 * 2);
constexpr size_t WS_NCL = WS_LF + al((size_t)M_PAD * 8 * 4);
constexpr size_t WS_PR = WS_NCL + 1 * MiB;
constexpr size_t PSTRIDE = al((size_t)M_PAD * 512 * 4);
constexpr size_t WS_Y = WS_PR + 7 * PSTRIDE;
constexpr size_t WS_TMP = WS_UR;
constexpr size_t WS_MG = WS_QB;
constexpr size_t WS_X1 = WS_HN;
constexpr size_t WS_HF = WS_UR;
static_assert(WS_QB + (size_t)M_PAD * 1024 * 2 <= WS_VB && WS_UR + (size_t)M_PAD * FF * 2 <= WS_OC, "overlay map");
constexpr size_t WS_QS = WS_Y + PSTRIDE;
constexpr size_t WS_PART = WS_QS + 1 * MiB;
constexpr size_t WS_SS = WS_PART + 1 * MiB, WS_SS48 = WS_SS + 2 * MiB;
constexpr size_t WS_WDT = WS_SS48 + 1 * MiB;
constexpr size_t WS_WAT = WS_WDT + 1 * MiB, WS_WGT = WS_WAT + 1 * MiB;
constexpr size_t UNIT_B16 = (size_t)2064 * 4096 * 2, UNIT_F32 = (size_t)2064 * 4096 * 4;
constexpr size_t WS_MTH = WS_WGT + 1 * MiB, WS_MTL = WS_MTH + al(UNIT_B16), WS_SLG = WS_MTL + al(UNIT_B16), WS_W2G = WS_SLG + al(UNIT_F32), WS_YLG = WS_W2G + al(UNIT_B16),
                 WS_G1G = WS_YLG + al(UNIT_F32), WS_G2G = WS_G1G + al(UNIT_F32), WS_S0G = WS_G2G + al(UNIT_F32);
constexpr size_t WS_PART2 = WS_S0G + al(UNIT_B16 + 8192);
constexpr size_t WS_END = WS_PART2 + 1 * MiB;
constexpr int CW_BAR = 4096;
constexpr int CW_QUEUE = 8192;
constexpr int CW_ZERO = 65536;
constexpr int CW_FLAG = 131072;
constexpr int RING_OFF = 0, RING_BYTES = 139264, LDSCTL_OFF = RING_BYTES, MISC_OFF = LDSCTL_OFF + 320, LDS_BYTES = 147456;

typedef unsigned v2u __attribute__((ext_vector_type(2)));
__device__ __forceinline__ float bflo(unsigned w) { return __uint_as_float(w << 16); }
__device__ __forceinline__ float bfhi(unsigned w) { return __uint_as_float(w & 0xffff0000u); }
template <int CTRL> __device__ __forceinline__ float dpp_f(float x) { return __builtin_bit_cast(float, __builtin_amdgcn_update_dpp(0, __builtin_bit_cast(int, x), CTRL, 0xF, 0xF, true)); }
__device__ __forceinline__ float red16(float x) {
    x += dpp_f<0xB1>(x); x += dpp_f<0x4E>(x); x += dpp_f<0x141>(x); x += dpp_f<0x128>(x); return x;
}
__device__ __forceinline__ float wred_sum(float x) {
    x = red16(x);
    { auto rr = __builtin_amdgcn_permlane16_swap(__float_as_uint(x), __float_as_uint(x), false, false); x = __uint_as_float(rr[0]) + __uint_as_float(rr[1]); }
    { auto rr = __builtin_amdgcn_permlane32_swap(__float_as_uint(x), __float_as_uint(x), false, false); x = __uint_as_float(rr[0]) + __uint_as_float(rr[1]); }
    return x;
}
__device__ __forceinline__ float wred_max(float x) {
    x = fmaxf(x, dpp_f<0xB1>(x)); x = fmaxf(x, dpp_f<0x4E>(x)); x = fmaxf(x, dpp_f<0x141>(x)); x = fmaxf(x, dpp_f<0x128>(x));
    { auto rr = __builtin_amdgcn_permlane16_swap(__float_as_uint(x), __float_as_uint(x), false, false); x = fmaxf(__uint_as_float(rr[0]), __uint_as_float(rr[1])); }
    { auto rr = __builtin_amdgcn_permlane32_swap(__float_as_uint(x), __float_as_uint(x), false, false); x = fmaxf(__uint_as_float(rr[0]), __uint_as_float(rr[1])); }
    return x;
}
__device__ __forceinline__ float wave_sum(float v) { return wred_sum(v); }
__device__ __forceinline__ float wave_max(float v) { return wred_max(v); }
__device__ __forceinline__ float sigmoidf_(float x) { return 1.0f / (1.0f + __expf(-x)); }

struct Args { const float* in[30]; float* out; unsigned char* ws; };

struct Frame {
    LAS unsigned char* lds;
    volatile LAS unsigned* MISC;
    gu32* ctl;
    int vcu, G;
    const float* in[30]; float* out; unsigned char* ws;
};
#define INP(i) (F.in[i])
enum { I_XP = 0, I_XS, I_SSHIFT, I_SWKV, I_CK, I_CV, I_CLF, I_PT, I_META, I_NMIX, I_WIN, I_MU, I_W0, I_WDEC, I_A0, I_WA, I_WG, I_KK, I_KA, I_RK, I_LNW, I_LNB, I_BF, I_WBR, I_WBF, I_WOUT, I_NFFN, I_WUP, I_WDN, I_NFIN };

__device__ __forceinline__ const float* xrow(const Frame& F, int m) {
    if (m < M_REAL) return F.in[I_XP] + (size_t)m * DMOD;
    if (m < ROW_SAMP) return F.in[I_META] + (size_t)(m - ROW_META) * DMOD;
    if (m < M_VALID) return F.in[I_XS] + (size_t)(m - ROW_SAMP) * DMOD;
    return nullptr;
}

__device__ __forceinline__ void p0_transpose_item(const float* W, int ldw, int nblk, int K, bf16* WT, int ldt, int row_off, int col_off, LAS float* scr, int item, int lane, const float* kscale = nullptr) {
    const int kb = item / nblk, nb = item % nblk, k0 = 64 * kb, n0 = 32 * nb;
#pragma unroll 8
    for (int i = 0; i < 32; ++i) { const int kk = 2 * i + (lane >> 5); scr[kk * 33 + (lane & 31)] = W[(size_t)(k0 + kk) * ldw + n0 + (lane & 31)] * (kscale ? kscale[k0 + kk] : 1.0f); }
    LDS_WAIT(); asm volatile("" ::: "memory");
    const int c = lane & 7;
#pragma unroll
    for (int j = 0; j < 4; ++j) { const int n = (lane >> 3) + 8 * j; const LAS float* s = scr + (8 * c) * 33 + n;
        v4u o; o.x = pk2(s[0 * 33], s[1 * 33]); o.y = pk2(s[2 * 33], s[3 * 33]); o.z = pk2(s[4 * 33], s[5 * 33]); o.w = pk2(s[6 * 33], s[7 * 33]);
        *(GAS v4u*)(WT + (size_t)(row_off + n0 + n) * ldt + col_off + k0 + 8 * c) = o; }
    LDS_WAIT(); asm volatile("" ::: "memory");
    (void)K;
}
__device__ __forceinline__ float log_sigmoid_(float z) { return fminf(z, 0.f) - log1pf(expf(-fabsf(z))); }

__device__ __forceinline__ void p0_prologue(Frame& F) {
    const int tid_ = tid_fresh(), lane_ = tid_ & 63, wave_ = __builtin_amdgcn_readfirstlane(tid_ >> 6); (void)lane_; (void)wave_;
    LAS float* scr = (LAS float*)(F.lds + RING_OFF + wave_ * 16384);
    const int gw = F.vcu * NWAVES + wave_, NGW = F.G * NWAVES;
    unsigned char* ws = F.ws;
    constexpr int I_A = 16 * 104, I_B = 16 * 64, I_BR = 8 * 32, I_O = 16 * 32, I_U = 16 * 128, I_D = 64 * 32;
    constexpr int I_L = 16, I_LG = 32;
    constexpr int NITEMS = I_A + I_B + 2 * I_BR + I_O + I_U + I_D + 2 * I_L + I_LG;
    for (int it = gw; it < NITEMS; it += NGW) {
        int r = it;
        if (r < I_A) { p0_transpose_item(INP(I_WIN), DIN, 104, 1024, (bf16*)(ws + WS_WIN), 1024, 0, 0, scr, r, lane_); continue; } r -= I_A;
        if (r < I_B) { p0_transpose_item(INP(I_WIN) + (COL_F + 8), DIN, 64, 1024, (bf16*)(ws + WS_WIN), 1024, COL_G, 0, scr, r, lane_); continue; } r -= I_B;
        if (r < I_BR) { p0_transpose_item(INP(I_WBR), 1024, 32, 512, (bf16*)(ws + WS_WBR), 1024, 0, 0, scr, r, lane_); continue; } r -= I_BR;
        if (r < I_BR) { p0_transpose_item(INP(I_WBF), 1024, 32, 512, (bf16*)(ws + WS_WBR), 1024, 0, 512, scr, r, lane_); continue; } r -= I_BR;
        if (r < I_O) { p0_transpose_item(INP(I_WOUT), 1024, 32, 1024, (bf16*)(ws + WS_WOUT), 1024, 0, 0, scr, r, lane_); continue; } r -= I_O;
        if (r < I_U) { p0_transpose_item(INP(I_WUP), FF, 128, 1024, (bf16*)(ws + WS_WUP), 1024, 0, 0, scr, r, lane_, INP(I_NFFN)); continue; } r -= I_U;
        if (r < I_D) { p0_transpose_item(INP(I_WDN), 1024, 32, FF, (bf16*)(ws + WS_WDN), FF, 0, 0, scr, r, lane_); continue; } r -= I_D;
        if (r < I_L) { p0_transpose_item(INP(I_WDEC), 512, 16, 64, (bf16*)(ws + WS_WDT), 64, 0, 0, scr, r, lane_); continue; } r -= I_L;
        if (r < I_L) { p0_transpose_item(INP(I_WA), 512, 16, 64, (bf16*)(ws + WS_WAT), 64, 0, 0, scr, r, lane_); continue; } r -= I_L;
        p0_transpose_item(INP(I_WG), 512, 16, 128, (bf16*)(ws + WS_WGT), 128, 0, 0, scr, r, lane_);
    }
    __syncthreads();
    LAS float* WF = (LAS float*)(F.lds + RING_OFF);
    for (int e = tid_; e < 8 * 1024; e += NTHR) { const int k = e >> 3, j = e & 7; WF[j * 1024 + k] = INP(I_NMIX)[k] * INP(I_WIN)[(size_t)k * DIN + COL_F + j]; }
    __syncthreads();
    f32x4 gm[4];
#pragma unroll
    for (int j = 0; j < 4; ++j) gm[j] = *((const GAS f32x4*)INP(I_NMIX) + lane_ + 64 * j);
    const float bfv = INP(I_BF)[lane_ & 7];
    bf16* HN = (bf16*)(ws + WS_HN); float* LF = (float*)(ws + WS_LF);
    f32x4 vnx[4];
    { const float* p0_ = gw < M_PAD ? xrow(F, gw) : nullptr; const GAS f32x4* xr = (const GAS f32x4*)(p0_ ? p0_ : F.in[I_XP]) + lane_;
#pragma unroll
      for (int j = 0; j < 4; ++j) vnx[j] = xr[64 * j]; }
    for (int m = gw; m < M_PAD; m += NGW) {
        const float* xr_ = xrow(F, m);
        GAS unsigned long long* o8 = (GAS unsigned long long*)(HN + (size_t)m * DMOD) + lane_;
        f32x4 v[4];
#pragma unroll
        for (int j = 0; j < 4; ++j) v[j] = vnx[j];
        { const int mn = m + NGW; const float* pn_ = mn < M_PAD ? xrow(F, mn) : nullptr; const GAS f32x4* xn = (const GAS f32x4*)(pn_ ? pn_ : F.in[I_XP]) + lane_;
#pragma unroll
          for (int j = 0; j < 4; ++j) vnx[j] = xn[64 * j]; }
        if (xr_ == nullptr) {
#pragma unroll
            for (int j = 0; j < 4; ++j) o8[64 * j] = 0ull;
            if (lane_ < 8) LF[(size_t)m * 8 + lane_] = 0.f;
            continue;
        }
        float s2 = 0.f;
#pragma unroll
        for (int j = 0; j < 4; ++j) { s2 += (v[j].x * v[j].x + v[j].y * v[j].y) + (v[j].z * v[j].z + v[j].w * v[j].w); }
        const float rstd = 1.0f / sqrtf(wave_sum(s2) * (1.f / DMOD) + RMS_EPS);
        float fa[8];
#pragma unroll
        for (int q = 0; q < 8; ++q) { float a = 0.f;
#pragma unroll
            for (int j = 0; j < 4; ++j) { const f32x4 w = *((const LAS f32x4*)(WF + q * 1024) + lane_ + 64 * j); a += (v[j].x * w.x + v[j].y * w.y) + (v[j].z * w.z + v[j].w * w.w); }
            fa[q] = wave_sum(a); }
        float mine = fa[0];
#pragma unroll
        for (int q = 1; q < 8; ++q) mine = ((lane_ & 7) == q) ? fa[q] : mine;
        const float lf = log_sigmoid_(mine * rstd + bfv);
        if (lane_ < 8) {
            LF[(size_t)m * 8 + lane_] = lf;
            if (m < M_REAL) F.out[O_LFP + ((size_t)(m >> 13) * TPOS + NMETA + (m & 8191)) * 8 + lane_] = lf;
            else if (m < ROW_SAMP) { F.out[O_LFP + (size_t)(m - ROW_META) * 8 + lane_] = lf; F.out[O_LFP + ((size_t)TPOS + (m - ROW_META)) * 8 + lane_] = lf; }
            else F.out[O_LFS + (size_t)(m - ROW_SAMP) * 8 + lane_] = lf;
        }
#pragma unroll
        for (int j = 0; j < 4; ++j) { const f32x4 h = v[j] * rstd * gm[j]; o8[64 * j] = (unsigned long long)pk2(h.x, h.y) | ((unsigned long long)pk2(h.z, h.w) << 32); }
    }
}

__device__ __forceinline__ void p1_cumsum(Frame& F, int bh) {
    const int tid_ = tid_fresh(), lane_ = tid_ & 63, wave_ = __builtin_amdgcn_readfirstlane(tid_ >> 6); (void)lane_; (void)wave_;
    const float* LF = (const float*)(F.ws + WS_LF); float* NCL = (float*)(F.ws + WS_NCL) + (size_t)bh * attn_body::BIASN;
    const int b = bh >> 3, h = bh & 7; constexpr int PER = 17;
    LAS float* wt = (LAS float*)(F.lds + RING_OFF);
    const int i0 = tid_ * PER;
    float s = 0.f;
    for (int i = 0; i < PER; ++i) { const int p = i0 + i; if (p < TPOS) { const int row = p < NMETA ? ROW_META + p : b * TREAL + (p - NMETA); s += LF[(size_t)row * 8 + h]; } }
    float inc = s;
#pragma unroll
    for (int o = 1; o < 64; o <<= 1) { const float t = __shfl_up(inc, o); if (lane_ >= o) inc += t; }
    if (lane_ == 63) wt[wave_] = inc;
    __syncthreads();
    float base = inc - s;
    for (int w = 0; w < wave_; ++w) base += wt[w];
    float c = base;
    for (int i = 0; i < PER; ++i) { const int p = i0 + i; if (p < TPOS) { const int row = p < NMETA ? ROW_META + p : b * TREAL + (p - NMETA); c += LF[(size_t)row * 8 + h];
        NCL[p < NMETA ? p : 128 + (p - NMETA)] = -c * LOG2E; } }
    if (tid_ >= 16 && tid_ < 128) NCL[tid_] = -1e30f;
    __syncthreads();
}

namespace pg8 {
struct EpiIn {
    static constexpr bool PERM = true, AFTER_DRAIN = false;
    bf16_t* UR; bf16_t* QB; bf16_t* KB; bf16_t* VB; bf16_t* GB; float* QS; float* out;
    static __device__ __forceinline__ float sg(float x) { return __builtin_amdgcn_rcpf(1.0f + __builtin_amdgcn_exp2f(-1.4426950408889634f * x)); }
    __device__ __forceinline__ void operator()(const f32x4 (&acc)[2][2][4][2], const Unit& u, int wr, int wc, int fr, int fq) const {
        const int row0 = u.pm * BM + wr * 64 + fr, col0 = u.pn * BM + wc * 32 + 8 * fq; const int pn = u.pn;
        const bool real = u.pm < 64;
        const bool tail = (u.pm & 31) == 31;
#pragma unroll
        for (int ai = 0; ai < 2; ++ai)
#pragma unroll
            for (int m = 0; m < 4; ++m) { const int r = row0 + ai * HALF + m * 16;
#pragma unroll
                for (int bj = 0; bj < 2; ++bj) { const int c = col0 + bj * HALF; const f32x4 v0 = acc[ai][bj][m][0], v1 = acc[ai][bj][m][1];
                    if (pn < 7) {
                        { u32x4 w; w.x = cvt_pk_bf16(v0[0], v0[1]); w.y = cvt_pk_bf16(v0[2], v0[3]); w.z = cvt_pk_bf16(v1[0], v1[1]); w.w = cvt_pk_bf16(v1[2], v1[3]); *(u32x4*)(UR + (size_t)r * DSHIFT + c) = w; }
                        if (real) { if (tail && (r & 8191) == 8191) { float* q = out + O_SHP + (size_t)(r >> 13) * DSHIFT + c; *(f32x4*)q = v0; *(f32x4*)(q + 4) = v1; } }
                        else if (r >= ROW_SAMP && r < M_VALID) { float* q = out + O_SHS + (size_t)(r - ROW_SAMP) * DSHIFT + c; *(f32x4*)q = v0; *(f32x4*)(q + 4) = v1; }
                    } else if (pn < 9) {
                        const int cc = c - COL_Q; const float sc = attn_body::C2;
                        u32x4 w; w.x = cvt_pk_bf16(v0[0] * sc, v0[1] * sc); w.y = cvt_pk_bf16(v0[2] * sc, v0[3] * sc); w.z = cvt_pk_bf16(v1[0] * sc, v1[1] * sc); w.w = cvt_pk_bf16(v1[2] * sc, v1[3] * sc);
                        *(u32x4*)(QB + (size_t)r * 512 + cc) = w;
                        if (!real) { if (r >= ROW_SAMP && r < M_VALID) { float* q = QS + (size_t)(r - ROW_SAMP) * 512 + cc; *(f32x4*)q = v0; *(f32x4*)(q + 4) = v1; } }
                    } else if (pn < 13) {
                        const bool isk = pn < 11; const int cc = c - (isk ? COL_K : COL_V);
                        u32x4 w; w.x = cvt_pk_bf16(v0[0], v0[1]); w.y = cvt_pk_bf16(v0[2], v0[3]); w.z = cvt_pk_bf16(v1[0], v1[1]); w.w = cvt_pk_bf16(v1[2], v1[3]);
                        *(u32x4*)((isk ? KB : VB) + (size_t)r * 512 + cc) = w;
                        float* op = out + (isk ? O_KP : O_VP);
                        if (real) { float* q = op + ((size_t)(r >> 13) * TPOS + NMETA + (r & 8191)) * 512 + cc; *(f32x4*)q = v0; *(f32x4*)(q + 4) = v1; }
                        else if (r < ROW_SAMP) { float* q = op + (size_t)(r - ROW_META) * 512 + cc; *(f32x4*)q = v0; *(f32x4*)(q + 4) = v1; q += (size_t)TPOS * 512; *(f32x4*)q = v0; *(f32x4*)(q + 4) = v1; }
                        else if (r < M_VALID) { float* q = out + (isk ? O_KS : O_VS) + (size_t)(r - ROW_SAMP) * 512 + cc; *(f32x4*)q = v0; *(f32x4*)(q + 4) = v1; }
                    } else {
                        const int cc = c - COL_G;
                        u32x4 w; w.x = cvt_pk_bf16(sg(v0[0]), sg(v0[1])); w.y = cvt_pk_bf16(sg(v0[2]), sg(v0[3])); w.z = cvt_pk_bf16(sg(v1[0]), sg(v1[1])); w.w = cvt_pk_bf16(sg(v1[2]), sg(v1[3]));
                        *(u32x4*)(GB + (size_t)r * DG + cc) = w;
                    }
                } }
    }
};
struct EpiBrA {
    static constexpr bool PERM = true, AFTER_DRAIN = false;
    bf16_t* TMP; const bf16_t* GB;
    __device__ __forceinline__ void operator()(const f32x4 (&acc)[2][2][4][2], const Unit& u, int wr, int wc, int fr, int fq) const {
        const int row0 = u.pm * BM + wr * 64 + fr, col0 = u.pn * BM + wc * 32 + 8 * fq;
#pragma unroll
        for (int ai = 0; ai < 2; ++ai)
#pragma unroll
            for (int m = 0; m < 4; ++m) { const int r = row0 + ai * HALF + m * 16;
#pragma unroll
                for (int bj = 0; bj < 2; ++bj) { const int c = col0 + bj * HALF; const f32x4 v0 = acc[ai][bj][m][0], v1 = acc[ai][bj][m][1];
                    const u32x4 g = *(const u32x4*)(GB + (size_t)r * DG + c);
                    u32x4 w; w.x = cvt_pk_bf16(v0[0] * bflo(g.x), v0[1] * bfhi(g.x)); w.y = cvt_pk_bf16(v0[2] * bflo(g.y), v0[3] * bfhi(g.y)); w.z = cvt_pk_bf16(v1[0] * bflo(g.z), v1[1] * bfhi(g.z)); w.w = cvt_pk_bf16(v1[2] * bflo(g.w), v1[3] * bfhi(g.w));
                    *(u32x4*)(TMP + (size_t)r * 1024 + c) = w; } }
    }
};
struct EpiBrB {
    static constexpr bool PERM = true, AFTER_DRAIN = false;
    const bf16_t* TMP; const bf16_t* GB; bf16_t* MG;
    __device__ __forceinline__ void operator()(const f32x4 (&acc)[2][2][4][2], const Unit& u, int wr, int wc, int fr, int fq) const {
        const int row0 = u.pm * BM + wr * 64 + fr, col0 = u.pn * BM + wc * 32 + 8 * fq;
#pragma unroll
        for (int ai = 0; ai < 2; ++ai)
#pragma unroll
            for (int m = 0; m < 4; ++m) { const int r = row0 + ai * HALF + m * 16;
#pragma unroll
                for (int bj = 0; bj < 2; ++bj) { const int c = col0 + bj * HALF; const f32x4 v0 = acc[ai][bj][m][0], v1 = acc[ai][bj][m][1];
                    const u32x4 g = *(const u32x4*)(GB + (size_t)r * DG + 1024 + c);
                    const u32x4 tw = *(const u32x4*)(TMP + (size_t)r * 1024 + c); const f32x4 t0 = {bflo(tw.x), bfhi(tw.x), bflo(tw.y), bfhi(tw.y)}, t1 = {bflo(tw.z), bfhi(tw.z), bflo(tw.w), bfhi(tw.w)};
                    u32x4 w; w.x = cvt_pk_bf16(t0[0] + v0[0] * bflo(g.x), t0[1] + v0[1] * bfhi(g.x)); w.y = cvt_pk_bf16(t0[2] + v0[2] * bflo(g.y), t0[3] + v0[3] * bfhi(g.y));
                    w.z = cvt_pk_bf16(t1[0] + v1[0] * bflo(g.z), t1[1] + v1[1] * bfhi(g.z)); w.w = cvt_pk_bf16(t1[2] + v1[2] * bflo(g.w), t1[3] + v1[3] * bfhi(g.w));
                    *(u32x4*)(MG + (size_t)r * 1024 + c) = w; } }
    }
};
template <bool ADD> struct EpiRes {
    static constexpr bool PERM = true, AFTER_DRAIN = false;
    bf16_t* XB; float* SS; const float* xp;
    __device__ __forceinline__ void operator()(const f32x4 (&acc)[2][2][4][2], const Unit& u, int wr, int wc, int fr, int fq) const {
        const int row0 = u.pm * BM + wr * 64 + fr, col0 = u.pn * BM + wc * 32 + 8 * fq;
#pragma unroll
        for (int ai = 0; ai < 2; ++ai)
#pragma unroll
            for (int m = 0; m < 4; ++m) { const int r = row0 + ai * HALF + m * 16; float ssq = 0.f;
#pragma unroll
                for (int bj = 0; bj < 2; ++bj) { const int c = col0 + bj * HALF; f32x4 v0 = acc[ai][bj][m][0], v1 = acc[ai][bj][m][1];
                    if (ADD) { const u32x4 xw = *(const u32x4*)(XB + (size_t)r * 1024 + c); v0 += (f32x4){bflo(xw.x), bfhi(xw.x), bflo(xw.y), bfhi(xw.y)}; v1 += (f32x4){bflo(xw.z), bfhi(xw.z), bflo(xw.w), bfhi(xw.w)}; }
                    else { v0 += *(const f32x4*)(xp + (size_t)r * 1024 + c); v1 += *(const f32x4*)(xp + (size_t)r * 1024 + c + 4);
                        ssq += (v0[0] * v0[0] + v0[1] * v0[1]) + (v0[2] * v0[2] + v0[3] * v0[3]) + (v1[0] * v1[0] + v1[1] * v1[1]) + (v1[2] * v1[2] + v1[3] * v1[3]); }
                    u32x4 w; w.x = cvt_pk_bf16(v0[0], v0[1]); w.y = cvt_pk_bf16(v0[2], v0[3]); w.z = cvt_pk_bf16(v1[0], v1[1]); w.w = cvt_pk_bf16(v1[2], v1[3]);
                    *(u32x4*)(XB + (size_t)r * 1024 + c) = w; }
                if (!ADD) { ssq += __shfl_xor(ssq, 16); ssq += __shfl_xor(ssq, 32); if (fq == 0) SS[(size_t)r * 16 + u.pn * 4 + wc] = ssq; } }
    }
};
struct EpiUp {
    static constexpr bool PERM = true, AFTER_DRAIN = false;
    bf16_t* HF; const float* SS;
    __device__ __forceinline__ void operator()(const f32x4 (&acc)[2][2][4][2], const Unit& u, int wr, int wc, int fr, int fq) const {
        const int row0 = u.pm * BM + wr * 64 + fr, col0 = u.pn * BM + wc * 32 + 8 * fq;
#pragma unroll
        for (int ai = 0; ai < 2; ++ai)
#pragma unroll
            for (int m = 0; m < 4; ++m) { const int r = row0 + ai * HALF + m * 16;
                const f32x4* sp = (const f32x4*)(SS + (size_t)r * 16); const f32x4 s4 = (sp[0] + sp[1]) + (sp[2] + sp[3]);
                const float rstd = __builtin_amdgcn_rsqf(((s4[0] + s4[1]) + (s4[2] + s4[3])) * (1.f / 1024.f) + RMS_EPS);
#pragma unroll
                for (int bj = 0; bj < 2; ++bj) { const int c = col0 + bj * HALF; f32x4 v0 = acc[ai][bj][m][0] * rstd, v1 = acc[ai][bj][m][1] * rstd;
                    v0 = __builtin_elementwise_max(v0, (f32x4){0.f, 0.f, 0.f, 0.f}); v1 = __builtin_elementwise_max(v1, (f32x4){0.f, 0.f, 0.f, 0.f}); v0 = v0 * v0; v1 = v1 * v1;
                    u32x4 w; w.x = cvt_pk_bf16(v0[0], v0[1]); w.y = cvt_pk_bf16(v0[2], v0[3]); w.z = cvt_pk_bf16(v1[0], v1[1]); w.w = cvt_pk_bf16(v1[2], v1[3]);
                    *(u32x4*)(HF + (size_t)r * FF + c) = w; } }
    }
};
}

__device__ __forceinline__ const bf16* prev_row(const Frame& F, const bf16* UR, int row) {
    if (row < M_REAL) return (row & 8191) ? UR + (size_t)(row - 1) * DSHIFT : UR + (size_t)(ROW_SAMP - 1) * DSHIFT;
    return row > ROW_META ? UR + (size_t)(row - 1) * DSHIFT : (const bf16*)(F.ctl + CW_ZERO);
}
__device__ __forceinline__ void p2_prep(Frame& F, int tl) {
    const int tid_ = tid_fresh(), lane_ = tid_ & 63, wave_ = __builtin_amdgcn_readfirstlane(tid_ >> 6); (void)lane_; (void)wave_;
    float* PR = (float*)(F.ws + WS_PR); constexpr size_t PS = PSTRIDE / 4;
    LAS float* ACT = (LAS float*)(F.lds + RING_OFF);
    const int c = tid_;
    const float* mu = INP(I_MU);
    const float mu_r = mu[c], mu_k = mu[512 + c], mu_v = mu[1024 + c];
    const float w0 = INP(I_W0)[c], a0 = INP(I_A0)[c], kkc = INP(I_KK)[c], kac = INP(I_KA)[c];
    const float* Wd = INP(I_WDEC) + c; const float* Wa = INP(I_WA) + c; const float* Wg = INP(I_WG) + c;
    constexpr int NTILE = M_VALID / 16;
    (void)NTILE; {
        const int r0 = tl * 16;
        __syncthreads();
#pragma unroll
        for (int i = 0; i < 8; ++i) { const int e = tid_ + NTHR * i, rr = e >> 8, k = e & 255, row = r0 + rr;
            const float* cur = F.out + O_SHS + (size_t)(row - ROW_SAMP) * DSHIFT + 1536 + k; const float* prv = F.in[I_SSHIFT] + (size_t)(row - ROW_SAMP) * DSHIFT + 1536 + k;
            const float u = *cur, us = u + mu[1536 + k] * (*prv - u);
            ACT[k * 16 + rr] = k < 64 ? tanhf(us) : k < 128 ? us : sigmoidf_(us); }
        __syncthreads();
        float aw[16], aa[16], ag[16];
#pragma unroll
        for (int i = 0; i < 16; ++i) { aw[i] = 0.f; aa[i] = 0.f; ag[i] = 0.f; }
        for (int k = 0; k < 64; ++k) { const float wd = Wd[(size_t)k * 512], wa = Wa[(size_t)k * 512];
#pragma unroll
            for (int q = 0; q < 4; ++q) { const f32x4 x = *(const LAS f32x4*)(ACT + k * 16 + 4 * q), y = *(const LAS f32x4*)(ACT + (64 + k) * 16 + 4 * q);
                aw[4 * q] += x[0] * wd; aw[4 * q + 1] += x[1] * wd; aw[4 * q + 2] += x[2] * wd; aw[4 * q + 3] += x[3] * wd;
                aa[4 * q] += y[0] * wa; aa[4 * q + 1] += y[1] * wa; aa[4 * q + 2] += y[2] * wa; aa[4 * q + 3] += y[3] * wa; } }
        for (int k = 0; k < 128; ++k) { const float wg = Wg[(size_t)k * 512];
#pragma unroll
            for (int q = 0; q < 4; ++q) { const f32x4 x = *(const LAS f32x4*)(ACT + (128 + k) * 16 + 4 * q);
                ag[4 * q] += x[0] * wg; ag[4 * q + 1] += x[1] * wg; ag[4 * q + 2] += x[2] * wg; ag[4 * q + 3] += x[3] * wg; } }
#pragma unroll
        for (int i = 0; i < 16; ++i) { const int row = r0 + i;
            const float* cur = F.out + O_SHS + (size_t)(row - ROW_SAMP) * DSHIFT + c; const float* prv = F.in[I_SSHIFT] + (size_t)(row - ROW_SAMP) * DSHIFT + c;
            const float ur = cur[0], uk = cur[512], uv = cur[1024];
            const float r = ur + mu_r * (prv[0] - ur), k = uk + mu_k * (prv[512] - uk), v = uv + mu_v * (prv[1024] - uv);
            const float x = w0 + aw[i];
            const float sp = fmaxf(-x, 0.f) + log1pf(expf(-fabsf(x)));
            const float dec = expf(-expf(-sp - 0.5f));
            const float a = sigmoidf_(a0 + aa[i]);
            float kk = k * kkc; const float nrm = sqrtf(wave_sum(kk * kk)); kk = kk / fmaxf(nrm, 1e-12f);
            const float k2 = k * (1.0f + (a - 1.0f) * kac);
            const size_t o = (size_t)row * 512 + c;
            PR[o] = r; PR[PS + o] = dec; PR[2 * PS + o] = k2; PR[3 * PS + o] = v; PR[4 * PS + o] = kk; PR[5 * PS + o] = kk * a; PR[6 * PS + o] = ag[i]; }
    }
    __syncthreads();
}

__device__ __forceinline__ void p2_meta_attn(Frame& F) {
    const int tid_ = tid_fresh(), lane_ = tid_ & 63, wave_ = __builtin_amdgcn_readfirstlane(tid_ >> 6); (void)lane_; (void)wave_;
    const bf16* QB = (const bf16*)(F.ws + WS_QB); const bf16* KB = (const bf16*)(F.ws + WS_KB); const bf16* VB = (const bf16*)(F.ws + WS_VB); bf16* OC = (bf16*)(F.ws + WS_OC);
    const float* NCL = (const float*)(F.ws + WS_NCL);
    const int h = wave_, i = lane_ & 15, part = lane_ >> 4;
    float q[16];
    { const v4u* qp = (const v4u*)(QB + (size_t)(ROW_META + i) * 512 + h * 64 + part * 16); const v4u a = qp[0], b = qp[1];
      q[0] = bflo(a.x); q[1] = bfhi(a.x); q[2] = bflo(a.y); q[3] = bfhi(a.y); q[4] = bflo(a.z); q[5] = bfhi(a.z); q[6] = bflo(a.w); q[7] = bfhi(a.w);
      q[8] = bflo(b.x); q[9] = bfhi(b.x); q[10] = bflo(b.y); q[11] = bfhi(b.y); q[12] = bflo(b.z); q[13] = bfhi(b.z); q[14] = bflo(b.w); q[15] = bfhi(b.w); }
    float s[16]; const float nci = NCL[(size_t)h * attn_body::BIASN + i];
#pragma unroll
    for (int j = 0; j < 16; ++j) { const v4u* kp = (const v4u*)(KB + (size_t)(ROW_META + j) * 512 + h * 64 + part * 16); const v4u a = kp[0], b = kp[1];
        float d = q[0] * bflo(a.x) + q[1] * bfhi(a.x) + q[2] * bflo(a.y) + q[3] * bfhi(a.y) + q[4] * bflo(a.z) + q[5] * bfhi(a.z) + q[6] * bflo(a.w) + q[7] * bfhi(a.w)
                + q[8] * bflo(b.x) + q[9] * bfhi(b.x) + q[10] * bflo(b.y) + q[11] * bfhi(b.y) + q[12] * bflo(b.z) + q[13] * bfhi(b.z) + q[14] * bflo(b.w) + q[15] * bfhi(b.w);
        d += __shfl_xor(d, 16); d += __shfl_xor(d, 32);
        s[j] = (j <= i) ? d + NCL[(size_t)h * attn_body::BIASN + j] - nci : -INFINITY; }
    float mx = s[0];
#pragma unroll
    for (int j = 1; j < 16; ++j) mx = fmaxf(mx, s[j]);
    float l = 0.f; float o[16];
#pragma unroll
    for (int d = 0; d < 16; ++d) o[d] = 0.f;
#pragma unroll
    for (int j = 0; j < 16; ++j) { const float p = exp2f(s[j] - mx); l += p;
        const v4u* vp = (const v4u*)(VB + (size_t)(ROW_META + j) * 512 + h * 64 + part * 16); const v4u a = vp[0], b = vp[1];
        o[0] += p * bflo(a.x); o[1] += p * bfhi(a.x); o[2] += p * bflo(a.y); o[3] += p * bfhi(a.y); o[4] += p * bflo(a.z); o[5] += p * bfhi(a.z); o[6] += p * bflo(a.w); o[7] += p * bfhi(a.w);
        o[8] += p * bflo(b.x); o[9] += p * bfhi(b.x); o[10] += p * bflo(b.y); o[11] += p * bfhi(b.y); o[12] += p * bflo(b.z); o[13] += p * bfhi(b.z); o[14] += p * bflo(b.w); o[15] += p * bfhi(b.w); }
    const float rl = 1.0f / l;
    v4u w0, w1; w0.x = pk2(o[0] * rl, o[1] * rl); w0.y = pk2(o[2] * rl, o[3] * rl); w0.z = pk2(o[4] * rl, o[5] * rl); w0.w = pk2(o[6] * rl, o[7] * rl);
    w1.x = pk2(o[8] * rl, o[9] * rl); w1.y = pk2(o[10] * rl, o[11] * rl); w1.z = pk2(o[12] * rl, o[13] * rl); w1.w = pk2(o[14] * rl, o[15] * rl);
    v4u* op = (v4u*)(OC + (size_t)(ROW_META + i) * 1024 + 512 + h * 64 + part * 16); op[0] = w0; op[1] = w1;
}

constexpr int PART_STRIDE = 80;
struct DecK { f32x4 k[4]; };
struct DecV { f32x4 v[4]; };
__device__ __forceinline__ void dec_ld(const Frame& F, DecK& K, DecV& V, int pgv, int h, int c, int cend, int g, int kq) {
    c = c < cend ? c : cend - 1;
    const int page = __builtin_amdgcn_readlane(pgv, c >> 3), pos0 = (c & 7) * 16;
    const size_t off = (size_t)page * (PAGE * 512) + h * 64 + 4 * kq + (size_t)(pos0 + g) * 512;
    const float* Kp = F.in[I_CK] + off; const float* Vp = F.in[I_CV] + off;
#pragma unroll
    for (int i = 0; i < 4; ++i) K.k[i] = __builtin_nontemporal_load((const f32x4*)(Kp + (size_t)(4 * i) * 512));
#pragma unroll
    for (int i = 0; i < 4; ++i) V.v[i] = __builtin_nontemporal_load((const f32x4*)(Vp + (size_t)(4 * i) * 512));
}
__device__ __forceinline__ float dec_lf(const Frame& F, int pgv, int h, int S, int Send, int lane) {
    S = S < Send ? S : Send - 1;
    const int page = __builtin_amdgcn_readlane(pgv, S >> 1);
    return F.in[I_CLF][(size_t)page * (PAGE * 8) + (size_t)((S & 1) * 64 + lane) * 8 + h];
}
template <int CC> __device__ __forceinline__ void dec_dot(const DecK& K, const f32x4 q4, float& smine, int kq) {
#pragma unroll
    for (int i = 0; i < 4; ++i) { float d = (K.k[i][0] * q4[0] + K.k[i][1] * q4[1]) + (K.k[i][2] * q4[2] + K.k[i][3] * q4[3]);
        d = red16(d); smine = (kq == 4 * CC + i) ? d : smine; }
}
__device__ __forceinline__ void dec_update(const DecV& V0, const DecV& V1, const DecV& V2, const DecV& V3, float lf, float smine, float& m, float& l, float& csum, f32x4& o4, int lane, int g, int kq) {
    float inc = lf;
#pragma unroll
    for (int o = 1; o < 64; o <<= 1) { const float t = __shfl_up(inc, o); if (lane >= o) inc += t; }
    const float cpos = __shfl(inc, 16 * (kq >> 2) + 4 * (kq & 3) + g), ctot = __shfl(inc, 63);
    const float s = smine - (csum + cpos);
    csum += ctot;
    const float mc = wred_max(s), mn = fmaxf(m, mc), alpha = __expf(m - mn), p = __expf(s - mn);
    l = l * alpha + wred_sum(p); m = mn; o4 = o4 * alpha;
#define DEC_PV(V, CC) _Pragma("unroll") for (int i = 0; i < 4; ++i) { const float pi = __shfl(p, g * 16 + 4 * (CC) + i); o4 += V.v[i] * pi; }
    DEC_PV(V0, 0) DEC_PV(V1, 1) DEC_PV(V2, 2) DEC_PV(V3, 3)
#undef DEC_PV
}
__device__ __forceinline__ void p2_decode_split(Frame& F, int item, int half) {
    const int tid_ = tid_fresh(), lane_ = tid_ & 63, wave_ = __builtin_amdgcn_readfirstlane(tid_ >> 6);
    const int bt = item >> 3, sp = item & 7, h = wave_, kq = lane_ & 15, g = lane_ >> 4;
    const float* QS = (const float*)(F.ws + WS_QS); float* PART = (float*)(F.ws + (half ? WS_PART2 : WS_PART)) + (size_t)((bt * NSPLIT + sp) * NH + h) * PART_STRIDE;
    const int* PT = (const int*)INP(I_PT);
    f32x4 q4 = *(const f32x4*)(QS + (size_t)bt * 512 + h * 64 + 4 * kq); q4 = q4 * 0.125f;
    float m = -1e30f, l = 0.f, csum = 0.f; f32x4 o4 = {0.f, 0.f, 0.f, 0.f};
    const int cbeg = half * 32, cend = cbeg + 32;
    DecK K0, K1, K2, K3; DecV V0, V1, V2, V3, V4, V5, V6, V7;
    const int pgv = PT[bt * NPAGES + sp * 8 + (lane_ & 7)];
#define DL(KX, VX, c) do { __builtin_amdgcn_sched_barrier(0); dec_ld(F, KX, VX, pgv, h, (c), cend, g, kq); __builtin_amdgcn_sched_barrier(0); } while (0)
#define DLF(S) dec_lf(F, pgv, h, (S), cend >> 2, lane_)
#define DU(A, B, C, D, LFV) dec_update(A, B, C, D, LFV, sm, m, l, csum, o4, lane_, g, kq)
    DL(K0, V0, cbeg); DL(K1, V1, cbeg + 1); DL(K2, V2, cbeg + 2);
    float lfA = DLF(cbeg >> 2), lfB;
#pragma unroll 1
    for (int c = cbeg; c < cend; c += 8) {
        float sm = 0.f;
        DL(K3, V3, c + 3); dec_dot<0>(K0, q4, sm, kq);
        DL(K0, V4, c + 4); dec_dot<1>(K1, q4, sm, kq);
        DL(K1, V5, c + 5); dec_dot<2>(K2, q4, sm, kq);
        DL(K2, V6, c + 6); dec_dot<3>(K3, q4, sm, kq);
        lfB = DLF((c >> 2) + 1);
        DU(V0, V1, V2, V3, lfA);
        sm = 0.f;
        DL(K3, V7, c + 7); dec_dot<0>(K0, q4, sm, kq);
        DL(K0, V0, c + 8); dec_dot<1>(K1, q4, sm, kq);
        DL(K1, V1, c + 9); dec_dot<2>(K2, q4, sm, kq);
        DL(K2, V2, c + 10); dec_dot<3>(K3, q4, sm, kq);
        lfA = DLF((c >> 2) + 2);
        DU(V4, V5, V6, V7, lfB);
    }
#undef DL
#undef DLF
#undef DU
#pragma unroll
    for (int e = 0; e < 4; ++e) { float t = o4[e]; t += __shfl_xor(t, 16); t += __shfl_xor(t, 32); o4[e] = t; }
    if (g == 0) *(f32x4*)(PART + 16 + 4 * kq) = o4;
    if (lane_ == 0) { PART[0] = m; PART[1] = l; PART[2] = csum; }
}

__device__ __forceinline__ void p2_scan_sample(Frame& F, int item) {
    const int tid_ = tid_fresh(), lane_ = tid_ & 63, wave_ = __builtin_amdgcn_readfirstlane(tid_ >> 6); (void)lane_; (void)wave_;
    const int bt = item >> 3, h = item & 7, v = tid_ >> 3, k8 = tid_ & 7;
    const float* PR = (const float*)(F.ws + WS_PR); constexpr size_t PS = PSTRIDE / 4;
    float* Y = (float*)(F.ws + WS_Y);
    const size_t ro = (size_t)(ROW_SAMP + bt) * 512 + h * 64, so = ((size_t)(bt * 8 + h) * 64 + v) * 64 + 8 * k8;
    const float vv = PR[3 * PS + ro + v];
    float u = 0.f; f32x4 S[2];
#pragma unroll
    for (int e = 0; e < 2; ++e) { S[e] = *(const f32x4*)(INP(I_SWKV) + so + 4 * e); const f32x4 kk4 = *(const f32x4*)(PR + 4 * PS + ro + 8 * k8 + 4 * e);
        u += (S[e][0] * kk4[0] + S[e][1] * kk4[1]) + (S[e][2] * kk4[2] + S[e][3] * kk4[3]); }
    u += __shfl_xor(u, 1); u += __shfl_xor(u, 2); u += __shfl_xor(u, 4);
    float y = 0.f;
#pragma unroll
    for (int e = 0; e < 2; ++e) { const f32x4 w4 = *(const f32x4*)(PR + PS + ro + 8 * k8 + 4 * e), b4 = *(const f32x4*)(PR + 5 * PS + ro + 8 * k8 + 4 * e),
                                              k4 = *(const f32x4*)(PR + 2 * PS + ro + 8 * k8 + 4 * e), r4 = *(const f32x4*)(PR + ro + 8 * k8 + 4 * e);
        S[e] = S[e] * w4 + k4 * vv - b4 * u;
        y += (S[e][0] * r4[0] + S[e][1] * r4[1]) + (S[e][2] * r4[2] + S[e][3] * r4[3]);
        *(f32x4*)(F.out + O_WKVS + so + 4 * e) = S[e]; }
    y += __shfl_xor(y, 1); y += __shfl_xor(y, 2); y += __shfl_xor(y, 4);
    if (k8 == 0) Y[ro + v] = y;
}

__device__ __forceinline__ void p2_post(Frame& F) {
    const int tid_ = tid_fresh(), lane_ = tid_ & 63, wave_ = __builtin_amdgcn_readfirstlane(tid_ >> 6); (void)lane_; (void)wave_;
    const float* PR = (const float*)(F.ws + WS_PR); constexpr size_t PS = PSTRIDE / 4;
    const float* Y = (const float*)(F.ws + WS_Y); bf16* OC = (bf16*)(F.ws + WS_OC);
    const int c = tid_;
    const float lw = INP(I_LNW)[c], lb = INP(I_LNB)[c], rk = INP(I_RK)[c];
    for (int row = ROW_SAMP + F.vcu; row < M_VALID; row += F.G) {
        const size_t o = (size_t)row * 512 + c;
        const float y = Y[o], r = PR[o], k = PR[2 * PS + o], v = PR[3 * PS + o], g = PR[6 * PS + o];
        const float mu = wave_sum(y) * (1.f / 64.f), d = y - mu, var = wave_sum(d * d) * (1.f / 64.f);
        const float yn = d * (1.0f / sqrtf(var + GN_EPS)) * lw + lb;
        const float bonus = wave_sum(r * k * rk) * v;
        const float ov = (yn + bonus) * g;
        const float on = __shfl_down(ov, 1);
        if ((lane_ & 1) == 0) *(unsigned*)(OC + (size_t)row * 1024 + c) = pk2(ov, on);
    }
}
__device__ __forceinline__ void p2_decode_combine(Frame& F, int bt) {
    const int tid_ = tid_fresh(), lane_ = tid_ & 63, wave_ = __builtin_amdgcn_readfirstlane(tid_ >> 6); (void)lane_; (void)wave_;
    const int h = wave_, d = lane_;
    const float* QS = (const float*)(F.ws + WS_QS); const float* PART = (const float*)(F.ws + WS_PART) + (size_t)(bt * NSPLIT * NH + h) * PART_STRIDE;
    const float* LF = (const float*)(F.ws + WS_LF); bf16* OC = (bf16*)(F.ws + WS_OC);
    const float kn = F.out[O_KS + (size_t)bt * 512 + h * 64 + d], vn = F.out[O_VS + (size_t)bt * 512 + h * 64 + d], qn = QS[(size_t)bt * 512 + h * 64 + d];
    const float snew = wave_sum(qn * kn) * 0.125f;
    float off = LF[(size_t)(ROW_SAMP + bt) * 8 + h];
    const float* PART2 = (const float*)(F.ws + WS_PART2) + (size_t)(bt * NSPLIT * NH + h) * PART_STRIDE;
    float Ms[2 * NSPLIT]; float M = snew;
#pragma unroll
    for (int j = 2 * NSPLIT - 1; j >= 0; --j) { const float* P = ((j & 1) ? PART2 : PART) + (size_t)(j >> 1) * NH * PART_STRIDE; Ms[j] = P[0] + P[2] + off; off += P[2]; M = fmaxf(M, Ms[j]); }
    float w = __expf(snew - M), L = w, o = w * vn;
#pragma unroll
    for (int j = 0; j < 2 * NSPLIT; ++j) { const float* P = ((j & 1) ? PART2 : PART) + (size_t)(j >> 1) * NH * PART_STRIDE; w = __expf(Ms[j] - M); L += w * P[1]; o += w * P[16 + d]; }
    const float ov = o / L, on = __shfl_down(ov, 1);
    if ((d & 1) == 0) *(unsigned*)(OC + (size_t)(ROW_SAMP + bt) * 1024 + 512 + h * 64 + d) = pk2(ov, on);
}

__device__ __forceinline__ void p6_norm_final(Frame& F) {
    const int tid_ = tid_fresh(), lane_ = tid_ & 63, wave_ = __builtin_amdgcn_readfirstlane(tid_ >> 6);
    const int gw = F.vcu * NWAVES + wave_, NGW = F.G * NWAVES;
    const bf16* XB = (const bf16*)(F.ws + WS_X1);
    const float* gf = INP(I_NFIN);
    const f32x4 g0 = *(const f32x4*)(gf + 8 * lane_), g1 = *(const f32x4*)(gf + 8 * lane_ + 4), g2 = *(const f32x4*)(gf + 512 + 8 * lane_), g3 = *(const f32x4*)(gf + 516 + 8 * lane_);
    for (int m = gw; m < M_VALID; m += NGW) {
        if (m >= M_REAL && m < ROW_SAMP) continue;
        const v4u wa = *(const v4u*)(XB + (size_t)m * DMOD + 8 * lane_), wb = *(const v4u*)(XB + (size_t)m * DMOD + 512 + 8 * lane_);
        const f32x4 v0 = {bflo(wa.x), bfhi(wa.x), bflo(wa.y), bfhi(wa.y)}, v1 = {bflo(wa.z), bfhi(wa.z), bflo(wa.w), bfhi(wa.w)}, v2 = {bflo(wb.x), bfhi(wb.x), bflo(wb.y), bfhi(wb.y)}, v3 = {bflo(wb.z), bfhi(wb.z), bflo(wb.w), bfhi(wb.w)};
        const f32x4 sq = (v0 * v0 + v1 * v1) + (v2 * v2 + v3 * v3);
        const float rstd = 1.0f / sqrtf(wave_sum((sq[0] + sq[1]) + (sq[2] + sq[3])) * (1.f / DMOD) + RMS_EPS);
        float* o = F.out + (m < M_REAL ? O_YP + (size_t)m * DMOD : O_YS + (size_t)(m - ROW_SAMP) * DMOD);
        *(f32x4*)(o + 8 * lane_) = v0 * rstd * g0; *(f32x4*)(o + 8 * lane_ + 4) = v1 * rstd * g1; *(f32x4*)(o + 512 + 8 * lane_) = v2 * rstd * g2; *(f32x4*)(o + 516 + 8 * lane_) = v3 * rstd * g3;
    }
}

constexpr int NCH = 129, NUNIT = 16 * NCH, TPB = 72;
constexpr int RA_KK = 0, RA_BB = 9216, RA_KT = 18432, RA_RT = 27648, RA_KET = 36864, RA_BET = 46080, RA_VMT = 55296, RA_AB = 64512, RA_BM = 73728, RA_ARK = 82944, RA_ARB = 92160,
              RA_XT = 101376, RA_DIAG = 119808, RA_ZS = 123904, RA_GC = 134144, RA_SEG = 134400, RA_END = 136448;
constexpr int RA_ACTW = 0, RA_ACTA = 9216, RA_ACTG = 18432, RA_WLF = 64512, RA_ALF = 81920, RA_GLF = 99328, RA_GAM = 116736, RA_BVF = RA_BB;
constexpr int FP = 68, ZP = 20, GP = 136;
static_assert(RA_END <= RING_BYTES && RA_GAM + 64 * FP * 4 <= RA_GC && RA_ACTG + 64 * GP * 2 <= RA_AB, "rwkv chunk LDS map");
constexpr size_t UE = 4096;

__device__ __forceinline__ int chunk_row(int b, int c, int t) { return c == 0 ? (t < NMETA ? ROW_META + t : -1) : b * TREAL + 64 * (c - 1) + t; }
#define FRAG_L(base, pitch, row, k) (*(const LAS bf16x8*)((const LAS bf16*)(base) + (row) * (pitch) + (k)))
#define FRAG_G(base, pitch, row, k) (*(const bf16x8*)((const bf16*)(base) + (size_t)(row) * (pitch) + (k)))
#define MMA16(acc, af, bf_) acc = __builtin_amdgcn_mfma_f32_16x16x32_bf16(af, bf_, acc, 0, 0, 0)
__device__ __forceinline__ f32x4 prod_ll(const LAS unsigned char* X, const LAS unsigned char* Y, int r0, int c0, int l15, int kg, f32x4 acc) {
#pragma unroll
    for (int k0 = 0; k0 < 64; k0 += 32) MMA16(acc, FRAG_L(Y, TPB, c0 + l15, k0 + 8 * kg), FRAG_L(X, TPB, r0 + l15, k0 + 8 * kg));
    return acc;
}
__device__ __forceinline__ v2u pk4(f32x4 v) { v2u w; w.x = pk2(v[0], v[1]); w.y = pk2(v[2], v[3]); return w; }
__device__ __forceinline__ f32x4 unpk4(v2u w) { return (f32x4){bflo(w.x), bfhi(w.x), bflo(w.y), bfhi(w.y)}; }
__device__ __forceinline__ float fsig(float x) { return __builtin_amdgcn_rcpf(1.0f + __builtin_amdgcn_exp2f(-LOG2E * x)); }
struct F8 { f32x4 a, b; };
__device__ __forceinline__ F8 ld8(const float* p) { F8 r; r.a = *(const f32x4*)p; r.b = *(const f32x4*)(p + 4); return r; }
__device__ __forceinline__ F8 ld8b(const bf16* p) { const v4u w = *(const v4u*)p; F8 r; r.a = (f32x4){bflo(w.x), bfhi(w.x), bflo(w.y), bfhi(w.y)}; r.b = (f32x4){bflo(w.z), bfhi(w.z), bflo(w.w), bfhi(w.w)}; return r; }
__device__ __forceinline__ F8 ld8l(const LAS float* p) { F8 r; r.a = *(const LAS f32x4*)p; r.b = *(const LAS f32x4*)(p + 4); return r; }
__device__ __forceinline__ float f8g(const F8& x, int e) { return e < 4 ? x.a[e] : x.b[e - 4]; }
__device__ __forceinline__ v4u pk8(const float (&v)[8]) { v4u w; w.x = pk2(v[0], v[1]); w.y = pk2(v[2], v[3]); w.z = pk2(v[4], v[5]); w.w = pk2(v[6], v[7]); return w; }

#define LBAR() asm volatile("s_waitcnt lgkmcnt(0)\n\ts_barrier" ::: "memory")
constexpr int DLIM = 32;
struct DecS { f32x4 k[4], v[4]; float lf; };
struct DecCtx { f32x4 q4, o4; float m, l, csum; int pgv, c; };
__device__ __forceinline__ void decs_load(const Frame& F, DecS& B, const DecCtx& D, int c, int hd, int lane) {
    const int kq = lane & 15, g = lane >> 4;
    const int page = __builtin_amdgcn_readlane(D.pgv, c >> 3), pos0 = (c & 7) * 16;
    const size_t off = (size_t)page * (PAGE * 512) + hd * 64 + 4 * kq + (size_t)(pos0 + g) * 512;
    const float* Kp = F.in[I_CK] + off; const float* Vp = F.in[I_CV] + off;
#pragma unroll
    for (int i = 0; i < 4; ++i) B.k[i] = __builtin_nontemporal_load((const f32x4*)(Kp + (size_t)(4 * i) * 512));
#pragma unroll
    for (int i = 0; i < 4; ++i) B.v[i] = __builtin_nontemporal_load((const f32x4*)(Vp + (size_t)(4 * i) * 512));
    B.lf = F.in[I_CLF][(size_t)page * (PAGE * 8) + (size_t)(pos0 + kq) * 8 + hd];
}
__device__ __forceinline__ void decs_use(const DecS& B, DecCtx& D, int lane) {
    const int kq = lane & 15, g = lane >> 4;
    float smine = 0.f;
#pragma unroll
    for (int i = 0; i < 4; ++i) { float d = (B.k[i][0] * D.q4[0] + B.k[i][1] * D.q4[1]) + (B.k[i][2] * D.q4[2] + B.k[i][3] * D.q4[3]);
        d = red16(d); smine = ((kq & 3) == i) ? d : smine; }
    float inc = B.lf;
    inc += dpp_f<0x111>(inc); inc += dpp_f<0x112>(inc); inc += dpp_f<0x114>(inc); inc += dpp_f<0x118>(inc);
    const float cpos = __shfl(inc, 4 * (kq & 3) + g);
    const float ctot = __uint_as_float(__builtin_amdgcn_readlane(__float_as_uint(inc), 15));
    const float s = smine - (D.csum + cpos);
    D.csum += ctot;
    const float mc = wred_max(s), mn = fmaxf(D.m, mc), alpha = __expf(D.m - mn), p = __expf(s - mn);
    D.l = D.l * alpha + 0.25f * wred_sum(p); D.m = mn; D.o4 = D.o4 * alpha;
    D.o4 += B.v[0] * dpp_f<0x00>(p); D.o4 += B.v[1] * dpp_f<0x55>(p); D.o4 += B.v[2] * dpp_f<0xAA>(p); D.o4 += B.v[3] * dpp_f<0xFF>(p);
}
__device__ __forceinline__ F8 unb(v4u w) { F8 r; r.a = (f32x4){bflo(w.x), bfhi(w.x), bflo(w.y), bfhi(w.y)}; r.b = (f32x4){bflo(w.z), bfhi(w.z), bflo(w.w), bfhi(w.w)}; return r; }
struct RaPre { v4u cw, pw, ca, pa, cg0, pg0, cg1, pg1; };
__device__ __forceinline__ void ra_prefetch(Frame& F, int u, RaPre& P) {
    const int tid = tid_fresh(); const int bh = u / NCH, c = u - bh * NCH, b = bh >> 3, h = bh & 7, t = tid >> 3, j8 = tid & 7, row = chunk_row(b, c, t);
    const bf16* UR = (const bf16*)(F.ws + WS_UR);
    const bf16* zr = (const bf16*)(F.ctl + CW_ZERO);
    const bf16* cur = row >= 0 ? UR + (size_t)row * DSHIFT : zr; const bf16* prv = row >= 0 ? prev_row(F, UR, row) : zr; (void)h;
    P.cw = *(const v4u*)(cur + 1536 + 8 * j8); P.pw = *(const v4u*)(prv + 1536 + 8 * j8); P.ca = *(const v4u*)(cur + 1600 + 8 * j8); P.pa = *(const v4u*)(prv + 1600 + 8 * j8);
    P.cg0 = *(const v4u*)(cur + 1664 + 16 * j8); P.pg0 = *(const v4u*)(prv + 1664 + 16 * j8); P.cg1 = *(const v4u*)(cur + 1672 + 16 * j8); P.pg1 = *(const v4u*)(prv + 1672 + 16 * j8);
}
__device__ __forceinline__ void rwkv_chunk_unit(Frame& F, int u, const RaPre& P, int un, RaPre& Pn, int uprev, DecCtx& D, DecS& DA) {
    const int tid = tid_fresh(), lane = tid & 63, wave = __builtin_amdgcn_readfirstlane(tid >> 6), l15 = lane & 15, kg = lane >> 4;
    const int bh = u / NCH, c = u - bh * NCH, b = bh >> 3, h = bh & 7;
    const int dc0 = D.c; const bool dgo = dc0 + 4 <= DLIM; DecS DB;
    LAS unsigned char* L = F.lds + RING_OFF;
    const int t = tid >> 3, j8 = tid & 7;
    const int row = chunk_row(b, c, t);
    const float* mu = INP(I_MU);
    const int r0 = 16 * (wave >> 1), cb = 32 * (wave & 1);
    float vr[8], vk2[8], vv[8], vkk[8], vb[8];
    if (row >= 0) {
        const int n0 = h * 64 + 8 * j8;
        const bf16* UR = (const bf16*)(F.ws + WS_UR); const bf16* cur = UR + (size_t)row * DSHIFT; const bf16* prv = prev_row(F, UR, row);
        const F8 cr = ld8b(cur + n0), pr = ld8b(prv + n0), mr = ld8(mu + n0), ck = ld8b(cur + 512 + n0), pk = ld8b(prv + 512 + n0), mk = ld8(mu + 512 + n0), cv = ld8b(cur + 1024 + n0), pv = ld8b(prv + 1024 + n0), mv = ld8(mu + 1024 + n0);
#pragma unroll
        for (int e = 0; e < 8; ++e) { const float ur = f8g(cr, e), uk = f8g(ck, e), uv = f8g(cv, e);
            vr[e] = ur + f8g(mr, e) * (f8g(pr, e) - ur); vk2[e] = uk + f8g(mk, e) * (f8g(pk, e) - uk); vv[e] = uv + f8g(mv, e) * (f8g(pv, e) - uv); }
    }
    LBAR();
    {
        float aw[8], aa[8], ag[16];
        if (row >= 0) {
            const F8 cw = unb(P.cw), pw = unb(P.pw), mw = ld8(mu + 1536 + 8 * j8);
            const F8 ca = unb(P.ca), pa = unb(P.pa), ma = ld8(mu + 1600 + 8 * j8);
#pragma unroll
            for (int e = 0; e < 8; ++e) { const float x = f8g(cw, e), y = f8g(ca, e); aw[e] = 2.0f * fsig(2.0f * (x + f8g(mw, e) * (f8g(pw, e) - x))) - 1.0f; aa[e] = y + f8g(ma, e) * (f8g(pa, e) - y); }
#pragma unroll
            for (int hh = 0; hh < 2; ++hh) { const F8 cg = unb(hh ? P.cg1 : P.cg0), pg = unb(hh ? P.pg1 : P.pg0), mg = ld8(mu + 1664 + 16 * j8 + 8 * hh);
#pragma unroll
                for (int e = 0; e < 8; ++e) { const float x = f8g(cg, e); ag[8 * hh + e] = fsig(x + f8g(mg, e) * (f8g(pg, e) - x)); } }
        } else {
#pragma unroll
            for (int e = 0; e < 8; ++e) { aw[e] = 0.f; aa[e] = 0.f; ag[e] = 0.f; ag[8 + e] = 0.f; }
        }
        v4u w; w.x = pk2(aw[0], aw[1]); w.y = pk2(aw[2], aw[3]); w.z = pk2(aw[4], aw[5]); w.w = pk2(aw[6], aw[7]);
        *(LAS v4u*)(L + RA_ACTW + (t * TPB + 8 * j8) * 2) = w;
        w.x = pk2(aa[0], aa[1]); w.y = pk2(aa[2], aa[3]); w.z = pk2(aa[4], aa[5]); w.w = pk2(aa[6], aa[7]);
        *(LAS v4u*)(L + RA_ACTA + (t * TPB + 8 * j8) * 2) = w;
        w.x = pk2(ag[0], ag[1]); w.y = pk2(ag[2], ag[3]); w.z = pk2(ag[4], ag[5]); w.w = pk2(ag[6], ag[7]);
        *(LAS v4u*)(L + RA_ACTG + (t * GP + 16 * j8) * 2) = w;
        w.x = pk2(ag[8], ag[9]); w.y = pk2(ag[10], ag[11]); w.z = pk2(ag[12], ag[13]); w.w = pk2(ag[14], ag[15]);
        *(LAS v4u*)(L + RA_ACTG + (t * GP + 16 * j8 + 8) * 2) = w;
    }
    LBAR();
    {
        const bf16* WdT = (const bf16*)(F.ws + WS_WDT) + (size_t)h * 64 * 64; const bf16* WaT = (const bf16*)(F.ws + WS_WAT) + (size_t)h * 64 * 64; const bf16* WgT = (const bf16*)(F.ws + WS_WGT) + (size_t)h * 64 * 128;
#pragma unroll
        for (int q = 0; q < 2; ++q) { const int c0 = cb + 16 * q; f32x4 xw = {0.f, 0.f, 0.f, 0.f}, xa = xw, xg = xw;
#pragma unroll
            for (int k0 = 0; k0 < 64; k0 += 32) { MMA16(xw, FRAG_G(WdT, 64, c0 + l15, k0 + 8 * kg), FRAG_L(L + RA_ACTW, TPB, r0 + l15, k0 + 8 * kg));
                                                  MMA16(xa, FRAG_G(WaT, 64, c0 + l15, k0 + 8 * kg), FRAG_L(L + RA_ACTA, TPB, r0 + l15, k0 + 8 * kg)); }
#pragma unroll
            for (int k0 = 0; k0 < 128; k0 += 32) MMA16(xg, FRAG_G(WgT, 128, c0 + l15, k0 + 8 * kg), FRAG_L(L + RA_ACTG, GP, r0 + l15, k0 + 8 * kg));
            const int o = ((r0 + l15) * FP + c0 + 4 * kg) * 4;
            *(LAS f32x4*)(L + RA_WLF + o) = xw; *(LAS f32x4*)(L + RA_ALF + o) = xa; *(LAS f32x4*)(L + RA_GLF + o) = xg; }
    }
    LBAR();
    asm volatile("s_waitcnt vmcnt(0)" ::: "memory");
    {
        const int n0 = h * 64 + 8 * j8;
        float wv[8], g1[8], g2[8];
        if (row >= 0) {
            const F8 w0 = ld8(INP(I_W0) + n0), a0 = ld8(INP(I_A0) + n0), kkc = ld8(INP(I_KK) + n0), kac = ld8(INP(I_KA) + n0), rkc = ld8(INP(I_RK) + n0), lw = ld8(INP(I_LNW) + n0), lb = ld8(INP(I_LNB) + n0);
            const F8 wl = ld8l((const LAS float*)(L + RA_WLF) + t * FP + 8 * j8), al_ = ld8l((const LAS float*)(L + RA_ALF) + t * FP + 8 * j8), gl = ld8l((const LAS float*)(L + RA_GLF) + t * FP + 8 * j8);
            float nrm = 0.f, bs = 0.f, av[8], gv[8];
#pragma unroll
            for (int e = 0; e < 8; ++e) {
                const float r = vr[e], k = vk2[e], v = vv[e];
                const float x = f8g(w0, e) + f8g(wl, e);
                wv[e] = __builtin_amdgcn_exp2f(-(0.60653066f * LOG2E) * fsig(x));
                const float a = fsig(f8g(a0, e) + f8g(al_, e));
                const float kr = k * f8g(kkc, e), k2 = k * (1.0f + (a - 1.0f) * f8g(kac, e));
                nrm += kr * kr; bs += r * k2 * f8g(rkc, e);
                vr[e] = r; vk2[e] = k2; vv[e] = v; vkk[e] = kr; av[e] = a; gv[e] = f8g(gl, e);
            }
            nrm += __shfl_xor(nrm, 1); nrm += __shfl_xor(nrm, 2); nrm += __shfl_xor(nrm, 4);
            bs += __shfl_xor(bs, 1); bs += __shfl_xor(bs, 2); bs += __shfl_xor(bs, 4);
            const float rn = __builtin_amdgcn_rsqf(fmaxf(nrm, 1e-24f));
#pragma unroll
            for (int e = 0; e < 8; ++e) { vkk[e] *= rn; vb[e] = vkk[e] * av[e]; g1[e] = f8g(lw, e) * gv[e]; g2[e] = (f8g(lb, e) + bs * vv[e]) * gv[e]; }
        } else {
#pragma unroll
            for (int e = 0; e < 8; ++e) { vr[e] = 0.f; vk2[e] = 0.f; vv[e] = 0.f; vkk[e] = 0.f; vb[e] = 0.f; wv[e] = 1.0f; g1[e] = 0.f; g2[e] = 0.f; }
        }
        LAS float* gm = (LAS float*)(L + RA_GAM) + t * FP + 8 * j8;
        *(LAS f32x4*)gm = (f32x4){wv[0], wv[1], wv[2], wv[3]}; *(LAS f32x4*)(gm + 4) = (f32x4){wv[4], wv[5], wv[6], wv[7]};
        *(v4u*)((bf16*)(F.ws + WS_G1G) + (size_t)u * UE + t * 64 + 8 * j8) = pk8(g1); *(v4u*)((bf16*)(F.ws + WS_G2G) + (size_t)u * UE + t * 64 + 8 * j8) = pk8(g2);
    }
    LBAR();
    if (dgo) { decs_load(F, DB, D, dc0 + 1, wave, lane); decs_use(DA, D, lane); decs_load(F, DA, D, dc0 + 2, wave, lane); }
    if (uprev >= 0 && tid == 0) __hip_atomic_store(F.ctl + CW_FLAG + 16 * uprev, 1u, __ATOMIC_RELAXED, __HIP_MEMORY_SCOPE_AGENT);
    {
        const int n = tid & 63, seg = tid >> 6; LAS float* G = (LAS float*)(L + RA_GAM); LAS float* SG = (LAS float*)(L + RA_SEG);
        float p = 1.0f, loc[8];
#pragma unroll
        for (int i = 0; i < 8; ++i) { p *= G[(8 * seg + i) * FP + n]; loc[i] = p; }
        SG[seg * 64 + n] = p;
        LBAR();
        float pre = 1.0f;
        for (int s = 0; s < seg; ++s) pre *= SG[s * 64 + n];
#pragma unroll
        for (int i = 0; i < 8; ++i) G[(8 * seg + i) * FP + n] = loc[i] * pre;
        if (seg == 7) ((LAS float*)(L + RA_GC))[n] = loc[7] * pre;
    }
    LBAR();
    {
        const LAS float* G = (const LAS float*)(L + RA_GAM);
        const F8 gt = ld8l(G + t * FP + 8 * j8), gc = ld8l((const LAS float*)(L + RA_GC) + 8 * j8);
        F8 gp; if (t > 0) gp = ld8l(G + (t - 1) * FP + 8 * j8); else { gp.a = (f32x4){1.f, 1.f, 1.f, 1.f}; gp.b = gp.a; }
        float xkk[8], xbb[8], xkt[8], xrt[8], xke[8], xbe[8];
#pragma unroll
        for (int e = 0; e < 8; ++e) { const float g = f8g(gt, e), rg = __builtin_amdgcn_rcpf(g), ce = f8g(gc, e) * rg;
            xkk[e] = vkk[e] * f8g(gp, e); xbb[e] = vb[e] * rg; xkt[e] = vk2[e] * rg; xrt[e] = vr[e] * g; xke[e] = vk2[e] * ce; xbe[e] = vb[e] * ce; }
        const int o = (t * TPB + 8 * j8) * 2;
        *(LAS v4u*)(L + RA_KK + o) = pk8(xkk); *(LAS v4u*)(L + RA_BB + o) = pk8(xbb); *(LAS v4u*)(L + RA_KT + o) = pk8(xkt); *(LAS v4u*)(L + RA_RT + o) = pk8(xrt);
        *(LAS v4u*)(L + RA_AB + o) = pk8(xke); *(LAS v4u*)(L + RA_BM + o) = pk8(xbe); *(LAS v4u*)(L + RA_ARK + o) = pk8(vv);
    }
    LBAR();
    if (un < NUNIT) ra_prefetch(F, un, Pn);
    {
        const int n = tid & 63, t8 = tid >> 6;
#pragma unroll
        for (int q = 0; q < 3; ++q) { const LAS unsigned short* src = (const LAS unsigned short*)(L + (q == 0 ? RA_AB : q == 1 ? RA_BM : RA_ARK)) + (8 * t8) * TPB + n;
            v4u w; w.x = (unsigned)src[0] | ((unsigned)src[TPB] << 16); w.y = (unsigned)src[2 * TPB] | ((unsigned)src[3 * TPB] << 16); w.z = (unsigned)src[4 * TPB] | ((unsigned)src[5 * TPB] << 16); w.w = (unsigned)src[6 * TPB] | ((unsigned)src[7 * TPB] << 16);
            *(LAS v4u*)(L + (q == 0 ? RA_KET : q == 1 ? RA_BET : RA_VMT) + (n * TPB + 8 * t8) * 2) = w; }
    }
    LBAR();
#pragma unroll
    for (int q = 0; q < 2; ++q) { const int c0 = cb + 16 * q, tt = r0 + l15, i0 = c0 + 4 * kg; const f32x4 z = {0.f, 0.f, 0.f, 0.f};
        f32x4 a = prod_ll(L + RA_KK, L + RA_BB, r0, c0, l15, kg, z), bm = prod_ll(L + RA_KK, L + RA_KT, r0, c0, l15, kg, z),
              rk = prod_ll(L + RA_RT, L + RA_KT, r0, c0, l15, kg, z), rb = prod_ll(L + RA_RT, L + RA_BB, r0, c0, l15, kg, z);
#pragma unroll
        for (int e = 0; e < 4; ++e) { const bool st = (i0 + e) < tt, le = (i0 + e) <= tt; a[e] = st ? a[e] : 0.f; bm[e] = st ? bm[e] : 0.f; rk[e] = le ? rk[e] : 0.f; rb[e] = le ? rb[e] : 0.f; }
        const int o = (tt * TPB + i0) * 2;
        *(LAS v2u*)(L + RA_AB + o) = pk4(a); *(LAS v2u*)(L + RA_BM + o) = pk4(bm); *(LAS v2u*)(L + RA_ARK + o) = pk4(rk); *(LAS v2u*)(L + RA_ARB + o) = pk4(rb);
        if (c0 == r0) *(LAS f32x4*)(L + RA_DIAG + (((r0 >> 4) * 16 + l15) * 16 + 4 * kg) * 4) = a;
    }
    for (int i = tid; i < 128 * TPB * 2 / 16; i += NTHR) *(LAS v4u*)(L + RA_XT + i * 16) = (v4u){0u, 0u, 0u, 0u};
    if (dgo) { decs_use(DB, D, lane); decs_load(F, DB, D, dc0 + 3, wave, lane); }
    LBAR();
#pragma unroll
    for (int q = 0; q < 2; ++q) { const int c0 = cb + 16 * q; const f32x4 bv = prod_ll(L + RA_BM, L + RA_VMT, r0, c0, l15, kg, (f32x4){0.f, 0.f, 0.f, 0.f});
        *(LAS f32x4*)(L + RA_BVF + ((r0 + l15) * FP + c0 + 4 * kg) * 4) = bv; }
    LBAR();
    if (wave < 4 && lane < 16) { const LAS float* Dg = (const LAS float*)(L + RA_DIAG) + wave * 256; float x[16];
#pragma unroll
        for (int i = 0; i < 16; ++i) { float s = (i == lane) ? 1.0f : 0.0f;
#pragma unroll
            for (int jj = 0; jj < i; ++jj) s -= Dg[i * 16 + jj] * x[jj];
            x[i] = s; }
#pragma unroll
        for (int i = 0; i < 16; ++i) { LAS unsigned short* tp = (LAS unsigned short*)(L + RA_BM) + (wave * 16 + i) * 32; tp[lane] = (unsigned short)f2bf(x[i]); tp[16 + lane] = 0; } }
    for (int i = tid; i < 128 * 32 * 2 / 16; i += NTHR) *(LAS v4u*)(L + RA_ZS + i * 16) = (v4u){0u, 0u, 0u, 0u};
    if (dgo) { decs_use(DA, D, lane); if (dc0 + 4 < DLIM) decs_load(F, DA, D, dc0 + 4, wave, lane); }
    LBAR();
    for (int p = 0; p < 4; ++p) {
        const int c0 = 16 * wave, tt = 16 * p + l15, cc = c0 + 4 * kg; f32x4 acc = {0.f, 0.f, 0.f, 0.f};
        if (p >= 1) MMA16(acc, FRAG_L(L + RA_XT, TPB, c0 + l15, 8 * kg), FRAG_L(L + RA_AB, TPB, tt, 8 * kg));
        if (p == 3) MMA16(acc, FRAG_L(L + RA_XT, TPB, c0 + l15, 32 + 8 * kg), FRAG_L(L + RA_AB, TPB, tt, 32 + 8 * kg));
        f32x4 rhs; if (wave < 4) rhs = unpk4(*(const LAS v2u*)(L + RA_KK + (tt * TPB + cc) * 2)); else rhs = *(const LAS f32x4*)(L + RA_BVF + (tt * FP + cc - 64) * 4);
        const f32x4 zv = rhs - acc; LAS unsigned short* ZT = (LAS unsigned short*)(L + RA_ZS);
#pragma unroll
        for (int e = 0; e < 4; ++e) ZT[(cc + e) * 32 + l15] = (unsigned short)f2bf(zv[e]);
        asm volatile("s_waitcnt lgkmcnt(0)" ::: "memory");
        f32x4 xa = {0.f, 0.f, 0.f, 0.f};
        MMA16(xa, FRAG_L(L + RA_ZS, 32, c0 + l15, 8 * kg), FRAG_L(L + RA_BM, 32, 16 * p + l15, 8 * kg));
        LAS unsigned short* XTs = (LAS unsigned short*)(L + RA_XT);
#pragma unroll
        for (int e = 0; e < 4; ++e) XTs[(cc + e) * TPB + 16 * p + l15] = (unsigned short)f2bf(xa[e]);
        asm volatile("s_waitcnt lgkmcnt(0)" ::: "memory");
    }
    if (dgo) { decs_use(DB, D, lane); D.c = dc0 + 4; }
    LBAR();
    {
        bf16* W2g = (bf16*)(F.ws + WS_W2G) + (size_t)u * UE; bf16* YLg = (bf16*)(F.ws + WS_YLG) + (size_t)u * UE; float* SLg = (float*)(F.ws + WS_SLG) + (size_t)u * UE;
        bf16* MTh = (bf16*)(F.ws + WS_MTH) + (size_t)u * UE; bf16* MTl = (bf16*)(F.ws + WS_MTL) + (size_t)u * UE;
        const LAS unsigned char* W1T = L + RA_XT; const LAS unsigned char* ULT = L + RA_XT + 64 * TPB * 2;
#pragma unroll
        for (int q = 0; q < 2; ++q) { const int c0 = cb + 16 * q, rr = r0 + l15, cc = c0 + 4 * kg; const f32x4 z = {0.f, 0.f, 0.f, 0.f};
            const f32x4 aw = prod_ll(L + RA_ARB, W1T, r0, c0, l15, kg, z);
            const f32x4 w2 = unpk4(*(const LAS v2u*)(L + RA_RT + (rr * TPB + cc) * 2)) - aw;
            *(v2u*)(W2g + rr * 64 + cc) = pk4(w2);
            const f32x4 yl = prod_ll(L + RA_ARK, L + RA_VMT, r0, c0, l15, kg, z) - prod_ll(L + RA_ARB, ULT, r0, c0, l15, kg, z);
            *(v2u*)(YLg + ((wave * 2 + q) * 64 + lane) * 4) = pk4(yl);
            f32x4 mt = prod_ll(L + RA_BET, W1T, r0, c0, l15, kg, z); const float gcv = ((const LAS float*)(L + RA_GC))[rr];
#pragma unroll
            for (int e = 0; e < 4; ++e) mt[e] = ((cc + e) == rr ? gcv : 0.f) - mt[e];
            const v2u mh = pk4(mt); const f32x4 mres = mt - unpk4(mh);
            { const v2u ml = pk4(mres);
              __hip_atomic_store((unsigned long long*)(MTh + rr * 64 + cc), (unsigned long long)mh.x | ((unsigned long long)mh.y << 32), __ATOMIC_RELAXED, __HIP_MEMORY_SCOPE_AGENT);
              __hip_atomic_store((unsigned long long*)(MTl + rr * 64 + cc), (unsigned long long)ml.x | ((unsigned long long)ml.y << 32), __ATOMIC_RELAXED, __HIP_MEMORY_SCOPE_AGENT); }
            const f32x4 sl = prod_ll(L + RA_VMT, L + RA_KET, r0, c0, l15, kg, z) - prod_ll(ULT, L + RA_BET, r0, c0, l15, kg, z);
            { unsigned long long* sp_ = (unsigned long long*)(SLg + ((wave * 2 + q) * 64 + lane) * 4);
              __hip_atomic_store(sp_, (unsigned long long)__float_as_uint(sl[0]) | ((unsigned long long)__float_as_uint(sl[1]) << 32), __ATOMIC_RELAXED, __HIP_MEMORY_SCOPE_AGENT);
              __hip_atomic_store(sp_ + 1, (unsigned long long)__float_as_uint(sl[2]) | ((unsigned long long)__float_as_uint(sl[3]) << 32), __ATOMIC_RELAXED, __HIP_MEMORY_SCOPE_AGENT); } }
    }
}

constexpr int RB_DEPTH = 4, RB_MT0 = 36864, RB_MTS = 18432;
struct RbSet { v4u mh, ml; f32x4 sl[2]; };
__device__ __forceinline__ void rwkv_chain(Frame& F, int bh) {
    const int tid = tid_fresh(), lane = tid & 63, wave = __builtin_amdgcn_readfirstlane(tid >> 6), l15 = lane & 15, kg = lane >> 4;
    const int r0 = 16 * (wave >> 1), cb = 32 * (wave & 1);
    const int mrow = 8 * wave + (lane >> 3), mpc = lane & 7;
    LAS unsigned char* L = F.lds + RING_OFF;
    bf16* S0g = (bf16*)(F.ws + WS_S0G);
    const bf16* MTh = (const bf16*)(F.ws + WS_MTH); const bf16* MTl = (const bf16*)(F.ws + WS_MTL); const float* SLg = (const float*)(F.ws + WS_SLG);
    __syncthreads();
    for (int i = tid; i < 4 * 9216 / 16; i += NTHR) *(LAS v4u*)(L + i * 16) = (v4u){0u, 0u, 0u, 0u};
    for (int i = tid; i < 4096 / 8; i += NTHR) *(v4u*)(S0g + (size_t)(bh * NCH) * UE + i * 8) = (v4u){0u, 0u, 0u, 0u};
    RbSet R[RB_DEPTH];
#define RB_WAITN(first, n) do { const int cc_ = (first) + (lane & 7); gu32* fl_ = F.ctl + CW_FLAG + 16 * (bh * NCH + (cc_ < NCH ? cc_ : NCH - 1)); unsigned sp_ = 0u; \
        for (;;) { const unsigned v_ = ((lane & 7) < (n) && cc_ < NCH) ? __hip_atomic_load(fl_, __ATOMIC_RELAXED, __HIP_MEMORY_SCOPE_AGENT) : 1u; if (__all(v_ != 0u)) break; __builtin_amdgcn_s_sleep(2); if (++sp_ > (1u << 20)) break; } \
        __builtin_amdgcn_fence(__ATOMIC_ACQUIRE, "agent"); } while (0)
#define RB_LOAD(S, uu) do { S.mh = *(const v4u*)(MTh + (size_t)(uu) * UE + mrow * 64 + mpc * 8); S.ml = *(const v4u*)(MTl + (size_t)(uu) * UE + mrow * 64 + mpc * 8); \
        _Pragma("unroll") for (int q = 0; q < 2; ++q) S.sl[q] = *(const f32x4*)(SLg + (size_t)(uu) * UE + ((wave * 2 + q) * 64 + lane) * 4); } while (0)
#define RB_PUT(S, slot) do { LAS unsigned char* d_ = L + RB_MT0 + (slot) * RB_MTS + (mrow * TPB + mpc * 8) * 2; *(LAS v4u*)d_ = S.mh; *(LAS v4u*)(d_ + 9216) = S.ml; } while (0)
    RB_WAITN(0, RB_DEPTH);
#pragma unroll
    for (int d = 0; d < RB_DEPTH; ++d) RB_LOAD(R[d], bh * NCH + d);
    RB_PUT(R[0], 0);
    __syncthreads();
#define RB_STEP(S, SN, c) do { const int u = bh * NCH + (c), cur = (c) & 1, nxt = cur ^ 1; \
        const LAS unsigned char* SH = L + cur * 18432; const LAS unsigned char* SL = SH + 9216; const LAS unsigned char* MH = L + RB_MT0 + cur * RB_MTS; const LAS unsigned char* ML = MH + 9216; f32x4 acc[2]; \
        _Pragma("unroll") for (int q = 0; q < 2; ++q) { const int c0 = cb + 16 * q; acc[q] = S.sl[q]; \
            _Pragma("unroll") for (int kk = 0; kk < 2; ++kk) { const bf16x8 bh_ = FRAG_L(SH, TPB, r0 + l15, 32 * kk + 8 * kg), bl_ = FRAG_L(SL, TPB, r0 + l15, 32 * kk + 8 * kg); \
                const bf16x8 ah_ = FRAG_L(MH, TPB, c0 + l15, 32 * kk + 8 * kg), al_ = FRAG_L(ML, TPB, c0 + l15, 32 * kk + 8 * kg); \
                MMA16(acc[q], al_, bh_); MMA16(acc[q], ah_, bl_); MMA16(acc[q], ah_, bh_); } } \
        if ((c) + 1 < NCH) RB_PUT(SN, nxt);                         \
        if ((c) + RB_DEPTH < NCH) RB_LOAD(S, u + RB_DEPTH); \
        _Pragma("unroll") for (int q = 0; q < 2; ++q) { const int rr = r0 + l15, cc = cb + 16 * q + 4 * kg; \
            const v2u hi = pk4(acc[q]); const f32x4 res = acc[q] - unpk4(hi); \
            *(LAS v2u*)(L + nxt * 18432 + (rr * TPB + cc) * 2) = hi; *(LAS v2u*)(L + nxt * 18432 + 9216 + (rr * TPB + cc) * 2) = pk4(res); \
            if ((c) + 1 < NCH) *(v2u*)(S0g + (size_t)(u + 1) * UE + rr * 64 + cc) = hi; \
            else *(f32x4*)(F.out + O_WKVP + ((size_t)(bh * 64 + rr) * 64 + cc)) = acc[q]; } \
        asm volatile("s_waitcnt lgkmcnt(0)\n\ts_barrier" ::: "memory"); } while (0)
    int c = 0;
    for (; c + RB_DEPTH <= NCH; c += RB_DEPTH) { if ((c & 7) == 0) RB_WAITN(c + RB_DEPTH, 8);
        RB_STEP(R[0], R[1], c); RB_STEP(R[1], R[2], c + 1); RB_STEP(R[2], R[3], c + 2); RB_STEP(R[3], R[0], c + 3); }
    if (c < NCH) { RB_STEP(R[0], R[1], c); ++c; }
    if (c < NCH) { RB_STEP(R[1], R[2], c); ++c; }
    if (c < NCH) { RB_STEP(R[2], R[3], c); ++c; }
    asm volatile("s_waitcnt vmcnt(0)" ::: "memory");
    __syncthreads();
#undef RB_LOAD
#undef RB_PUT
#undef RB_WAITN
#undef RB_STEP
}

struct RcPre { bf16x8 s0[2][2], w2[2]; v2u yl[2]; v4u g1, g2; };
__device__ __forceinline__ void rc_prefetch(Frame& F, int u, RcPre& P) {
    const int tid = tid_fresh(), lane = tid & 63, wave = __builtin_amdgcn_readfirstlane(tid >> 6), l15 = lane & 15, kg = lane >> 4;
    const int r0 = 16 * (wave >> 1), cb = 32 * (wave & 1), t = tid >> 3, j8 = tid & 7;
    const bf16* W2g = (const bf16*)(F.ws + WS_W2G) + (size_t)u * UE; const bf16* S0g = (const bf16*)(F.ws + WS_S0G) + (size_t)u * UE; const bf16* YLg = (const bf16*)(F.ws + WS_YLG) + (size_t)u * UE;
#pragma unroll
    for (int kk = 0; kk < 2; ++kk) { P.w2[kk] = FRAG_G(W2g, 64, r0 + l15, 32 * kk + 8 * kg);
#pragma unroll
        for (int q = 0; q < 2; ++q) P.s0[q][kk] = FRAG_G(S0g, 64, cb + 16 * q + l15, 32 * kk + 8 * kg); }
#pragma unroll
    for (int q = 0; q < 2; ++q) P.yl[q] = *(const v2u*)(YLg + ((wave * 2 + q) * 64 + lane) * 4);
    P.g1 = *(const v4u*)((const bf16*)(F.ws + WS_G1G) + (size_t)u * UE + t * 64 + 8 * j8); P.g2 = *(const v4u*)((const bf16*)(F.ws + WS_G2G) + (size_t)u * UE + t * 64 + 8 * j8);
}
__device__ __forceinline__ void rwkv_fix_unit(Frame& F, int u, const RcPre& P, int un, RcPre& Pn) {
    const int tid = tid_fresh(), lane = tid & 63, wave = __builtin_amdgcn_readfirstlane(tid >> 6), l15 = lane & 15, kg = lane >> 4;
    const int bh = u / NCH, c = u - bh * NCH, b = bh >> 3, h = bh & 7;
    const int r0 = 16 * (wave >> 1), cb = 32 * (wave & 1);
    LAS unsigned char* L = F.lds + RING_OFF;
    LBAR();
#pragma unroll
    for (int q = 0; q < 2; ++q) { const int c0 = cb + 16 * q; f32x4 acc = unpk4(P.yl[q]);
#pragma unroll
        for (int kk = 0; kk < 2; ++kk) MMA16(acc, P.s0[q][kk], P.w2[kk]);
        *(LAS f32x4*)(L + ((r0 + l15) * FP + c0 + 4 * kg) * 4) = acc; }
    const F8 g1 = unb(P.g1), g2 = unb(P.g2);
    if (un < NUNIT) rc_prefetch(F, un, Pn);
    LBAR();
    const int t = tid >> 3, j8 = tid & 7, row = chunk_row(b, c, t);
    const F8 y = ld8l((const LAS float*)L + t * FP + 8 * j8);
    float s = 0.f;
#pragma unroll
    for (int e = 0; e < 8; ++e) s += f8g(y, e);
    s += __shfl_xor(s, 1); s += __shfl_xor(s, 2); s += __shfl_xor(s, 4);
    const float mu = s * (1.f / 64.f); float q2 = 0.f;
#pragma unroll
    for (int e = 0; e < 8; ++e) { const float d = f8g(y, e) - mu; q2 += d * d; }
    q2 += __shfl_xor(q2, 1); q2 += __shfl_xor(q2, 2); q2 += __shfl_xor(q2, 4);
    const float rstd = 1.0f / sqrtf(q2 * (1.f / 64.f) + GN_EPS);
    float o[8];
#pragma unroll
    for (int e = 0; e < 8; ++e) o[e] = (f8g(y, e) - mu) * rstd * f8g(g1, e) + f8g(g2, e);
    if (row >= 0) *(v4u*)((bf16*)(F.ws + WS_OC) + (size_t)row * 1024 + h * 64 + 8 * j8) = pk8(o);
}


template <class Epi> __device__ __forceinline__ void skinny_gemm(Frame& F, const bf16* A, int lda, const bf16* Bt, int ldb, int K, int cbk, const Epi& epi) {
    const int tid = tid_fresh(), lane = tid & 63, wave = __builtin_amdgcn_readfirstlane(tid >> 6), l15 = lane & 15, kg = lane >> 4;
    LAS unsigned char* L = F.lds + RING_OFF;
    const bf16* Ar = A + (size_t)(ROW_META + l15) * lda + 8 * kg; const bf16* Br = Bt + (size_t)(16 * cbk + l15) * ldb + 8 * kg;
    const int kw = K >> 3, kbeg = wave * kw;
    f32x4 acc[3] = {{0.f, 0.f, 0.f, 0.f}, {0.f, 0.f, 0.f, 0.f}, {0.f, 0.f, 0.f, 0.f}};
#pragma unroll 8
    for (int k0 = kbeg; k0 < kbeg + kw; k0 += 32) {
        const bf16x8 wf = *(const bf16x8*)(Br + k0);
#pragma unroll
        for (int mt = 0; mt < 3; ++mt) { const bf16x8 af = *(const bf16x8*)(Ar + (size_t)(16 * mt) * lda + k0); MMA16(acc[mt], wf, af); }
    }
    __syncthreads();
#pragma unroll
    for (int mt = 0; mt < 3; ++mt) *(LAS f32x4*)(L + ((wave * 3 + mt) * 64 + lane) * 16) = acc[mt];
    __syncthreads();
    if (tid < 192) { const int mt = tid >> 6, ln = tid & 63; f32x4 s = {0.f, 0.f, 0.f, 0.f};
#pragma unroll
        for (int w = 0; w < 8; ++w) s += *(const LAS f32x4*)(L + ((w * 3 + mt) * 64 + ln) * 16);
        epi(16 * mt + (ln & 15), 16 * cbk + 4 * (ln >> 4), s); }
    __syncthreads();
}
struct SkBrA { bf16* TMP; const bf16* GB; __device__ __forceinline__ void operator()(int r, int c, f32x4 v) const { const size_t row = ROW_META + r; const v2u g = *(const v2u*)(GB + row * DG + c);
    v2u w; w.x = pk2(v[0] * bflo(g.x), v[1] * bfhi(g.x)); w.y = pk2(v[2] * bflo(g.y), v[3] * bfhi(g.y)); *(v2u*)(TMP + row * 1024 + c) = w; } };
struct SkBrB { const bf16* TMP; const bf16* GB; bf16* MG; __device__ __forceinline__ void operator()(int r, int c, f32x4 v) const { const size_t row = ROW_META + r; const v2u g = *(const v2u*)(GB + row * DG + 1024 + c);
    const f32x4 t = unpk4(*(const v2u*)(TMP + row * 1024 + c)); v2u w; w.x = pk2(t[0] + v[0] * bflo(g.x), t[1] + v[1] * bfhi(g.x)); w.y = pk2(t[2] + v[2] * bflo(g.y), t[3] + v[3] * bfhi(g.y)); *(v2u*)(MG + row * 1024 + c) = w; } };
struct SkOut { bf16* XB; float* SS48; const float* xm; const float* xs; int cbk; __device__ __forceinline__ void operator()(int r, int c, f32x4 v) const { const size_t row = ROW_META + r;
    const float* x = r < NMETA ? xm + (size_t)r * 1024 : xs + (size_t)(r - NMETA) * 1024; v += *(const f32x4*)(x + c);
    float ssq = (v[0] * v[0] + v[1] * v[1]) + (v[2] * v[2] + v[3] * v[3]); ssq += __shfl_xor(ssq, 16); ssq += __shfl_xor(ssq, 32);
    if ((c & 15) == 0) SS48[r * 64 + cbk] = ssq;
    v2u w; w.x = pk2(v[0], v[1]); w.y = pk2(v[2], v[3]); *(v2u*)(XB + row * 1024 + c) = w; } };
struct SkUp { bf16* HF; const float* SS48; __device__ __forceinline__ void operator()(int r, int c, f32x4 v) const { const size_t row = ROW_META + r;
    const f32x4* sp = (const f32x4*)(SS48 + r * 64); f32x4 s4 = sp[0];
#pragma unroll
    for (int i = 1; i < 16; ++i) s4 += sp[i];
    const float rstd = __builtin_amdgcn_rsqf(((s4[0] + s4[1]) + (s4[2] + s4[3])) * (1.f / 1024.f) + RMS_EPS);
    v = __builtin_elementwise_max(v * rstd, (f32x4){0.f, 0.f, 0.f, 0.f}); v = v * v;
    v2u w; w.x = pk2(v[0], v[1]); w.y = pk2(v[2], v[3]); *(v2u*)(HF + row * FF + c) = w; } };
struct SkDown { bf16* XB; __device__ __forceinline__ void operator()(int r, int c, f32x4 v) const { const size_t row = ROW_META + r; v += unpk4(*(const v2u*)(XB + row * 1024 + c));
    v2u w; w.x = pk2(v[0], v[1]); w.y = pk2(v[2], v[3]); *(v2u*)(XB + row * 1024 + c) = w; } };

__global__ void __launch_bounds__(NTHR, 2) fwd_kernel(Args args) {
    extern __shared__ __attribute__((aligned(16))) unsigned char lds[];
    Frame F;
    F.lds = (LAS unsigned char*)lds;
    F.MISC = (volatile LAS unsigned*)(F.lds + MISC_OFF);
    F.G = gridDim.x; { const int bx = blockIdx.x; F.vcu = (F.G % 8 == 0) ? (bx % 8) * (F.G / 8) + bx / 8 : bx; }
    F.ws = args.ws; F.out = args.out; F.ctl = (gu32*)(args.ws + WS_CTL);
#pragma unroll
    for (int i = 0; i < 30; ++i) F.in[i] = args.in[i];
    for (int u = threadIdx.x; u < (LDS_BYTES - LDSCTL_OFF) / 4; u += NTHR) ((LAS unsigned*)(F.lds + LDSCTL_OFF))[u] = 0u;
    __syncthreads();
    XcdBarrier bar = xcd_barrier_post((unsigned*)(F.ctl + CW_BAR), F.MISC + 8);
    unsigned char* ws = args.ws;
    using namespace pg8;

    p0_prologue(F);
    xcd_barrier(bar);

    if ((int)blockIdx.x >= (int)gridDim.x - 16) p1_cumsum(F, (int)blockIdx.x - ((int)gridDim.x - 16));
    {
        Gemm g{(const bf16_t*)(ws + WS_HN), (const bf16_t*)(ws + WS_WIN), M_PAD, N1, 1024, 1024}; StaticOrder S; S.init(M_PAD, N1, F.G, (int)blockIdx.x);
        EpiIn E{(bf16_t*)(ws + WS_UR), (bf16_t*)(ws + WS_QB), (bf16_t*)(ws + WS_KB), (bf16_t*)(ws + WS_VB), (bf16_t*)(ws + WS_GB), (float*)(ws + WS_QS), F.out};
        gemm_phase<EpiIn, StaticOrder, PG8_ALIGN, PG8_SP2>(F.lds + RING_OFF, g, S, E);
    }
    xcd_barrier(bar);

    {
        const int rank = F.vcu, NW_ = F.G;
#define RA_UNIT(i) (((i) & 15) * NCH + ((i) >> 4))
        RaPre PA, PB; int it = rank;
        DecCtx D; DecS DA;
        const int dlane = (int)threadIdx.x & 63, dwave = __builtin_amdgcn_readfirstlane((int)threadIdx.x >> 6); const bool ditem = F.vcu < NSAMP * NSPLIT;
        { const int bt = ditem ? F.vcu >> 3 : 0, sp = F.vcu & 7;
          D.q4 = *(const f32x4*)((const float*)(ws + WS_QS) + (size_t)bt * 512 + dwave * 64 + 4 * (dlane & 15)) * 0.125f; D.o4 = (f32x4){0.f, 0.f, 0.f, 0.f}; D.m = -1e30f; D.l = 0.f; D.csum = 0.f;
          D.pgv = ((const int*)INP(I_PT))[bt * NPAGES + sp * 8 + (dlane & 7)]; D.c = ditem ? 0 : DLIM;
          decs_load(F, DA, D, 0, dwave, dlane); }
        if (it < NUNIT) ra_prefetch(F, RA_UNIT(it), PA);
        int ulast = -1;
        for (; it < NUNIT; it += 2 * NW_) { rwkv_chunk_unit(F, RA_UNIT(it), PA, it + NW_ < NUNIT ? RA_UNIT(it + NW_) : NUNIT, PB, ulast, D, DA); ulast = RA_UNIT(it);
            if (it + NW_ < NUNIT) { rwkv_chunk_unit(F, RA_UNIT(it + NW_), PB, it + 2 * NW_ < NUNIT ? RA_UNIT(it + 2 * NW_) : NUNIT, PA, ulast, D, DA); ulast = RA_UNIT(it + NW_); } }
#undef RA_UNIT
        {
            while (D.c < DLIM) { decs_use(DA, D, dlane); if (D.c + 1 < DLIM) decs_load(F, DA, D, D.c + 1, dwave, dlane); D.c += 1; }
            if (ditem) { float* PART = (float*)(ws + WS_PART) + (size_t)(F.vcu * NH + dwave) * PART_STRIDE; f32x4 o4 = D.o4;
#pragma unroll
                for (int e = 0; e < 4; ++e) { float t = o4[e]; t += __shfl_xor(t, 16); t += __shfl_xor(t, 32); o4[e] = t; }
                if ((dlane >> 4) == 0) *(f32x4*)(PART + 16 + 4 * (dlane & 15)) = o4;
                if (dlane == 0) { PART[0] = D.m; PART[1] = D.l; PART[2] = D.csum; } }
        }
        asm volatile("s_waitcnt vmcnt(0)" ::: "memory"); __syncthreads();
        if (ulast >= 0 && threadIdx.x == 0) __hip_atomic_store(F.ctl + CW_FLAG + 16 * ulast, 1u, __ATOMIC_RELAXED, __HIP_MEMORY_SCOPE_AGENT);
        if (F.vcu == 1 || F.vcu == 2) { __syncthreads(); p2_prep(F, ROW_SAMP / 16 + F.vcu - 1); }
        if ((F.vcu & 15) == 0) { __syncthreads(); rwkv_chain(F, F.vcu >> 4); }
    }
    __syncthreads();
    if (F.vcu == F.G - 1) p2_meta_attn(F);
    __syncthreads();
    {
        const attn_body::bf16* Qp = (const attn_body::bf16*)(ws + WS_QB); const attn_body::bf16* Kp = (const attn_body::bf16*)(ws + WS_KB); const attn_body::bf16* Vp = (const attn_body::bf16*)(ws + WS_VB);
        attn_body::bf16* Op = (attn_body::bf16*)(ws + WS_OC); const float* NCLp = (const float*)(ws + WS_NCL);
        const int x0 = (int)(xb_xcc_id() & 7u);
        if (threadIdx.x == 0) F.MISC[1] = 0u;
        for (int kx = 0; kx < 8; ++kx) { const int x = (x0 + kx) & 7;
        if (kx == 1) {
            if (threadIdx.x < 8) { const unsigned hq = __hip_atomic_load(F.ctl + CW_QUEUE + 64 * (int)threadIdx.x, __ATOMIC_RELAXED, __HIP_MEMORY_SCOPE_AGENT);
                const unsigned long long bm = __ballot(hq >= 96u); if (threadIdx.x == 0) F.MISC[1] = (unsigned)(bm & 0xffull); }
        }
        __syncthreads();
        if (__builtin_amdgcn_readfirstlane((int)((F.MISC[1] >> x) & 1u))) { __syncthreads(); continue; }
        for (;;) {
            if (threadIdx.x == 0) F.MISC[0] = __hip_atomic_fetch_add(F.ctl + CW_QUEUE + 64 * x, 1u, __ATOMIC_RELAXED, __HIP_MEMORY_SCOPE_AGENT);
            __syncthreads();
            const int item = __builtin_amdgcn_readfirstlane((int)F.MISC[0]);
            __syncthreads();
            if (item >= 96) break;
            int ai; bool dec;
            if (item < 40) { dec = false; ai = item; }
            else if (item < 88) { const int j = item - 40, j3 = j / 3, jr = j - 3 * j3; if (jr != 2) { dec = true; ai = 2 * j3 + jr; } else { dec = false; ai = 40 + j3; } }
            else { dec = false; ai = item - 32; }
            if (dec) { if (32 * x + ai >= F.G) p2_decode_split(F, 32 * x + ai, 0); p2_decode_split(F, 32 * x + ai, 1); }
            else { const int qb = 31 - (ai >> 1), bhh = 2 * x + (ai & 1);
                attn_body::attn_unit<8>(bhh >> 3, bhh & 7, qb, Qp, Kp, Vp, Op, NCLp + (size_t)bhh * attn_body::BIASN, (char*)lds + RING_OFF); }
        } }
    }
    xcd_barrier(bar);

    if (F.vcu >= NSAMP) {
        RcPre QA, QB, QC; const int NR_ = F.G - NSAMP; int u = F.vcu - NSAMP;
        if (u < NUNIT) rc_prefetch(F, u, QA);
        if (u + NR_ < NUNIT) rc_prefetch(F, u + NR_, QB);
        for (; u < NUNIT; u += 3 * NR_) { rwkv_fix_unit(F, u, QA, u + 2 * NR_, QC);
            if (u + NR_ < NUNIT) rwkv_fix_unit(F, u + NR_, QB, u + 3 * NR_, QA);
            if (u + 2 * NR_ < NUNIT) rwkv_fix_unit(F, u + 2 * NR_, QC, u + 4 * NR_, QB); }
        asm volatile("s_waitcnt vmcnt(0)" ::: "memory"); __syncthreads();
    }
    if (F.vcu < NSAMP) {
        for (int hh = 0; hh < NH; ++hh) p2_scan_sample(F, F.vcu * NH + hh);
        asm volatile("s_waitcnt vmcnt(0)" ::: "memory"); __syncthreads();
        p2_post(F); p2_decode_combine(F, F.vcu); }
    xcd_barrier(bar);

    {
    if (F.vcu < 64) {
        skinny_gemm(F, (const bf16*)(ws + WS_OC), 1024, (const bf16*)(ws + WS_WBR), 1024, 512, F.vcu, SkBrA{(bf16*)(ws + WS_TMP), (const bf16*)(ws + WS_GB)});
        skinny_gemm(F, (const bf16*)(ws + WS_OC) + 512, 1024, (const bf16*)(ws + WS_WBR) + 512, 1024, 512, F.vcu, SkBrB{(const bf16*)(ws + WS_TMP), (const bf16*)(ws + WS_GB), (bf16*)(ws + WS_MG)});
    }
    {
        Gemm g{(const bf16_t*)(ws + WS_OC), (const bf16_t*)(ws + WS_WBR), M_REAL, 1024, 512, 1024}; StaticOrder S; S.init(M_REAL, 1024, F.G, (int)blockIdx.x);
        EpiBrA E{(bf16_t*)(ws + WS_TMP), (const bf16_t*)(ws + WS_GB)};
        gemm_phase<EpiBrA, StaticOrder, PG8_ALIGN, PG8_SP2>(F.lds + RING_OFF, g, S, E);
    }
    {
        Gemm g{(const bf16_t*)(ws + WS_OC) + 512, (const bf16_t*)(ws + WS_WBR) + 512, M_REAL, 1024, 512, 1024}; StaticOrder S; S.init(M_REAL, 1024, F.G, (int)blockIdx.x);
        EpiBrB E{(const bf16_t*)(ws + WS_TMP), (const bf16_t*)(ws + WS_GB), (bf16_t*)(ws + WS_MG)};
        gemm_phase<EpiBrB, StaticOrder, PG8_ALIGN, PG8_SP2>(F.lds + RING_OFF, g, S, E);
    }
        }
    xcd_barrier(bar);

    if (F.vcu < 64) skinny_gemm(F, (const bf16*)(ws + WS_MG), 1024, (const bf16*)(ws + WS_WOUT), 1024, 1024, F.vcu, SkOut{(bf16*)(ws + WS_X1), (float*)(ws + WS_SS48), INP(I_META), INP(I_XS), F.vcu});
    {
        Gemm g{(const bf16_t*)(ws + WS_MG), (const bf16_t*)(ws + WS_WOUT), M_REAL, 1024, 1024, 1024}; StaticOrder S; S.init(M_REAL, 1024, F.G, (int)blockIdx.x);
        EpiRes<false> E{(bf16_t*)(ws + WS_X1), (float*)(ws + WS_SS), INP(I_XP)};
        gemm_phase<EpiRes<false>, StaticOrder, PG8_ALIGN, PG8_SP2>(F.lds + RING_OFF, g, S, E);
    }
    xcd_barrier(bar);

    for (int cbk = F.vcu; cbk < FF / 16; cbk += F.G) skinny_gemm(F, (const bf16*)(ws + WS_X1), 1024, (const bf16*)(ws + WS_WUP), 1024, 1024, cbk, SkUp{(bf16*)(ws + WS_HF), (const float*)(ws + WS_SS48)});
    {
        Gemm g{(const bf16_t*)(ws + WS_X1), (const bf16_t*)(ws + WS_WUP), M_REAL, FF, 1024, 1024}; StaticOrder S; S.init(M_REAL, FF, F.G, (int)blockIdx.x);
        EpiUp E{(bf16_t*)(ws + WS_HF), (const float*)(ws + WS_SS)};
        gemm_phase<EpiUp, StaticOrder, PG8_ALIGN, PG8_SP2>(F.lds + RING_OFF, g, S, E);
    }
    xcd_barrier(bar);

    if (F.vcu < 64) skinny_gemm(F, (const bf16*)(ws + WS_HF), FF, (const bf16*)(ws + WS_WDN), FF, FF, F.vcu, SkDown{(bf16*)(ws + WS_X1)});
    {
        Gemm g{(const bf16_t*)(ws + WS_HF), (const bf16_t*)(ws + WS_WDN), M_REAL, 1024, FF, FF}; StaticOrder S; S.init(M_REAL, 1024, F.G, (int)blockIdx.x);
        EpiRes<true> E{(bf16_t*)(ws + WS_X1), nullptr, nullptr};
        gemm_phase<EpiRes<true>, StaticOrder, PG8_ALIGN, PG8_SP2>(F.lds + RING_OFF, g, S, E);
    }
    xcd_barrier(bar);

    p6_norm_final(F);
}

extern "C" void kernel_launch(void* const* d_in, const int* in_sizes, int n_in, void* d_out, int out_size, void* d_ws, size_t ws_size, hipStream_t stream) {
    static int grid = 0;
    if (grid == 0) {
        if (n_in != 30 || (size_t)out_size != O_END || ws_size < WS_END) { fprintf(stderr, "kernel_launch: unexpected sizes: n_in %d out %d ws %zu (need %zu)\n", n_in, out_size, ws_size, (size_t)WS_END); grid = -1; return; }
        int dev = 0, cus = 0, per_cu = 0;
        if (hipGetDevice(&dev) != hipSuccess || hipDeviceGetAttribute(&cus, hipDeviceAttributeMultiprocessorCount, dev) != hipSuccess) { grid = -1; return; }
        if (hipFuncSetAttribute((const void*)fwd_kernel, hipFuncAttributeMaxDynamicSharedMemorySize, LDS_BYTES) != hipSuccess) { fprintf(stderr, "kernel_launch: hipFuncSetAttribute failed\n"); grid = -1; return; }
        if (hipOccupancyMaxActiveBlocksPerMultiprocessor(&per_cu, (const void*)fwd_kernel, NTHR, LDS_BYTES) != hipSuccess || per_cu < 1) { fprintf(stderr, "kernel_launch: occupancy query says %d\n", per_cu); }
        (void)hipGetLastError();
        grid = cus;
        if (grid != 256) fprintf(stderr, "kernel_launch: grid %d (built for 256)\n", grid);
    }
    if (grid < 0) return;
    (void)in_sizes;
    if (hipMemsetAsync((char*)d_ws + WS_CTL, 0, CTL_ZERO_BYTES, stream) != hipSuccess) return;
    Args a{};
    for (int i = 0; i < 30; ++i) a.in[i] = (const float*)d_in[i];
    a.out = (float*)d_out; a.ws = (unsigned char*)d_ws;
    hipLaunchKernelGGL(fwd_kernel, dim3(grid), dim3(NTHR), LDS_BYTES, stream, a);
}
```

```cpp
#include <hip/hip_runtime.h>
#include <hip/hip_bf16.h>
#include <cstdio>
#include <cstdint>
#include <cmath>
__device__ __forceinline__ int tid_fresh() { int t = (int)threadIdx.x; asm volatile("" : "+v"(t)); return t; }
namespace pg8 {
#define PG8_LAS __attribute__((address_space(3)))
typedef unsigned short bf16_t;
typedef short bf16x8 __attribute__((ext_vector_type(8)));
typedef float f32x4 __attribute__((ext_vector_type(4)));
typedef unsigned u32x4 __attribute__((ext_vector_type(4)));
constexpr int BM = 256, BK = 64, HALF = 128, HTB = HALF * BK * 2  , STAGE_BYTES = 8 * HTB, NXCD = 8, WGM = 8;

__host__ __device__ __forceinline__ int lds_byte(int r, int c) { const int st = (r >> 4) * 2 + (c >> 5), rr = r & 15, cc = c & 31, ob = rr * 64 + cc * 2; return st * 1024 + (ob ^ (((ob >> 9) & 1) << 5)); }
__host__ __device__ __forceinline__ void stage_rc(int b, int& R, int& C) { const int st = b / 1024, sb = b % 1024, swz = sb ^ (((sb >> 9) & 1) << 5); R = (st >> 1) * 16 + swz / 64; C = (st & 1) * 32 + (swz % 64) / 2; }
__host__ __device__ __forceinline__ int perm32(int rho) { const int n = rho >> 4, i = rho & 15; return 8 * (i >> 2) + 4 * n + (i & 3); }

struct Unit { int pm, pn; };
struct Gemm { const bf16_t* A; const bf16_t* Bt; int M, N, K, ld; };

struct StaticOrder {
    int nM, nN, nwg, G, c;
    __host__ __device__ void init(int M, int N, int G_, int c_) { nM = M / BM; nN = N / BM; nwg = nM * nN; G = G_; c = c_; }
    __host__ __device__ bool next(int i, Unit& u) const {
        const long L = (long)i * G + c; if (L >= nwg) return false;
        int wgid = (int)L; { const int q = nwg / NXCD, r = nwg % NXCD, xcd = wgid % NXCD, off = wgid / NXCD; wgid = (xcd < r ? xcd * (q + 1) : r * (q + 1) + (xcd - r) * q) + off; }
        const int nig = WGM * nN, gid = wgid / nig, fm = gid * WGM, gsz = (nM - fm) < WGM ? (nM - fm) : WGM;
        u.pm = fm + ((wgid % nig) % gsz); u.pn = (wgid % nig) / gsz; return true;
    }
    __device__ __forceinline__ void a_ready(const Unit&) const {}
    __device__ __forceinline__ void done(const Unit&) const {}
};

typedef float f32x2c __attribute__((ext_vector_type(2))); typedef __bf16 bf16x2c __attribute__((ext_vector_type(2)));
__device__ __forceinline__ unsigned cvt_pk_bf16(float lo, float hi) { const f32x2c v = {lo, hi}; return __builtin_bit_cast(unsigned, __builtin_convertvector(v, bf16x2c)); }
typedef float f32x2 __attribute__((ext_vector_type(2)));
template <class Epi, class Sched, bool ALIGN_EPI = false, bool SP2 = false>
__device__ __forceinline__ void gemm_phase(PG8_LAS unsigned char* lds, const Gemm g, const Sched& S, const Epi& E) {
    const int tid = tid_fresh(), wid = __builtin_amdgcn_readfirstlane(tid >> 6), lane = tid & 63, wr = wid >> 2, wc = wid & 3, fr = lane & 15, fq = lane >> 4;
    const int K = g.K, nt = K / BK, LD = g.ld;
    unsigned voffA[2], voffB[2];
#pragma unroll
    for (int i = 0; i < 2; ++i) { int R, C; stage_rc(tid * 16 + i * 8192, R, C); const int Rb = Epi::PERM ? ((R & ~31) + perm32(R & 31)) : R;
        voffA[i] = (unsigned)(R * LD + C) * 2u; voffB[i] = (unsigned)(Rb * LD + C) * 2u; }
    const size_t kstep = (size_t)(BK * 2);
    const size_t hstep = (size_t)HALF * LD * 2;
    const size_t tstep = 2 * hstep;
    const unsigned ldsw = (unsigned)wid * 1024u;
    const int aoff = lds_byte(wr * 64 + fr, fq * 8), boff = lds_byte(wc * 32 + fr, fq * 8);
#define PG8_SA(b, h) (((b) * 2 + (h)) * HTB)
#define PG8_SB(b, h) ((4 + (b) * 2 + (h)) * HTB)
#define PG8_STAGE(bufoff, gbase, voff) do { _Pragma("unroll") for (int _i = 0; _i < 2; ++_i) \
        __builtin_amdgcn_global_load_lds((const unsigned*)((const char*)(gbase) + (voff)[_i]), (PG8_LAS unsigned*)(lds + (bufoff) + ldsw + _i * 8192), 16, 0, 0); } while (0)
#define PG8_LDA(dst, b, h) do { _Pragma("unroll") for (int m = 0; m < 4; ++m) _Pragma("unroll") for (int k = 0; k < 2; ++k) dst[m][k] = *(const PG8_LAS bf16x8*)(lds + PG8_SA(b, h) + aoff + m * 2048 + k * 1024); } while (0)
#define PG8_LDB(dst, b, h) do { _Pragma("unroll") for (int n = 0; n < 2; ++n) _Pragma("unroll") for (int k = 0; k < 2; ++k) dst[n][k] = *(const PG8_LAS bf16x8*)(lds + PG8_SB(b, h) + boff + n * 2048 + k * 1024); } while (0)
#define PG8_MMA(ai, bj, At, Bt) do { __builtin_amdgcn_s_setprio(1); _Pragma("unroll") for (int m = 0; m < 4; ++m) _Pragma("unroll") for (int n = 0; n < 2; ++n) _Pragma("unroll") for (int k = 0; k < 2; ++k) \
        acc[ai][bj][m][n] = __builtin_amdgcn_mfma_f32_16x16x32_bf16(Bt[n][k], At[m][k], acc[ai][bj][m][n], 0, 0, 0); __builtin_amdgcn_s_setprio(0); } while (0)
#define PG8_WAIT_V(n) asm volatile("s_waitcnt vmcnt(" #n ")" ::: "memory")
#define PG8_WAIT_L(n) asm volatile("s_waitcnt lgkmcnt(" #n ")" ::: "memory")
#define PG8_BAR __builtin_amdgcn_s_barrier()
#define PG8_SCHED __builtin_amdgcn_sched_barrier(0)
    Unit cur, nxt; int ui = 0;
    if (!S.next(0, cur)) return;
    f32x4 acc[2][2][4][2];
#pragma unroll
    for (int a = 0; a < 2; ++a)
#pragma unroll
        for (int b = 0; b < 2; ++b)
#pragma unroll
            for (int m = 0; m < 4; ++m)
#pragma unroll
                for (int n = 0; n < 2; ++n) acc[a][b][m][n] = (f32x4){0.f, 0.f, 0.f, 0.f};
    bf16x8 At[4][2], B0[2][2], B1[2][2];
    const char* cA = (const char*)g.A + (size_t)cur.pm * tstep; const char* cB = (const char*)g.Bt + (size_t)cur.pn * tstep;
    S.a_ready(cur);
    if constexpr (SP2) {
        PG8_STAGE(PG8_SB(0, 0), cB, voffB); PG8_STAGE(PG8_SB(0, 1), cB + hstep, voffB); PG8_STAGE(PG8_SA(0, 0), cA, voffA); PG8_STAGE(PG8_SA(0, 1), cA + hstep, voffA);
        if (wr == 1) PG8_BAR;
        PG8_WAIT_V(2); PG8_BAR;
        PG8_STAGE(PG8_SB(1, 0), cB + kstep, voffB); PG8_STAGE(PG8_SA(1, 0), cA + kstep, voffA); PG8_STAGE(PG8_SB(1, 1), cB + hstep + kstep, voffB);
        PG8_WAIT_V(6); PG8_BAR;
    } else {
        PG8_STAGE(PG8_SB(0, 0), cB, voffB); PG8_STAGE(PG8_SA(0, 0), cA, voffA); PG8_STAGE(PG8_SB(0, 1), cB + hstep, voffB); PG8_STAGE(PG8_SA(0, 1), cA + hstep, voffA);
        if (wr == 1) PG8_BAR;
        PG8_WAIT_V(4); PG8_BAR;
        PG8_STAGE(PG8_SB(1, 0), cB + kstep, voffB); PG8_STAGE(PG8_SA(1, 0), cA + kstep, voffA); PG8_STAGE(PG8_SB(1, 1), cB + hstep + kstep, voffB);
        PG8_WAIT_V(6); PG8_BAR;
    }
    for (;;) {
        const bool has_next = S.next(ui + 1, nxt);
        const char* nA = has_next ? (const char*)g.A + (size_t)nxt.pm * tstep : cA; const char* nB = has_next ? (const char*)g.Bt + (size_t)nxt.pn * tstep : cB;
        for (int t = 0; t < nt; t += 2) {
            const bool last = (t == nt - 2);
            const char* a1 = cA + (size_t)(t + 1) * kstep;
            const char* a2 = last ? nA : cA + (size_t)(t + 2) * kstep; const char* b2 = last ? nB : cB + (size_t)(t + 2) * kstep;
            const char* a3 = a2 + kstep; const char* b3 = b2 + kstep;
            if (last && has_next) S.a_ready(nxt);
            if constexpr (SP2) {
            PG8_LDB(B0, 0, 0); PG8_LDB(B1, 0, 1); PG8_SCHED; PG8_LDA(At, 0, 0); PG8_STAGE(PG8_SA(1, 1), a1 + hstep, voffA);
            PG8_WAIT_V(8); PG8_WAIT_L(0); PG8_BAR; PG8_MMA(0, 0, At, B0); PG8_MMA(0, 1, At, B1); PG8_BAR; PG8_SCHED;
            PG8_LDA(At, 0, 1); PG8_STAGE(PG8_SB(0, 0), b2, voffB); PG8_STAGE(PG8_SB(0, 1), b2 + hstep, voffB); PG8_STAGE(PG8_SA(0, 0), a2, voffA);
            PG8_WAIT_V(8); PG8_WAIT_L(0); PG8_BAR; PG8_MMA(1, 0, At, B0); PG8_MMA(1, 1, At, B1); PG8_BAR; PG8_SCHED;
            PG8_LDB(B0, 1, 0); PG8_LDB(B1, 1, 1); PG8_SCHED; PG8_LDA(At, 1, 0); PG8_STAGE(PG8_SA(0, 1), a2 + hstep, voffA);
            PG8_WAIT_V(8); PG8_WAIT_L(0); PG8_BAR; PG8_MMA(0, 0, At, B0); PG8_MMA(0, 1, At, B1); PG8_BAR; PG8_SCHED;
            PG8_LDA(At, 1, 1); PG8_STAGE(PG8_SB(1, 0), b3, voffB); PG8_STAGE(PG8_SB(1, 1), b3 + hstep, voffB); PG8_STAGE(PG8_SA(1, 0), a3, voffA);
            PG8_WAIT_V(8); PG8_WAIT_L(0); PG8_BAR; PG8_MMA(1, 0, At, B0); PG8_MMA(1, 1, At, B1); PG8_BAR; PG8_SCHED;
            } else {
            PG8_LDB(B0, 0, 0); PG8_SCHED; PG8_LDA(At, 0, 0); PG8_STAGE(PG8_SA(1, 1), a1 + hstep, voffA);
            PG8_WAIT_L(8); PG8_BAR; PG8_WAIT_L(0); PG8_MMA(0, 0, At, B0); PG8_BAR; PG8_SCHED;
            PG8_LDB(B1, 0, 1); PG8_STAGE(PG8_SB(0, 0), b2, voffB);
            PG8_BAR; PG8_WAIT_L(0); PG8_MMA(0, 1, At, B1); PG8_BAR;
            PG8_LDA(At, 0, 1); PG8_STAGE(PG8_SA(0, 0), a2, voffA);
            PG8_BAR; PG8_WAIT_L(0); PG8_MMA(1, 0, At, B0); PG8_BAR; PG8_SCHED;
            PG8_STAGE(PG8_SB(0, 1), b2 + hstep, voffB);
            PG8_WAIT_V(6); PG8_BAR; PG8_MMA(1, 1, At, B1); PG8_BAR;
            PG8_LDB(B0, 1, 0); PG8_SCHED; PG8_LDA(At, 1, 0); PG8_STAGE(PG8_SA(0, 1), a2 + hstep, voffA);
            PG8_WAIT_L(8); PG8_BAR; PG8_WAIT_L(0); PG8_MMA(0, 0, At, B0); PG8_BAR; PG8_SCHED;
            PG8_LDB(B1, 1, 1); PG8_STAGE(PG8_SB(1, 0), b3, voffB);
            PG8_BAR; PG8_WAIT_L(0); PG8_MMA(0, 1, At, B1); PG8_BAR;
            PG8_LDA(At, 1, 1); PG8_STAGE(PG8_SA(1, 0), a3, voffA);
            PG8_BAR; PG8_WAIT_L(0); PG8_MMA(1, 0, At, B0); PG8_BAR; PG8_SCHED;
            PG8_STAGE(PG8_SB(1, 1), b3 + hstep, voffB);
            PG8_WAIT_V(6); PG8_BAR; PG8_MMA(1, 1, At, B1); PG8_BAR;
            }
        }
        if constexpr (ALIGN_EPI) { if (wr == 0) PG8_BAR; }
        if constexpr (!Epi::AFTER_DRAIN) { E(acc, cur, wr, wc, fr, fq); S.done(cur); }
        if (!has_next) break;
#pragma unroll
        for (int a = 0; a < 2; ++a)
#pragma unroll
            for (int b = 0; b < 2; ++b)
#pragma unroll
                for (int m = 0; m < 4; ++m)
#pragma unroll
                    for (int n = 0; n < 2; ++n) acc[a][b][m][n] = (f32x4){0.f, 0.f, 0.f, 0.f};
        cur = nxt; cA = nA; cB = nB; ++ui;
        if constexpr (ALIGN_EPI) { if (wr == 1) PG8_BAR; }
    }
    PG8_WAIT_V(0);
    if constexpr (!ALIGN_EPI) { if (wr == 0) PG8_BAR; }
    PG8_BAR;
    if constexpr (Epi::AFTER_DRAIN) { E.fused(acc, cur, wr, wc, fr, fq, lds, wid, lane); S.done(cur); }
#undef PG8_SA
#undef PG8_SB
#undef PG8_STAGE
#undef PG8_LDA
#undef PG8_LDB
#undef PG8_MMA
#undef PG8_WAIT_V
#undef PG8_WAIT_L
#undef PG8_BAR
#undef PG8_SCHED
}
}
#define PG8_SP2 true
#define PG8_ALIGN true
namespace attn_body {
using bf16=__hip_bfloat16;
using bf16x8=__attribute__((ext_vector_type(8)))short;
using s16x4=__attribute__((ext_vector_type(4)))short;
using f32x16=__attribute__((ext_vector_type(16)))float;
using u32x4=__attribute__((ext_vector_type(4)))unsigned;
using f32x4=__attribute__((ext_vector_type(4)))float;
constexpr int BATCH=2,NHEAD=8,SEQ=8192,D=64,DM=NHEAD*D,OPITCH=1024,OCOL0=512,METAROW=16384,BIASN=8320;
constexpr int NW=8,QBLK=32,QB=QBLK*NW,KVBLK=64,NQB=SEQ/QB;
constexpr int ATTN_PITCH=DM, ATTN_UNIT_ROWS=QB;
__device__ __forceinline__ int crow(int r,int hi){return (r&3)+8*(r>>2)+4*hi;}
#define SBAR() __builtin_amdgcn_sched_barrier(0)
__device__ __forceinline__ void cmask(f32x16&p0,f32x16&p1,int jb,int qrel,int hi){
  const float NEG=-INFINITY; int kb=64*jb+4*hi;
  #pragma unroll
  for(int r=0;r<16;++r){int kv=kb+(r&3)+8*(r>>2); if(kv>qrel)p0[r]=NEG; if(kv+32>qrel)p1[r]=NEG;}
}

constexpr int NSLOT=3, SLOTB=8192;
constexpr int LDS_K=0, LDS_V=NSLOT*SLOTB, LDS_WS=2*NSLOT*SLOTB, LDS_OST=LDS_WS+NW*64*4, LDS_BIAS=LDS_OST+NW*4096, LDS_BYTES=LDS_BIAS+BIASN*4;
constexpr float C2=0.125f*1.4426950408889634f;
__device__ __forceinline__ void glds16(const void*gsrc,unsigned lds_dst){unsigned keep;
  asm volatile("s_mov_b32 %0, m0\n\ts_mov_b32 m0, %2\n\ts_nop 0\n\tglobal_load_lds_dwordx4 %1, off\n\ts_mov_b32 m0, %0":"=&s"(keep):"v"(gsrc),"s"(lds_dst):"memory");}
__device__ __forceinline__ float max3f(float a,float b,float c){float r;asm("v_max3_f32 %0, %1, %2, %3":"=v"(r):"v"(a),"v"(b),"v"(c));return r;}
__device__ __forceinline__ float max2f(float a,float b){float r;asm("v_max_f32_e32 %0, %1, %2":"=v"(r):"v"(a),"v"(b));return r;}
__device__ __forceinline__ float fadd_s(float a,float b){float r;asm("v_add_f32_e32 %0, %1, %2":"=v"(r):"v"(a),"v"(b));return r;}
__device__ __forceinline__ float fsub_s(float a,float b){float r;asm("v_sub_f32_e32 %0, %1, %2":"=v"(r):"v"(a),"v"(b));return r;}
typedef float f32x2_t __attribute__((ext_vector_type(2))); typedef __bf16 bf16x2_t __attribute__((ext_vector_type(2)));
__device__ __forceinline__ unsigned cvtpk_s(float lo,float hi){f32x2_t v={lo,hi};bf16x2_t b=__builtin_convertvector(v,bf16x2_t);return __builtin_bit_cast(unsigned,b);}
#define WAIT_BAR(N) asm volatile("s_waitcnt vmcnt(" #N ") lgkmcnt(0)\n\ts_barrier":::"memory")

__device__ __forceinline__ void qkt(f32x16&p0,f32x16&p1,const char*Kslot,const bf16x8*qr,const f32x16&cb0,const f32x16&cb1,int r32,int hi){
  const char*kb=Kslot+hi*1024+r32*16;
  #pragma unroll
  for(int d0=0;d0<4;++d0){
    const bf16x8 b0=*reinterpret_cast<const bf16x8*>(kb+d0*2048);
    const bf16x8 b1=*reinterpret_cast<const bf16x8*>(kb+d0*2048+512);
    if(d0==0){p0=__builtin_amdgcn_mfma_f32_32x32x16_bf16(b0,qr[0],cb0,0,0,0);p1=__builtin_amdgcn_mfma_f32_32x32x16_bf16(b1,qr[0],cb1,0,0,0);}
    else{p0=__builtin_amdgcn_mfma_f32_32x32x16_bf16(b0,qr[d0],p0,0,0,0);p1=__builtin_amdgcn_mfma_f32_32x32x16_bf16(b1,qr[d0],p1,0,0,0);}}
}
typedef __attribute__((address_space(3))) const char* lds_cptr;
typedef short v4i16_t __attribute__((ext_vector_type(4)));
__device__ __forceinline__ void kload8(bf16x8*kf,lds_cptr kp){
  kf[0]=*(const __attribute__((address_space(3))) bf16x8*)(kp);      kf[1]=*(const __attribute__((address_space(3))) bf16x8*)(kp+512);
  kf[2]=*(const __attribute__((address_space(3))) bf16x8*)(kp+2048); kf[3]=*(const __attribute__((address_space(3))) bf16x8*)(kp+2560);
  kf[4]=*(const __attribute__((address_space(3))) bf16x8*)(kp+4096); kf[5]=*(const __attribute__((address_space(3))) bf16x8*)(kp+4608);
  kf[6]=*(const __attribute__((address_space(3))) bf16x8*)(kp+6144); kf[7]=*(const __attribute__((address_space(3))) bf16x8*)(kp+6656);
}
__device__ __forceinline__ void kload2(bf16x8*kf,lds_cptr kp,int j){ kf[2*j]=*(const __attribute__((address_space(3))) bf16x8*)(kp+j*2048); kf[2*j+1]=*(const __attribute__((address_space(3))) bf16x8*)(kp+j*2048+512); }
__device__ __forceinline__ s16x4 vtr(lds_cptr p){ return __builtin_bit_cast(s16x4,__builtin_amdgcn_ds_read_tr16_b64_v4i16((__attribute__((address_space(3))) v4i16_t*)p)); }
__device__ __forceinline__ float rowmax(const f32x16&p0,const f32x16&p1){
  float a=max3f(p0[0],p0[1],p1[0]),b=max3f(p0[2],p0[3],p1[1]);a=max3f(a,p1[2],p1[3]);
  #pragma unroll
  for(int r=4;r<16;r+=4){a=max3f(a,p0[r],p0[r+1]);b=max3f(b,p0[r+2],p0[r+3]);a=max3f(a,p1[r],p1[r+1]);b=max3f(b,p1[r+2],p1[r+3]);}
  const float m=max2f(a,b);
  auto rr=__builtin_amdgcn_permlane32_swap(__float_as_uint(m),__float_as_uint(m),false,false);
  return max2f(__uint_as_float(rr[0]),__uint_as_float(rr[1]));
}
__device__ __forceinline__ void pv(f32x16*o,int vb,bf16x8 pa0,bf16x8 pa1,bf16x8 pa2,bf16x8 pa3){
  #pragma unroll
  for(int d0=0;d0<2;++d0){s16x4 lo[4],hi[4];
    #pragma unroll
    for(int ks=0;ks<4;++ks){
      asm volatile("ds_read_b64_tr_b16 %0,%1 offset:%c2":"=&v"(lo[ks]):"v"(vb),"i"(d0*4096+ks*1024):"memory");
      asm volatile("ds_read_b64_tr_b16 %0,%1 offset:%c2":"=&v"(hi[ks]):"v"(vb),"i"(d0*4096+ks*1024+512):"memory");}
    asm volatile("s_waitcnt lgkmcnt(0)":::"memory");SBAR();
    #define PK(k) (bf16x8){lo[k][0],lo[k][1],lo[k][2],lo[k][3],hi[k][0],hi[k][1],hi[k][2],hi[k][3]}
    o[d0]=__builtin_amdgcn_mfma_f32_32x32x16_bf16(pa0,PK(0),o[d0],0,0,0);
    o[d0]=__builtin_amdgcn_mfma_f32_32x32x16_bf16(pa1,PK(1),o[d0],0,0,0);
    o[d0]=__builtin_amdgcn_mfma_f32_32x32x16_bf16(pa2,PK(2),o[d0],0,0,0);
    o[d0]=__builtin_amdgcn_mfma_f32_32x32x16_bf16(pa3,PK(3),o[d0],0,0,0);
    #undef PK
  }
}

#ifndef ATTN_STORE16
#define ATTN_STORE16(p,v) (*(u32x4*)(p)=(v))
#endif
template<int THRL> __device__ __forceinline__ void attn_unit(int b,int h,int qb,const bf16*Q,const bf16*__restrict__ K,const bf16*__restrict__ V,bf16*O,const float*__restrict__ NCL,char*shm){
  const int tid=tid_fresh(),lane=tid&63,r32=lane&31,hi=lane>>5; const int wid=__builtin_amdgcn_readfirstlane(tid>>6);
  const long rowbase=(long)b*SEQ; const int q0=qb*QB;
  const bf16*Qw=Q+(rowbase+q0+wid*QBLK)*DM+h*D;
  const bf16*Kh=K+(rowbase-128)*DM+h*D,*Vh=V+(rowbase-128)*DM+h*D;
  const bf16*Khm=K+(long)METAROW*DM+h*D,*Vhm=V+(long)METAROW*DM+h*D;
  const unsigned lds0=(unsigned)(uintptr_t)shm;
  float*wsf=(float*)(shm+LDS_WS)+wid*64;
  const bf16*ksrc=Kh+(long)lane*DM+wid*8;
  const bf16*vsrc=Vh+(long)(16*(wid&3)+(lane>>2))*DM+(wid>>2)*32+(lane&3)*8;
  const bf16*ksrcm=Khm+(long)lane*DM+wid*8;
  const bf16*vsrcm=Vhm+(long)(16*(wid&3)+(lane>>2))*DM+(wid>>2)*32+(lane&3)*8;
  const unsigned kdst=lds0+LDS_K+wid*1024, vdst=lds0+LDS_V+wid*1024;
  #define DMA_K(t,slot) glds16(ksrc+(long)(t)*KVBLK*DM,(unsigned)__builtin_amdgcn_readfirstlane(kdst+(slot)))
  #define DMA_V(t,slot) glds16(vsrc+(long)(t)*KVBLK*DM,(unsigned)__builtin_amdgcn_readfirstlane(vdst+(slot)))
  #define DMA_KM(slot) glds16(ksrcm,(unsigned)__builtin_amdgcn_readfirstlane(kdst+(slot)))
  #define DMA_VM(slot) glds16(vsrcm,(unsigned)__builtin_amdgcn_readfirstlane(vdst+(slot)))
  const int vb0=(int)(lds0+LDS_V)+((lane>>4)&1)*32+(lane&3)*8+(4*hi+((lane&15)>>2))*64;
  const char*Kbase=shm+LDS_K; bf16x8 kf[8];
  const lds_cptr shm3=(lds_cptr)shm; const lds_cptr kp0=shm3+LDS_K+hi*1024+r32*16; const lds_cptr vp0=shm3+LDS_V+((lane>>4)&1)*32+(lane&3)*8+(4*hi+((lane&15)>>2))*64;
  const int NT=(q0+QB)/KVBLK+2;
  { float*BLw=(float*)(shm+LDS_BIAS); const float ref=NCL[128+q0]; for(int j=tid;j<NT*KVBLK;j+=NW*64) BLw[j]=NCL[j]-ref; }
  const __attribute__((address_space(3))) f32x4*BLp=(const __attribute__((address_space(3))) f32x4*)((lds_cptr)shm+LDS_BIAS)+hi;
  DMA_KM(0);DMA_VM(0);DMA_KM(SLOTB);
  bf16x8 qr[4];
  #pragma unroll
  for(int d0=0;d0<4;++d0)qr[d0]=*reinterpret_cast<const bf16x8*>(&Qw[(long)r32*DM+d0*16+hi*8]);
  float mhat=0.f,l_reg=0.f;f32x16 o[2];o[0]=f32x16{};o[1]=f32x16{};float nm=0.f;
  const int qrel=wid*QBLK+r32;
  #define CMASK(P0,P1,t) do{int jb_=(t)-(NT-4); if(jb_>=0)cmask(P0,P1,jb_,qrel,hi);}while(0)
  bool resc=false;
  #define START(P0,P1) do{ const float rm=rowmax(P0,P1); resc=false; \
    { const float dl=rm; mhat=fadd_s(mhat,dl); \
      _Pragma("unroll") for(int r=0;r<16;++r){P0[r]=fsub_s(P0[r],dl);P1[r]=fsub_s(P1[r],dl);} \
      nm=-mhat; } \
    _Pragma("unroll") for(int r=0;r<16;++r)P0[r]=__builtin_amdgcn_exp2f(P0[r]); }while(0)
  #define RESC() do{ if(resc){ asm volatile("s_waitcnt lgkmcnt(0)":::"memory"); \
      _Pragma("unroll") for(int d_=0;d_<2;++d_) _Pragma("unroll") for(int r=0;r<16;++r)o[d_][r]*=wsf[crow(r,hi)]; } }while(0)
  f32x16 pA0,pA1,pB0,pB1;
  int sl_prev=0,sl_cur=0,sl_next=SLOTB;
  #define ROT() do{sl_prev=sl_cur;sl_cur=sl_next;sl_next=(sl_next==(NSLOT-1)*SLOTB)?0:sl_next+SLOTB;}while(0)
  DMA_K(2,2*SLOTB);
  WAIT_BAR(3);
  #define CBIAS(X0,X1,t) do{ _Pragma("unroll") for(int g_=0;g_<4;++g_){ const f32x4 a_=BLp[16*(t)+2*g_], b_=BLp[16*(t)+8+2*g_]; \
      X0[4*g_]=a_[0]+nm;X0[4*g_+1]=a_[1]+nm;X0[4*g_+2]=a_[2]+nm;X0[4*g_+3]=a_[3]+nm; X1[4*g_]=b_[0]+nm;X1[4*g_+1]=b_[1]+nm;X1[4*g_+2]=b_[2]+nm;X1[4*g_+3]=b_[3]+nm; } }while(0)
  { f32x16 cb0,cb1; CBIAS(cb0,cb1,0); qkt(pA0,pA1,Kbase,qr,cb0,cb1,r32,hi); }asm volatile("s_nop 15\n\ts_nop 7":"+v"(pA0),"+v"(pA1));CMASK(pA0,pA1,0);
  START(pA0,pA1);
  _Pragma("unroll") for(int r=0;r<16;++r)pA1[r]=__builtin_amdgcn_exp2f(pA1[r]);
  WAIT_BAR(0);
  DMA_K(3,0);DMA_VM(SLOTB);
  ROT();
  kload8(kf,kp0+sl_cur);
  WAIT_BAR(2);
  s16x4 vlo[8],vhi[8]; u32x4 pw0,pw1,pw2,pw3;
  #define PKW(P,B) cvtpk_s(P[B],P[B+1])
  #define PAF(k) __builtin_bit_cast(bf16x8,pw##k)
  #define VFR(i) (bf16x8){vlo[i][0],vlo[i][1],vlo[i][2],vlo[i][3],vhi[i][0],vhi[i][1],vhi[i][2],vhi[i][3]}
  #define PIN(x) asm volatile("":"+v"(x))
  #define MX3(a,b,c) __builtin_fmaxf(__builtin_fmaxf((a),(b)),(c))
  #define GAPA(MF,A0,A1,A2,A3,W0,W1,PW) do{ MF; sacc+=A0; sacc+=A1; sacc+=A2; sacc+=A3; PIN(sacc); W0; W1; PIN(PW); SBAR(); }while(0)
  #define EX(v) __builtin_amdgcn_exp2f(v)
  #define GAPB(MF,X,B) do{ MF; X[B]=EX(X[B]); X[B+1]=EX(X[B+1]); X[B+2]=EX(X[B+2]); X[B+3]=EX(X[B+3]); PIN(X); SBAR(); }while(0)
  #define VRD(i) do{ vlo[i]=vtr(vp_+(((i)>>2)*4096+((i)&3)*1024)); vhi[i]=vtr(vp_+(((i)>>2)*4096+((i)&3)*1024+512)); }while(0)
  #define KRD(G,j) do{ if(G){ kload2(kf,kp0+sl_next,j); SBAR(); } }while(0)
  #define STEP(C0,C1,P0,P1,t,GK,GV,GL) do{ SBAR(); \
    const lds_cptr vp_=vp0+sl_prev; CBIAS(C0,C1,t); SBAR(); \
    VRD(0); SBAR(); float sacc=(P0[0]+P0[1]); \
    GAPA(C0=__builtin_amdgcn_mfma_f32_32x32x16_bf16(kf[0],qr[0],C0,0,0,0), P0[2],P0[3],P0[4],P0[5],     pw0[0]=PKW(P0,0), pw0[1]=PKW(P0,2), pw0); \
    VRD(4); SBAR(); GAPA(C1=__builtin_amdgcn_mfma_f32_32x32x16_bf16(kf[1],qr[0],C1,0,0,0), P0[6],P0[7],P0[8],P0[9],     pw0[2]=PKW(P0,4), pw0[3]=PKW(P0,6), pw0); \
    VRD(1); SBAR(); GAPA(C0=__builtin_amdgcn_mfma_f32_32x32x16_bf16(kf[2],qr[1],C0,0,0,0),   P0[10],P0[11],P0[12],P0[13], pw1[0]=PKW(P0,8), pw1[1]=PKW(P0,10), pw1); \
    VRD(5); SBAR(); GAPA(C1=__builtin_amdgcn_mfma_f32_32x32x16_bf16(kf[3],qr[1],C1,0,0,0),   P0[14],P0[15],P1[0],P1[1],   pw1[2]=PKW(P0,12),pw1[3]=PKW(P0,14), pw1); \
    VRD(2); SBAR(); GAPA(C0=__builtin_amdgcn_mfma_f32_32x32x16_bf16(kf[4],qr[2],C0,0,0,0),   P1[2],P1[3],P1[4],P1[5],     pw2[0]=PKW(P1,0), pw2[1]=PKW(P1,2), pw2); \
    VRD(6); SBAR(); GAPA(C1=__builtin_amdgcn_mfma_f32_32x32x16_bf16(kf[5],qr[2],C1,0,0,0),   P1[6],P1[7],P1[8],P1[9],     pw2[2]=PKW(P1,4), pw2[3]=PKW(P1,6), pw2); \
    VRD(3); SBAR(); GAPA(C0=__builtin_amdgcn_mfma_f32_32x32x16_bf16(kf[6],qr[3],C0,0,0,0),   P1[10],P1[11],P1[12],P1[13], pw3[0]=PKW(P1,8), pw3[1]=PKW(P1,10), pw3); \
    VRD(7); SBAR(); GAPA(C1=__builtin_amdgcn_mfma_f32_32x32x16_bf16(kf[7],qr[3],C1,0,0,0),   P1[14],P1[15],0.f,0.f,       pw3[2]=PKW(P1,12),pw3[3]=PKW(P1,14), pw3); \
    l_reg+=sacc; \
    if(GK){DMA_K((t)+3,sl_cur);} if(GV){DMA_V((t)+1,sl_next);} \
    CMASK(C0,C1,t); \
    { float a=MX3(C0[0],C0[1],C1[0]),b=MX3(C0[2],C0[3],C1[1]); a=MX3(a,C1[2],C1[3]); \
      _Pragma("unroll") for(int r=4;r<16;r+=4){a=MX3(a,C0[r],C0[r+1]);b=MX3(b,C0[r+2],C0[r+3]);a=MX3(a,C1[r],C1[r+1]);b=MX3(b,C1[r+2],C1[r+3]);} \
      float rm=__builtin_fmaxf(a,b); { auto rr=__builtin_amdgcn_permlane32_swap(__float_as_uint(rm),__float_as_uint(rm),false,false); rm=__builtin_fmaxf(__uint_as_float(rr[0]),__uint_as_float(rr[1])); } \
      resc=false; \
      if(__builtin_expect(__any(rm>(float)THRL),0)){ const float dl=__builtin_fmaxf(rm,0.f); mhat+=dl; \
        _Pragma("unroll") for(int r=0;r<16;++r){C0[r]-=dl;C1[r]-=dl;} \
        nm=-mhat; \
        const float f=__builtin_amdgcn_exp2f(-dl); l_reg*=f; if(hi==0)wsf[r32]=f; resc=true; } } \
    SBAR(); \
    GAPB(o[0]=__builtin_amdgcn_mfma_f32_32x32x16_bf16(PAF(0),VFR(0),o[0],0,0,0), C0,0); \
    GAPB(o[1]=__builtin_amdgcn_mfma_f32_32x32x16_bf16(PAF(0),VFR(4),o[1],0,0,0), C0,4); \
    KRD(GL,0); GAPB(o[0]=__builtin_amdgcn_mfma_f32_32x32x16_bf16(PAF(1),VFR(1),o[0],0,0,0), C0,8); \
    KRD(GL,1); GAPB(o[1]=__builtin_amdgcn_mfma_f32_32x32x16_bf16(PAF(1),VFR(5),o[1],0,0,0), C0,12); \
    KRD(GL,2); GAPB(o[0]=__builtin_amdgcn_mfma_f32_32x32x16_bf16(PAF(2),VFR(2),o[0],0,0,0), C1,0); \
    KRD(GL,3); GAPB(o[1]=__builtin_amdgcn_mfma_f32_32x32x16_bf16(PAF(2),VFR(6),o[1],0,0,0), C1,4); \
    GAPB(o[0]=__builtin_amdgcn_mfma_f32_32x32x16_bf16(PAF(3),VFR(3),o[0],0,0,0), C1,8); \
    GAPB(o[1]=__builtin_amdgcn_mfma_f32_32x32x16_bf16(PAF(3),VFR(7),o[1],0,0,0), C1,12); \
    }while(0)
  int t=1;
  #undef CMASK
  #define CMASK(P0,P1,t) do{}while(0)
  for(;t+5<NT;t+=2){
    STEP(pB0,pB1,pA0,pA1,t,true,true,true);     WAIT_BAR(2); RESC(); ROT();
    STEP(pA0,pA1,pB0,pB1,t+1,true,true,true);   WAIT_BAR(2); RESC(); ROT();
  }
  #undef CMASK
  #define CMASK(P0,P1,t) do{int jb_=(t)-(NT-4); if(jb_>=0)cmask(P0,P1,jb_,qrel,hi);}while(0)
  #define ENDW(tt) do{ if((tt)+3<NT){WAIT_BAR(2);} else if((tt)+2<NT){WAIT_BAR(1);} else {WAIT_BAR(0);} }while(0)
  for(;t+1<NT;t+=2){
    STEP(pB0,pB1,pA0,pA1,t,(t+3<NT),(t+1<NT),(t+1<NT));       ENDW(t);   RESC(); ROT();
    STEP(pA0,pA1,pB0,pB1,t+1,(t+4<NT),(t+2<NT),(t+2<NT));     ENDW(t+1); RESC(); ROT();
  }
  STEP(pB0,pB1,pA0,pA1,NT-1,false,false,false); RESC();
  { float sacc=pB0[0]+pB0[1]; _Pragma("unroll") for(int r=2;r<16;++r)sacc+=pB0[r]; _Pragma("unroll") for(int r=0;r<16;++r)sacc+=pB1[r]; l_reg+=sacc;
    pw0=(u32x4){PKW(pB0,0),PKW(pB0,2),PKW(pB0,4),PKW(pB0,6)};pw1=(u32x4){PKW(pB0,8),PKW(pB0,10),PKW(pB0,12),PKW(pB0,14)};pw2=(u32x4){PKW(pB1,0),PKW(pB1,2),PKW(pB1,4),PKW(pB1,6)};pw3=(u32x4){PKW(pB1,8),PKW(pB1,10),PKW(pB1,12),PKW(pB1,14)};
    SBAR(); pv(o,vb0+sl_cur,PAF(0),PAF(1),PAF(2),PAF(3)); }
  #undef PKW
  #undef PAF
  #undef VFR
  #undef PIN
  #undef MX3
  #undef GAPA
  #undef GAPB
  #undef EX
  #undef VRD
  #undef KRD
  #undef STEP
  #undef ENDW
  {auto rr=__builtin_amdgcn_permlane32_swap(__float_as_uint(l_reg),__float_as_uint(l_reg),false,false);l_reg=__uint_as_float(rr[0])+__uint_as_float(rr[1]);}
  if(hi==0)wsf[32+r32]=l_reg;asm volatile("s_waitcnt lgkmcnt(0)":::"memory");
  float rli[16];
  #pragma unroll
  for(int r=0;r<16;++r)rli[r]=__builtin_amdgcn_rcpf(wsf[32+crow(r,hi)]);
  bf16*Ow=O+(rowbase+q0+wid*QBLK)*OPITCH+OCOL0+h*D;
  { bf16*stg=(bf16*)(shm+LDS_OST)+wid*2048;
    #pragma unroll
    for(int r=0;r<16;++r){const int orow=crow(r,hi);
      #pragma unroll
      for(int d0=0;d0<2;++d0)stg[orow*64+d0*32+r32]=__float2bfloat16(o[d0][r]*rli[r]);}
    asm volatile("s_waitcnt lgkmcnt(0)":::"memory");
    #pragma unroll
    for(int i=0;i<4;++i){const int row=i*8+(lane>>3),ch=lane&7; const u32x4 v=*(const u32x4*)(stg+row*64+ch*8); ATTN_STORE16(Ow+(long)row*OPITCH+ch*8,v);} }
  asm volatile("s_waitcnt lgkmcnt(0)\n\ts_barrier":::"memory");
  #undef DMA_K
  #undef DMA_V
  #undef DMA_KM
  #undef DMA_VM
  #undef CBIAS
  #undef CMASK
  #undef START
  #undef RESC
  #undef ROT
}
constexpr int ATTN_LDS_BYTES=LDS_BYTES;
struct AttnTensors { const bf16* Q; const bf16* K; const bf16* V; bf16* O; const float* NCL; };
struct AttnUnit { int bh; int qb; };
struct StaticOrder {
  int vcu;
  __device__ __forceinline__ explicit StaticOrder(int grid,int block):vcu((block%8)*(grid/8)+block/8){}
  __device__ __forceinline__ bool next(int i,AttnUnit&u)const{ if(i>=2)return false; const int s=vcu&15; u.bh=vcu>>4; u.qb=(i==0)?s:31-s; return true; }
  __device__ __forceinline__ void a_ready(const AttnUnit&)const{}
  __device__ __forceinline__ void done(const AttnUnit&)const{}
};
template<class Sched,int THRL=8> __device__ __forceinline__ void attn_phase(char*lds,const AttnTensors&T,const Sched&S){
  AttnUnit u;
  for(int i=0;S.next(i,u);++i){ S.a_ready(u); attn_unit<THRL>(u.bh/NHEAD,u.bh%NHEAD,u.qb,T.Q,T.K,T.V,T.O,T.NCL+(long)u.bh*BIASN,lds); S.done(u); }
}
#undef SBAR
#undef WAIT_BAR
}
#define GAS __attribute__((address_space(1)))
#define LAS __attribute__((address_space(3)))
typedef unsigned short bf16;
typedef unsigned v4u __attribute__((ext_vector_type(4)));
typedef float f32x4 __attribute__((ext_vector_type(4)));
typedef short bf16x8 __attribute__((ext_vector_type(8)));
typedef GAS unsigned gu32;
typedef GAS unsigned long long gu64;
#define RLX_AGENT __ATOMIC_RELAXED, __HIP_MEMORY_SCOPE_AGENT
#define LDS_WAIT() asm volatile("s_waitcnt lgkmcnt(0)" ::: "memory")
#define VM_WAIT() asm volatile("s_waitcnt vmcnt(0)" ::: "memory")
__device__ __forceinline__ unsigned long long rt() { return __builtin_amdgcn_s_memrealtime(); }
__device__ __forceinline__ unsigned f2bf(float f) { unsigned u = __builtin_bit_cast(unsigned, f); return (u + 0x7fffu + ((u >> 16) & 1u)) >> 16; }
__device__ __forceinline__ unsigned pk2(float lo, float hi) { return f2bf(lo) | (f2bf(hi) << 16); }

#define XB_TMO      128
#define XB_XCNT(j)  (256  + 64 * (j))
#define XB_XSUB(j)  (1280 + 64 * (j))
#define XB_XGEN(j)  (2304 + 64 * (j))
#define XB_TOP      3328
#define XB_TOPGEN   3392
#define XCD_BAR_WORDS 3456
#define XB_SPIN_CAP (1u << 18)

__device__ __forceinline__ unsigned xb_ld(unsigned* p)              { return __hip_atomic_load(p, __ATOMIC_RELAXED, __HIP_MEMORY_SCOPE_AGENT); }
__device__ __forceinline__ unsigned xb_add(unsigned* p, unsigned v) { return __hip_atomic_fetch_add(p, v, __ATOMIC_RELAXED, __HIP_MEMORY_SCOPE_AGENT); }
__device__ __forceinline__ unsigned xb_xcc_id() { return (unsigned)__builtin_amdgcn_s_getreg((3 << 11) | 20) & 0xFu; }
#define XB_SPIN(cond, bar) do { unsigned _sp = 0; while (cond) { __builtin_amdgcn_s_sleep(1); \
    if ((++_sp & 255u) == 0u) { if (xb_ld(&(bar)[XB_TMO])) break; if (_sp > XB_SPIN_CAP) { atomicAdd(&(bar)[XB_TMO], 1u); break; } } } } while (0)

struct XcdBarrier {
    unsigned* bar; unsigned x;
    volatile LAS unsigned* st;
};

__device__ __forceinline__ XcdBarrier xcd_barrier_post(unsigned* bar, volatile LAS unsigned* st) {
    XcdBarrier b; b.bar = bar; b.x = xb_xcc_id(); b.st = st;
    if (threadIdx.x == 0) (void)xb_add(&bar[XB_XCNT(b.x)], 1u);
    return b;
}
__device__ __forceinline__ void xcd_barrier_complete(unsigned* bar, unsigned x, unsigned& nloc, unsigned& nx) {
    const unsigned G = gridDim.x * gridDim.y * gridDim.z;
    unsigned sum, cnt, mine, sp = 0u;
    for (;;) {
        sum = 0u; cnt = 0u; mine = 0u;
#pragma unroll
        for (unsigned j = 0; j < 16; ++j) { const unsigned c = xb_ld(&bar[XB_XCNT(j)]); sum += c; cnt += (c > 0u) ? 1u : 0u; mine = (j == x) ? c : mine; }
        if (sum == G) break;
        __builtin_amdgcn_s_sleep(1);
        if ((++sp & 255u) == 0u) { if (xb_ld(&bar[XB_TMO])) break; if (sp > XB_SPIN_CAP) { atomicAdd(&bar[XB_TMO], 1u); break; } }
    }
    nloc = mine > 0u ? mine : 1u; nx = cnt > 0u ? cnt : 1u;
}

__device__ __forceinline__ void xcd_barrier(const XcdBarrier& b) {
    asm volatile("s_waitcnt vmcnt(0)" ::: "memory");
    __syncthreads();
    if (threadIdx.x == 0) {
        unsigned* bar = b.bar;
        __builtin_amdgcn_s_waitcnt(0);
        unsigned nloc = b.st[0], nx = b.st[1];
        if (nloc == 0u) { xcd_barrier_complete(bar, b.x, nloc, nx); b.st[0] = nloc; b.st[1] = nx; }
        const unsigned old = xb_add(&bar[XB_XSUB(b.x)], 1u);
        const unsigned gen = old / nloc;
        if (old + 1u == (gen + 1u) * nloc) {
            __builtin_amdgcn_fence(__ATOMIC_RELEASE, "agent");
            asm volatile("s_waitcnt vmcnt(0)" ::: "memory");
            const unsigned og = xb_add(&bar[XB_TOP], 1u);
            const unsigned tg = og / nx;
            if (og + 1u == (tg + 1u) * nx) xb_add(&bar[XB_TOPGEN], 1u);
            else XB_SPIN(xb_ld(&bar[XB_TOPGEN]) == tg, bar);
            __builtin_amdgcn_fence(__ATOMIC_ACQUIRE, "agent");
            xb_add(&bar[XB_XGEN(b.x)], 1u);
            asm volatile("s_waitcnt vmcnt(0)" ::: "memory");
        } else {
            XB_SPIN(xb_ld(&bar[XB_XGEN(b.x)]) == gen, bar);
            __builtin_amdgcn_fence(__ATOMIC_ACQUIRE, "agent");
            asm volatile("s_waitcnt vmcnt(0)" ::: "memory");
        }
    }
    __syncthreads();
}

constexpr int NWAVES = 8, NTHR = NWAVES * 64;
constexpr int DMOD = 1024, TREAL = 8192, NBATCH = 2, NMETA = 16, TPOS = TREAL + NMETA, NSAMP = 32;
constexpr int M_REAL = NBATCH * TREAL, ROW_META = M_REAL, ROW_SAMP = ROW_META + NMETA, M_VALID = ROW_SAMP + NSAMP, M_PAD = 16640;
constexpr int DSHIFT = 1792, DIN = 5384, N1 = 5376, DR = 512, NH = 8, HD = 64, FF = 4096, DG = 2048;
constexpr int COL_Q = 1792, COL_K = 2304, COL_V = 2816, COL_F = 3328, COL_G = 3328;
constexpr int NPAGES = 64, PAGE = 128, NSPLIT = 8;
constexpr float RMS_EPS = 1e-6f, GN_EPS = 64e-5f, LOG2E = 1.4426950408889634f;
constexpr size_t O_YP = 0, O_YS = O_YP + (size_t)M_REAL * DMOD, O_SHP = O_YS + (size_t)NSAMP * DMOD, O_WKVP = O_SHP + 2 * DSHIFT, O_KP = O_WKVP + 2 * 8 * 64 * 64,
                 O_VP = O_KP + (size_t)2 * TPOS * 512, O_LFP = O_VP + (size_t)2 * TPOS * 512, O_SHS = O_LFP + (size_t)2 * TPOS * 8, O_WKVS = O_SHS + (size_t)NSAMP * DSHIFT,
                 O_KS = O_WKVS + (size_t)NSAMP * 8 * 64 * 64, O_VS = O_KS + NSAMP * 512, O_LFS = O_VS + NSAMP * 512, O_END = O_LFS + NSAMP * 8;
static_assert(O_END == 34959360, "d_out size");
constexpr size_t MiB = 1u << 20;
constexpr size_t al(size_t x) { return (x + MiB - 1) / MiB * MiB; }
constexpr size_t WS_CTL = 0, CTL_ZERO_BYTES = 1 * MiB;
constexpr size_t WS_WIN = 1 * MiB;
constexpr size_t WS_WBR = WS_WIN + al((size_t)N1 * 1024 * 2);
constexpr size_t WS_WOUT = WS_WBR + 2 * MiB;
constexpr size_t WS_WUP = WS_WOUT + 2 * MiB;
constexpr size_t WS_WDN = WS_WUP + 8 * MiB;
constexpr size_t WS_HN = WS_WDN + 8 * MiB;
constexpr size_t WS_UR = WS_HN + al((size_t)M_PAD * 1024 * 2);
constexpr size_t WS_QB = WS_UR + al((size_t)M_PAD * DSHIFT * 4);
constexpr size_t WS_KB = WS_QB + al((size_t)M_PAD * 512 * 2);
constexpr size_t WS_VB = WS_KB + al((size_t)M_PAD * 512 * 2);
constexpr size_t WS_GB = WS_VB + al((size_t)M_PAD * 512 * 2);
constexpr size_t WS_OC = WS_GB + al((size_t)M_PAD * DG * 2);
constexpr size_t WS_LF = WS_OC + al((size_t)M_PAD * 1024 * 2);
constexpr size_t WS_NCL = WS_LF + al((size_t)M_PAD * 8 * 4);
constexpr size_t WS_PR = WS_NCL + 1 * MiB;
constexpr size_t PSTRIDE = al((size_t)M_PAD * 512 * 4);
constexpr size_t WS_Y = WS_PR + 7 * PSTRIDE;
constexpr size_t WS_TMP = WS_UR;
constexpr size_t WS_MG = WS_QB;
constexpr size_t WS_X1 = WS_HN;
constexpr size_t WS_HF = WS_UR;
static_assert(WS_QB + (size_t)M_PAD * 1024 * 2 <= WS_VB && WS_UR + (size_t)M_PAD * FF * 2 <= WS_OC, "overlay map");
constexpr size_t WS_QS = WS_Y + PSTRIDE;
constexpr size_t WS_PART = WS_QS + 1 * MiB;
constexpr size_t WS_SS = WS_PART + 1 * MiB, WS_SS48 = WS_SS + 2 * MiB;
constexpr size_t WS_WDT = WS_SS48 + 1 * MiB;
constexpr size_t WS_WAT = WS_WDT + 1 * MiB, WS_WGT = WS_WAT + 1 * MiB;
constexpr size_t UNIT_B16 = (size_t)2064 * 4096 * 2, UNIT_F32 = (size_t)2064 * 4096 * 4;
constexpr size_t WS_MTH = WS_WGT + 1 * MiB, WS_MTL = WS_MTH + al(UNIT_B16), WS_SLG = WS_MTL + al(UNIT_B16), WS_W2G = WS_SLG + al(UNIT_F32), WS_YLG = WS_W2G + al(UNIT_B16),
                 WS_G1G = WS_YLG + al(UNIT_F32), WS_G2G = WS_G1G + al(UNIT_F32), WS_S0G = WS_G2G + al(UNIT_F32);
constexpr size_t WS_PART2 = WS_S0G + al(UNIT_B16 + 8192);
constexpr size_t WS_END = WS_PART2 + 1 * MiB;
constexpr int CW_BAR = 4096;
constexpr int CW_QUEUE = 8192;
constexpr int CW_ZERO = 65536;
constexpr int CW_FLAG = 131072;
constexpr int RING_OFF = 0, RING_BYTES = 139264, LDSCTL_OFF = RING_BYTES, MISC_OFF = LDSCTL_OFF + 320, LDS_BYTES = 147456;

typedef unsigned v2u __attribute__((ext_vector_type(2)));
__device__ __forceinline__ float bflo(unsigned w) { return __uint_as_float(w << 16); }
__device__ __forceinline__ float bfhi(unsigned w) { return __uint_as_float(w & 0xffff0000u); }
template <int CTRL> __device__ __forceinline__ float dpp_f(float x) { return __builtin_bit_cast(float, __builtin_amdgcn_update_dpp(0, __builtin_bit_cast(int, x), CTRL, 0xF, 0xF, true)); }
__device__ __forceinline__ float red16(float x) {
    x += dpp_f<0xB1>(x); x += dpp_f<0x4E>(x); x += dpp_f<0x141>(x); x += dpp_f<0x128>(x); return x;
}
__device__ __forceinline__ float wred_sum(float x) {
    x = red16(x);
    { auto rr = __builtin_amdgcn_permlane16_swap(__float_as_uint(x), __float_as_uint(x), false, false); x = __uint_as_float(rr[0]) + __uint_as_float(rr[1]); }
    { auto rr = __builtin_amdgcn_permlane32_swap(__float_as_uint(x), __float_as_uint(x), false, false); x = __uint_as_float(rr[0]) + __uint_as_float(rr[1]); }
    return x;
}
__device__ __forceinline__ float wred_max(float x) {
    x = fmaxf(x, dpp_f<0xB1>(x)); x = fmaxf(x, dpp_f<0x4E>(x)); x = fmaxf(x, dpp_f<0x141>(x)); x = fmaxf(x, dpp_f<0x128>(x));
    { auto rr = __builtin_amdgcn_permlane16_swap(__float_as_uint(x), __float_as_uint(x), false, false); x = fmaxf(__uint_as_float(rr[0]), __uint_as_float(rr[1])); }
    { auto rr = __builtin_amdgcn_permlane32_swap(__float_as_uint(x), __float_as_uint(x), false, false); x = fmaxf(__uint_as_float(rr[0]), __uint_as_float(rr[1])); }
    return x;
}
__device__ __forceinline__ float wave_sum(float v) { return wred_sum(v); }
__device__ __forceinline__ float wave_max(float v) { return wred_max(v); }
__device__ __forceinline__ float sigmoidf_(float x) { return 1.0f / (1.0f + __expf(-x)); }

struct Args { const float* in[30]; float* out; unsigned char* ws; };

struct Frame {
    LAS unsigned char* lds;
    volatile LAS unsigned* MISC;
    gu32* ctl;
    int vcu, G;
    const float* in[30]; float* out; unsigned char* ws;
};
#define INP(i) (F.in[i])
enum { I_XP = 0, I_XS, I_SSHIFT, I_SWKV, I_CK, I_CV, I_CLF, I_PT, I_META, I_NMIX, I_WIN, I_MU, I_W0, I_WDEC, I_A0, I_WA, I_WG, I_KK, I_KA, I_RK, I_LNW, I_LNB, I_BF, I_WBR, I_WBF, I_WOUT, I_NFFN, I_WUP, I_WDN, I_NFIN };

__device__ __forceinline__ const float* xrow(const Frame& F, int m) {
    if (m < M_REAL) return F.in[I_XP] + (size_t)m * DMOD;
    if (m < ROW_SAMP) return F.in[I_META] + (size_t)(m - ROW_META) * DMOD;
    if (m < M_VALID) return F.in[I_XS] + (size_t)(m - ROW_SAMP) * DMOD;
    return nullptr;
}

__device__ __forceinline__ void p0_transpose_item(const float* W, int ldw, int nblk, int K, bf16* WT, int ldt, int row_off, int col_off, LAS float* scr, int item, int lane, const float* kscale = nullptr) {
    const int kb = item / nblk, nb = item % nblk, k0 = 64 * kb, n0 = 32 * nb;
#pragma unroll 8
    for (int i = 0; i < 32; ++i) { const int kk = 2 * i + (lane >> 5); scr[kk * 33 + (lane & 31)] = W[(size_t)(k0 + kk) * ldw + n0 + (lane & 31)] * (kscale ? kscale[k0 + kk] : 1.0f); }
    LDS_WAIT(); asm volatile("" ::: "memory");
    const int c = lane & 7;
#pragma unroll
    for (int j = 0; j < 4; ++j) { const int n = (lane >> 3) + 8 * j; const LAS float* s = scr + (8 * c) * 33 + n;
        v4u o; o.x = pk2(s[0 * 33], s[1 * 33]); o.y = pk2(s[2 * 33], s[3 * 33]); o.z = pk2(s[4 * 33], s[5 * 33]); o.w = pk2(s[6 * 33], s[7 * 33]);
        *(GAS v4u*)(WT + (size_t)(row_off + n0 + n) * ldt + col_off + k0 + 8 * c) = o; }
    LDS_WAIT(); asm volatile("" ::: "memory");
    (void)K;
}
__device__ __forceinline__ float log_sigmoid_(float z) { return fminf(z, 0.f) - log1pf(expf(-fabsf(z))); }

__device__ __forceinline__ void p0_prologue(Frame& F) {
    const int tid_ = tid_fresh(), lane_ = tid_ & 63, wave_ = __builtin_amdgcn_readfirstlane(tid_ >> 6); (void)lane_; (void)wave_;
    LAS float* scr = (LAS float*)(F.lds + RING_OFF + wave_ * 16384);
    const int gw = F.vcu * NWAVES + wave_, NGW = F.G * NWAVES;
    unsigned char* ws = F.ws;
    constexpr int I_A = 16 * 104, I_B = 16 * 64, I_BR = 8 * 32, I_O = 16 * 32, I_U = 16 * 128, I_D = 64 * 32;
    constexpr int I_L = 16, I_LG = 32;
    constexpr int NITEMS = I_A + I_B + 2 * I_BR + I_O + I_U + I_D + 2 * I_L + I_LG;
    for (int it = gw; it < NITEMS; it += NGW) {
        int r = it;
        if (r < I_A) { p0_transpose_item(INP(I_WIN), DIN, 104, 1024, (bf16*)(ws + WS_WIN), 1024, 0, 0, scr, r, lane_); continue; } r -= I_A;
        if (r < I_B) { p0_transpose_item(INP(I_WIN) + (COL_F + 8), DIN, 64, 1024, (bf16*)(ws + WS_WIN), 1024, COL_G, 0, scr, r, lane_); continue; } r -= I_B;
        if (r < I_BR) { p0_transpose_item(INP(I_WBR), 1024, 32, 512, (bf16*)(ws + WS_WBR), 1024, 0, 0, scr, r, lane_); continue; } r -= I_BR;
        if (r < I_BR) { p0_transpose_item(INP(I_WBF), 1024, 32, 512, (bf16*)(ws + WS_WBR), 1024, 0, 512, scr, r, lane_); continue; } r -= I_BR;
        if (r < I_O) { p0_transpose_item(INP(I_WOUT), 1024, 32, 1024, (bf16*)(ws + WS_WOUT), 1024, 0, 0, scr, r, lane_); continue; } r -= I_O;
        if (r < I_U) { p0_transpose_item(INP(I_WUP), FF, 128, 1024, (bf16*)(ws + WS_WUP), 1024, 0, 0, scr, r, lane_, INP(I_NFFN)); continue; } r -= I_U;
        if (r < I_D) { p0_transpose_item(INP(I_WDN), 1024, 32, FF, (bf16*)(ws + WS_WDN), FF, 0, 0, scr, r, lane_); continue; } r -= I_D;
        if (r < I_L) { p0_transpose_item(INP(I_WDEC), 512, 16, 64, (bf16*)(ws + WS_WDT), 64, 0, 0, scr, r, lane_); continue; } r -= I_L;
        if (r < I_L) { p0_transpose_item(INP(I_WA), 512, 16, 64, (bf16*)(ws + WS_WAT), 64, 0, 0, scr, r, lane_); continue; } r -= I_L;
        p0_transpose_item(INP(I_WG), 512, 16, 128, (bf16*)(ws + WS_WGT), 128, 0, 0, scr, r, lane_);
    }
    __syncthreads();
    LAS float* WF = (LAS float*)(F.lds + RING_OFF);
    for (int e = tid_; e < 8 * 1024; e += NTHR) { const int k = e >> 3, j = e & 7; WF[j * 1024 + k] = INP(I_NMIX)[k] * INP(I_WIN)[(size_t)k * DIN + COL_F + j]; }
    __syncthreads();
    f32x4 gm[4];
#pragma unroll
    for (int j = 0; j < 4; ++j) gm[j] = *((const GAS f32x4*)INP(I_NMIX) + lane_ + 64 * j);
    f32x4 wf[8][4];
#pragma unroll
    for (int q = 0; q < 8; ++q)
#pragma unroll
        for (int j = 0; j < 4; ++j) wf[q][j] = *((const LAS f32x4*)(WF + q * 1024) + lane_ + 64 * j);
    const float bfv = INP(I_BF)[lane_ & 7];
    bf16* HN = (bf16*)(ws + WS_HN); float* LF = (float*)(ws + WS_LF);
    f32x4 vnx[4];
    { const float* p0_ = gw < M_PAD ? xrow(F, gw) : nullptr; const GAS f32x4* xr = (const GAS f32x4*)(p0_ ? p0_ : F.in[I_XP]) + lane_;
#pragma unroll
      for (int j = 0; j < 4; ++j) vnx[j] = xr[64 * j]; }
    for (int m = gw; m < M_PAD; m += NGW) {
        const float* xr_ = xrow(F, m);
        GAS unsigned long long* o8 = (GAS unsigned long long*)(HN + (size_t)m * DMOD) + lane_;
        f32x4 v[4];
#pragma unroll
        for (int j = 0; j < 4; ++j) v[j] = vnx[j];
        { const int mn = m + NGW; const float* pn_ = mn < M_PAD ? xrow(F, mn) : nullptr; const GAS f32x4* xn = (const GAS f32x4*)(pn_ ? pn_ : F.in[I_XP]) + lane_;
#pragma unroll
          for (int j = 0; j < 4; ++j) vnx[j] = xn[64 * j]; }
        if (xr_ == nullptr) {
#pragma unroll
            for (int j = 0; j < 4; ++j) o8[64 * j] = 0ull;
            if (lane_ < 8) LF[(size_t)m * 8 + lane_] = 0.f;
            continue;
        }
        float s2 = 0.f;
#pragma unroll
        for (int j = 0; j < 4; ++j) { s2 += (v[j].x * v[j].x + v[j].y * v[j].y) + (v[j].z * v[j].z + v[j].w * v[j].w); }
        const float rstd = 1.0f / sqrtf(wave_sum(s2) * (1.f / DMOD) + RMS_EPS);
        float fa[8];
#pragma unroll
        for (int q = 0; q < 8; ++q) { float a = 0.f;
#pragma unroll
            for (int j = 0; j < 4; ++j) { const f32x4 w = wf[q][j]; a += (v[j].x * w.x + v[j].y * w.y) + (v[j].z * w.z + v[j].w * w.w); }
            fa[q] = wave_sum(a); }
        float mine = fa[0];
#pragma unroll
        for (int q = 1; q < 8; ++q) mine = ((lane_ & 7) == q) ? fa[q] : mine;
        const float lf = log_sigmoid_(mine * rstd + bfv);
        if (lane_ < 8) {
            LF[(size_t)m * 8 + lane_] = lf;
            if (m < M_REAL) F.out[O_LFP + ((size_t)(m >> 13) * TPOS + NMETA + (m & 8191)) * 8 + lane_] = lf;
            else if (m < ROW_SAMP) { F.out[O_LFP + (size_t)(m - ROW_META) * 8 + lane_] = lf; F.out[O_LFP + ((size_t)TPOS + (m - ROW_META)) * 8 + lane_] = lf; }
            else F.out[O_LFS + (size_t)(m - ROW_SAMP) * 8 + lane_] = lf;
        }
#pragma unroll
        for (int j = 0; j < 4; ++j) { const f32x4 h = v[j] * rstd * gm[j]; o8[64 * j] = (unsigned long long)pk2(h.x, h.y) | ((unsigned long long)pk2(h.z, h.w) << 32); }
    }
}

__device__ __forceinline__ void p1_cumsum(Frame& F, int bh) {
    const int tid_ = tid_fresh(), lane_ = tid_ & 63, wave_ = __builtin_amdgcn_readfirstlane(tid_ >> 6); (void)lane_; (void)wave_;
    const float* LF = (const float*)(F.ws + WS_LF); float* NCL = (float*)(F.ws + WS_NCL) + (size_t)bh * attn_body::BIASN;
    const int b = bh >> 3, h = bh & 7; constexpr int PER = 17;
    LAS float* wt = (LAS float*)(F.lds + RING_OFF);
    const int i0 = tid_ * PER;
    float s = 0.f;
    for (int i = 0; i < PER; ++i) { const int p = i0 + i; if (p < TPOS) { const int row = p < NMETA ? ROW_META + p : b * TREAL + (p - NMETA); s += LF[(size_t)row * 8 + h]; } }
    float inc = s;
#pragma unroll
    for (int o = 1; o < 64; o <<= 1) { const float t = __shfl_up(inc, o); if (lane_ >= o) inc += t; }
    if (lane_ == 63) wt[wave_] = inc;
    __syncthreads();
    float base = inc - s;
    for (int w = 0; w < wave_; ++w) base += wt[w];
    float c = base;
    for (int i = 0; i < PER; ++i) { const int p = i0 + i; if (p < TPOS) { const int row = p < NMETA ? ROW_META + p : b * TREAL + (p - NMETA); c += LF[(size_t)row * 8 + h];
        NCL[p < NMETA ? p : 128 + (p - NMETA)] = -c * LOG2E; } }
    if (tid_ >= 16 && tid_ < 128) NCL[tid_] = -1e30f;
    __syncthreads();
}

namespace pg8 {
struct EpiIn {
    static constexpr bool PERM = true, AFTER_DRAIN = false;
    bf16_t* UR; bf16_t* QB; bf16_t* KB; bf16_t* VB; bf16_t* GB; float* QS; float* out;
    static __device__ __forceinline__ float sg(float x) { return __builtin_amdgcn_rcpf(1.0f + __builtin_amdgcn_exp2f(-1.4426950408889634f * x)); }
    __device__ __forceinline__ void operator()(const f32x4 (&acc)[2][2][4][2], const Unit& u, int wr, int wc, int fr, int fq) const {
        const int row0 = u.pm * BM + wr * 64 + fr, col0 = u.pn * BM + wc * 32 + 8 * fq; const int pn = u.pn;
        const bool real = u.pm < 64;
        const bool tail = (u.pm & 31) == 31;
#pragma unroll
        for (int ai = 0; ai < 2; ++ai)
#pragma unroll
            for (int m = 0; m < 4; ++m) { const int r = row0 + ai * HALF + m * 16;
#pragma unroll
                for (int bj = 0; bj < 2; ++bj) { const int c = col0 + bj * HALF; const f32x4 v0 = acc[ai][bj][m][0], v1 = acc[ai][bj][m][1];
                    if (pn < 7) {
                        { u32x4 w; w.x = cvt_pk_bf16(v0[0], v0[1]); w.y = cvt_pk_bf16(v0[2], v0[3]); w.z = cvt_pk_bf16(v1[0], v1[1]); w.w = cvt_pk_bf16(v1[2], v1[3]); *(u32x4*)(UR + (size_t)r * DSHIFT + c) = w; }
                        if (real) { if (tail && (r & 8191) == 8191) { float* q = out + O_SHP + (size_t)(r >> 13) * DSHIFT + c; *(f32x4*)q = v0; *(f32x4*)(q + 4) = v1; } }
                        else if (r >= ROW_SAMP && r < M_VALID) { float* q = out + O_SHS + (size_t)(r - ROW_SAMP) * DSHIFT + c; *(f32x4*)q = v0; *(f32x4*)(q + 4) = v1; }
                    } else if (pn < 9) {
                        const int cc = c - COL_Q; const float sc = attn_body::C2;
                        u32x4 w; w.x = cvt_pk_bf16(v0[0] * sc, v0[1] * sc); w.y = cvt_pk_bf16(v0[2] * sc, v0[3] * sc); w.z = cvt_pk_bf16(v1[0] * sc, v1[1] * sc); w.w = cvt_pk_bf16(v1[2] * sc, v1[3] * sc);
                        *(u32x4*)(QB + (size_t)r * 512 + cc) = w;
                        if (!real) { if (r >= ROW_SAMP && r < M_VALID) { float* q = QS + (size_t)(r - ROW_SAMP) * 512 + cc; *(f32x4*)q = v0; *(f32x4*)(q + 4) = v1; } }
                    } else if (pn < 13) {
                        const bool isk = pn < 11; const int cc = c - (isk ? COL_K : COL_V);
                        u32x4 w; w.x = cvt_pk_bf16(v0[0], v0[1]); w.y = cvt_pk_bf16(v0[2], v0[3]); w.z = cvt_pk_bf16(v1[0], v1[1]); w.w = cvt_pk_bf16(v1[2], v1[3]);
                        *(u32x4*)((isk ? KB : VB) + (size_t)r * 512 + cc) = w;
                        float* op = out + (isk ? O_KP : O_VP);
                        if (real) { float* q = op + ((size_t)(r >> 13) * TPOS + NMETA + (r & 8191)) * 512 + cc; *(f32x4*)q = v0; *(f32x4*)(q + 4) = v1; }
                        else if (r < ROW_SAMP) { float* q = op + (size_t)(r - ROW_META) * 512 + cc; *(f32x4*)q = v0; *(f32x4*)(q + 4) = v1; q += (size_t)TPOS * 512; *(f32x4*)q = v0; *(f32x4*)(q + 4) = v1; }
                        else if (r < M_VALID) { float* q = out + (isk ? O_KS : O_VS) + (size_t)(r - ROW_SAMP) * 512 + cc; *(f32x4*)q = v0; *(f32x4*)(q + 4) = v1; }
                    } else {
                        const int cc = c - COL_G;
                        u32x4 w; w.x = cvt_pk_bf16(sg(v0[0]), sg(v0[1])); w.y = cvt_pk_bf16(sg(v0[2]), sg(v0[3])); w.z = cvt_pk_bf16(sg(v1[0]), sg(v1[1])); w.w = cvt_pk_bf16(sg(v1[2]), sg(v1[3]));
                        *(u32x4*)(GB + (size_t)r * DG + cc) = w;
                    }
                } }
    }
};
struct EpiBrA {
    static constexpr bool PERM = true, AFTER_DRAIN = false;
    bf16_t* TMP; const bf16_t* GB;
    __device__ __forceinline__ void operator()(const f32x4 (&acc)[2][2][4][2], const Unit& u, int wr, int wc, int fr, int fq) const {
        const int row0 = u.pm * BM + wr * 64 + fr, col0 = u.pn * BM + wc * 32 + 8 * fq;
#pragma unroll
        for (int ai = 0; ai < 2; ++ai)
#pragma unroll
            for (int m = 0; m < 4; ++m) { const int r = row0 + ai * HALF + m * 16;
#pragma unroll
                for (int bj = 0; bj < 2; ++bj) { const int c = col0 + bj * HALF; const f32x4 v0 = acc[ai][bj][m][0], v1 = acc[ai][bj][m][1];
                    const u32x4 g = *(const u32x4*)(GB + (size_t)r * DG + c);
                    u32x4 w; w.x = cvt_pk_bf16(v0[0] * bflo(g.x), v0[1] * bfhi(g.x)); w.y = cvt_pk_bf16(v0[2] * bflo(g.y), v0[3] * bfhi(g.y)); w.z = cvt_pk_bf16(v1[0] * bflo(g.z), v1[1] * bfhi(g.z)); w.w = cvt_pk_bf16(v1[2] * bflo(g.w), v1[3] * bfhi(g.w));
                    *(u32x4*)(TMP + (size_t)r * 1024 + c) = w; } }
    }
};
struct EpiBrB {
    static constexpr bool PERM = true, AFTER_DRAIN = false;
    const bf16_t* TMP; const bf16_t* GB; bf16_t* MG;
    __device__ __forceinline__ void operator()(const f32x4 (&acc)[2][2][4][2], const Unit& u, int wr, int wc, int fr, int fq) const {
        const int row0 = u.pm * BM + wr * 64 + fr, col0 = u.pn * BM + wc * 32 + 8 * fq;
#pragma unroll
        for (int ai = 0; ai < 2; ++ai)
#pragma unroll
            for (int m = 0; m < 4; ++m) { const int r = row0 + ai * HALF + m * 16;
#pragma unroll
                for (int bj = 0; bj < 2; ++bj) { const int c = col0 + bj * HALF; const f32x4 v0 = acc[ai][bj][m][0], v1 = acc[ai][bj][m][1];
                    const u32x4 g = *(const u32x4*)(GB + (size_t)r * DG + 1024 + c);
                    const u32x4 tw = *(const u32x4*)(TMP + (size_t)r * 1024 + c); const f32x4 t0 = {bflo(tw.x), bfhi(tw.x), bflo(tw.y), bfhi(tw.y)}, t1 = {bflo(tw.z), bfhi(tw.z), bflo(tw.w), bfhi(tw.w)};
                    u32x4 w; w.x = cvt_pk_bf16(t0[0] + v0[0] * bflo(g.x), t0[1] + v0[1] * bfhi(g.x)); w.y = cvt_pk_bf16(t0[2] + v0[2] * bflo(g.y), t0[3] + v0[3] * bfhi(g.y));
                    w.z = cvt_pk_bf16(t1[0] + v1[0] * bflo(g.z), t1[1] + v1[1] * bfhi(g.z)); w.w = cvt_pk_bf16(t1[2] + v1[2] * bflo(g.w), t1[3] + v1[3] * bfhi(g.w));
                    *(u32x4*)(MG + (size_t)r * 1024 + c) = w; } }
    }
};
template <bool ADD> struct EpiRes {
    static constexpr bool PERM = true, AFTER_DRAIN = false;
    bf16_t* XB; float* SS; const float* xp;
    __device__ __forceinline__ void operator()(const f32x4 (&acc)[2][2][4][2], const Unit& u, int wr, int wc, int fr, int fq) const {
        const int row0 = u.pm * BM + wr * 64 + fr, col0 = u.pn * BM + wc * 32 + 8 * fq;
#pragma unroll
        for (int ai = 0; ai < 2; ++ai)
#pragma unroll
            for (int m = 0; m < 4; ++m) { const int r = row0 + ai * HALF + m * 16; float ssq = 0.f;
#pragma unroll
                for (int bj = 0; bj < 2; ++bj) { const int c = col0 + bj * HALF; f32x4 v0 = acc[ai][bj][m][0], v1 = acc[ai][bj][m][1];
                    if (ADD) { const u32x4 xw = *(const u32x4*)(XB + (size_t)r * 1024 + c); v0 += (f32x4){bflo(xw.x), bfhi(xw.x), bflo(xw.y), bfhi(xw.y)}; v1 += (f32x4){bflo(xw.z), bfhi(xw.z), bflo(xw.w), bfhi(xw.w)}; }
                    else { v0 += *(const f32x4*)(xp + (size_t)r * 1024 + c); v1 += *(const f32x4*)(xp + (size_t)r * 1024 + c + 4);
                        ssq += (v0[0] * v0[0] + v0[1] * v0[1]) + (v0[2] * v0[2] + v0[3] * v0[3]) + (v1[0] * v1[0] + v1[1] * v1[1]) + (v1[2] * v1[2] + v1[3] * v1[3]); }
                    u32x4 w; w.x = cvt_pk_bf16(v0[0], v0[1]); w.y = cvt_pk_bf16(v0[2], v0[3]); w.z = cvt_pk_bf16(v1[0], v1[1]); w.w = cvt_pk_bf16(v1[2], v1[3]);
                    *(u32x4*)(XB + (size_t)r * 1024 + c) = w; }
                if (!ADD) { ssq += __shfl_xor(ssq, 16); ssq += __shfl_xor(ssq, 32); if (fq == 0) SS[(size_t)r * 16 + u.pn * 4 + wc] = ssq; } }
    }
};
struct EpiUp {
    static constexpr bool PERM = true, AFTER_DRAIN = false;
    bf16_t* HF; const float* SS;
    __device__ __forceinline__ void operator()(const f32x4 (&acc)[2][2][4][2], const Unit& u, int wr, int wc, int fr, int fq) const {
        const int row0 = u.pm * BM + wr * 64 + fr, col0 = u.pn * BM + wc * 32 + 8 * fq;
#pragma unroll
        for (int ai = 0; ai < 2; ++ai)
#pragma unroll
            for (int m = 0; m < 4; ++m) { const int r = row0 + ai * HALF + m * 16;
                const f32x4* sp = (const f32x4*)(SS + (size_t)r * 16); const f32x4 s4 = (sp[0] + sp[1]) + (sp[2] + sp[3]);
                const float rstd = __builtin_amdgcn_rsqf(((s4[0] + s4[1]) + (s4[2] + s4[3])) * (1.f / 1024.f) + RMS_EPS);
#pragma unroll
                for (int bj = 0; bj < 2; ++bj) { const int c = col0 + bj * HALF; f32x4 v0 = acc[ai][bj][m][0] * rstd, v1 = acc[ai][bj][m][1] * rstd;
                    v0 = __builtin_elementwise_max(v0, (f32x4){0.f, 0.f, 0.f, 0.f}); v1 = __builtin_elementwise_max(v1, (f32x4){0.f, 0.f, 0.f, 0.f}); v0 = v0 * v0; v1 = v1 * v1;
                    u32x4 w; w.x = cvt_pk_bf16(v0[0], v0[1]); w.y = cvt_pk_bf16(v0[2], v0[3]); w.z = cvt_pk_bf16(v1[0], v1[1]); w.w = cvt_pk_bf16(v1[2], v1[3]);
                    *(u32x4*)(HF + (size_t)r * FF + c) = w; } }
    }
};
}

__device__ __forceinline__ const bf16* prev_row(const Frame& F, const bf16* UR, int row) {
    if (row < M_REAL) return (row & 8191) ? UR + (size_t)(row - 1) * DSHIFT : UR + (size_t)(ROW_SAMP - 1) * DSHIFT;
    return row > ROW_META ? UR + (size_t)(row - 1) * DSHIFT : (const bf16*)(F.ctl + CW_ZERO);
}
__device__ __forceinline__ void p2_prep(Frame& F, int tl) {
    const int tid_ = tid_fresh(), lane_ = tid_ & 63, wave_ = __builtin_amdgcn_readfirstlane(tid_ >> 6); (void)lane_; (void)wave_;
    float* PR = (float*)(F.ws + WS_PR); constexpr size_t PS = PSTRIDE / 4;
    LAS float* ACT = (LAS float*)(F.lds + RING_OFF);
    const int c = tid_;
    const float* mu = INP(I_MU);
    const float mu_r = mu[c], mu_k = mu[512 + c], mu_v = mu[1024 + c];
    const float w0 = INP(I_W0)[c], a0 = INP(I_A0)[c], kkc = INP(I_KK)[c], kac = INP(I_KA)[c];
    const float* Wd = INP(I_WDEC) + c; const float* Wa = INP(I_WA) + c; const float* Wg = INP(I_WG) + c;
    constexpr int NTILE = M_VALID / 16;
    (void)NTILE; {
        const int r0 = tl * 16;
        __syncthreads();
#pragma unroll
        for (int i = 0; i < 8; ++i) { const int e = tid_ + NTHR * i, rr = e >> 8, k = e & 255, row = r0 + rr;
            const float* cur = F.out + O_SHS + (size_t)(row - ROW_SAMP) * DSHIFT + 1536 + k; const float* prv = F.in[I_SSHIFT] + (size_t)(row - ROW_SAMP) * DSHIFT + 1536 + k;
            const float u = *cur, us = u + mu[1536 + k] * (*prv - u);
            ACT[k * 16 + rr] = k < 64 ? tanhf(us) : k < 128 ? us : sigmoidf_(us); }
        __syncthreads();
        float aw[16], aa[16], ag[16];
#pragma unroll
        for (int i = 0; i < 16; ++i) { aw[i] = 0.f; aa[i] = 0.f; ag[i] = 0.f; }
        for (int k = 0; k < 64; ++k) { const float wd = Wd[(size_t)k * 512], wa = Wa[(size_t)k * 512];
#pragma unroll
            for (int q = 0; q < 4; ++q) { const f32x4 x = *(const LAS f32x4*)(ACT + k * 16 + 4 * q), y = *(const LAS f32x4*)(ACT + (64 + k) * 16 + 4 * q);
                aw[4 * q] += x[0] * wd; aw[4 * q + 1] += x[1] * wd; aw[4 * q + 2] += x[2] * wd; aw[4 * q + 3] += x[3] * wd;
                aa[4 * q] += y[0] * wa; aa[4 * q + 1] += y[1] * wa; aa[4 * q + 2] += y[2] * wa; aa[4 * q + 3] += y[3] * wa; } }
        for (int k = 0; k < 128; ++k) { const float wg = Wg[(size_t)k * 512];
#pragma unroll
            for (int q = 0; q < 4; ++q) { const f32x4 x = *(const LAS f32x4*)(ACT + (128 + k) * 16 + 4 * q);
                ag[4 * q] += x[0] * wg; ag[4 * q + 1] += x[1] * wg; ag[4 * q + 2] += x[2] * wg; ag[4 * q + 3] += x[3] * wg; } }
#pragma unroll
        for (int i = 0; i < 16; ++i) { const int row = r0 + i;
            const float* cur = F.out + O_SHS + (size_t)(row - ROW_SAMP) * DSHIFT + c; const float* prv = F.in[I_SSHIFT] + (size_t)(row - ROW_SAMP) * DSHIFT + c;
            const float ur = cur[0], uk = cur[512], uv = cur[1024];
            const float r = ur + mu_r * (prv[0] - ur), k = uk + mu_k * (prv[512] - uk), v = uv + mu_v * (prv[1024] - uv);
            const float x = w0 + aw[i];
            const float sp = fmaxf(-x, 0.f) + log1pf(expf(-fabsf(x)));
            const float dec = expf(-expf(-sp - 0.5f));
            const float a = sigmoidf_(a0 + aa[i]);
            float kk = k * kkc; const float nrm = sqrtf(wave_sum(kk * kk)); kk = kk / fmaxf(nrm, 1e-12f);
            const float k2 = k * (1.0f + (a - 1.0f) * kac);
            const size_t o = (size_t)row * 512 + c;
            PR[o] = r; PR[PS + o] = dec; PR[2 * PS + o] = k2; PR[3 * PS + o] = v; PR[4 * PS + o] = kk; PR[5 * PS + o] = kk * a; PR[6 * PS + o] = ag[i]; }
    }
    __syncthreads();
}

__device__ __forceinline__ void p2_meta_attn(Frame& F) {
    const int tid_ = tid_fresh(), lane_ = tid_ & 63, wave_ = __builtin_amdgcn_readfirstlane(tid_ >> 6); (void)lane_; (void)wave_;
    const bf16* QB = (const bf16*)(F.ws + WS_QB); const bf16* KB = (const bf16*)(F.ws + WS_KB); const bf16* VB = (const bf16*)(F.ws + WS_VB); bf16* OC = (bf16*)(F.ws + WS_OC);
    const float* NCL = (const float*)(F.ws + WS_NCL);
    const int h = wave_, i = lane_ & 15, part = lane_ >> 4;
    float q[16];
    { const v4u* qp = (const v4u*)(QB + (size_t)(ROW_META + i) * 512 + h * 64 + part * 16); const v4u a = qp[0], b = qp[1];
      q[0] = bflo(a.x); q[1] = bfhi(a.x); q[2] = bflo(a.y); q[3] = bfhi(a.y); q[4] = bflo(a.z); q[5] = bfhi(a.z); q[6] = bflo(a.w); q[7] = bfhi(a.w);
      q[8] = bflo(b.x); q[9] = bfhi(b.x); q[10] = bflo(b.y); q[11] = bfhi(b.y); q[12] = bflo(b.z); q[13] = bfhi(b.z); q[14] = bflo(b.w); q[15] = bfhi(b.w); }
    float s[16]; const float nci = NCL[(size_t)h * attn_body::BIASN + i];
#pragma unroll
    for (int j = 0; j < 16; ++j) { const v4u* kp = (const v4u*)(KB + (size_t)(ROW_META + j) * 512 + h * 64 + part * 16); const v4u a = kp[0], b = kp[1];
        float d = q[0] * bflo(a.x) + q[1] * bfhi(a.x) + q[2] * bflo(a.y) + q[3] * bfhi(a.y) + q[4] * bflo(a.z) + q[5] * bfhi(a.z) + q[6] * bflo(a.w) + q[7] * bfhi(a.w)
                + q[8] * bflo(b.x) + q[9] * bfhi(b.x) + q[10] * bflo(b.y) + q[11] * bfhi(b.y) + q[12] * bflo(b.z) + q[13] * bfhi(b.z) + q[14] * bflo(b.w) + q[15] * bfhi(b.w);
        d += __shfl_xor(d, 16); d += __shfl_xor(d, 32);
        s[j] = (j <= i) ? d + NCL[(size_t)h * attn_body::BIASN + j] - nci : -INFINITY; }
    float mx = s[0];
#pragma unroll
    for (int j = 1; j < 16; ++j) mx = fmaxf(mx, s[j]);
    float l = 0.f; float o[16];
#pragma unroll
    for (int d = 0; d < 16; ++d) o[d] = 0.f;
#pragma unroll
    for (int j = 0; j < 16; ++j) { const float p = exp2f(s[j] - mx); l += p;
        const v4u* vp = (const v4u*)(VB + (size_t)(ROW_META + j) * 512 + h * 64 + part * 16); const v4u a = vp[0], b = vp[1];
        o[0] += p * bflo(a.x); o[1] += p * bfhi(a.x); o[2] += p * bflo(a.y); o[3] += p * bfhi(a.y); o[4] += p * bflo(a.z); o[5] += p * bfhi(a.z); o[6] += p * bflo(a.w); o[7] += p * bfhi(a.w);
        o[8] += p * bflo(b.x); o[9] += p * bfhi(b.x); o[10] += p * bflo(b.y); o[11] += p * bfhi(b.y); o[12] += p * bflo(b.z); o[13] += p * bfhi(b.z); o[14] += p * bflo(b.w); o[15] += p * bfhi(b.w); }
    const float rl = 1.0f / l;
    v4u w0, w1; w0.x = pk2(o[0] * rl, o[1] * rl); w0.y = pk2(o[2] * rl, o[3] * rl); w0.z = pk2(o[4] * rl, o[5] * rl); w0.w = pk2(o[6] * rl, o[7] * rl);
    w1.x = pk2(o[8] * rl, o[9] * rl); w1.y = pk2(o[10] * rl, o[11] * rl); w1.z = pk2(o[12] * rl, o[13] * rl); w1.w = pk2(o[14] * rl, o[15] * rl);
    v4u* op = (v4u*)(OC + (size_t)(ROW_META + i) * 1024 + 512 + h * 64 + part * 16); op[0] = w0; op[1] = w1;
}

constexpr int PART_STRIDE = 80;
struct DecK { f32x4 k[4]; };
struct DecV { f32x4 v[4]; };
__device__ __forceinline__ void dec_ld(const Frame& F, DecK& K, DecV& V, int pgv, int h, int c, int cend, int g, int kq) {
    c = c < cend ? c : cend - 1;
    const int page = __builtin_amdgcn_readlane(pgv, c >> 3), pos0 = (c & 7) * 16;
    const size_t off = (size_t)page * (PAGE * 512) + h * 64 + 4 * kq + (size_t)(pos0 + g) * 512;
    const float* Kp = F.in[I_CK] + off; const float* Vp = F.in[I_CV] + off;
#pragma unroll
    for (int i = 0; i < 4; ++i) K.k[i] = __builtin_nontemporal_load((const f32x4*)(Kp + (size_t)(4 * i) * 512));
#pragma unroll
    for (int i = 0; i < 4; ++i) V.v[i] = __builtin_nontemporal_load((const f32x4*)(Vp + (size_t)(4 * i) * 512));
}
__device__ __forceinline__ float dec_lf(const Frame& F, int pgv, int h, int S, int Send, int lane) {
    S = S < Send ? S : Send - 1;
    const int page = __builtin_amdgcn_readlane(pgv, S >> 1);
    return F.in[I_CLF][(size_t)page * (PAGE * 8) + (size_t)((S & 1) * 64 + lane) * 8 + h];
}
template <int CC> __device__ __forceinline__ void dec_dot(const DecK& K, const f32x4 q4, float& smine, int kq) {
#pragma unroll
    for (int i = 0; i < 4; ++i) { float d = (K.k[i][0] * q4[0] + K.k[i][1] * q4[1]) + (K.k[i][2] * q4[2] + K.k[i][3] * q4[3]);
        d = red16(d); smine = (kq == 4 * CC + i) ? d : smine; }
}
__device__ __forceinline__ void dec_update(const DecV& V0, const DecV& V1, const DecV& V2, const DecV& V3, float lf, float smine, float& m, float& l, float& csum, f32x4& o4, int lane, int g, int kq) {
    float inc = lf;
#pragma unroll
    for (int o = 1; o < 64; o <<= 1) { const float t = __shfl_up(inc, o); if (lane >= o) inc += t; }
    const float cpos = __shfl(inc, 16 * (kq >> 2) + 4 * (kq & 3) + g), ctot = __shfl(inc, 63);
    const float s = smine - (csum + cpos);
    csum += ctot;
    const float mc = wred_max(s), mn = fmaxf(m, mc), alpha = __expf(m - mn), p = __expf(s - mn);
    l = l * alpha + wred_sum(p); m = mn; o4 = o4 * alpha;
#define DEC_PV(V, CC) _Pragma("unroll") for (int i = 0; i < 4; ++i) { const float pi = __shfl(p, g * 16 + 4 * (CC) + i); o4 += V.v[i] * pi; }
    DEC_PV(V0, 0) DEC_PV(V1, 1) DEC_PV(V2, 2) DEC_PV(V3, 3)
#undef DEC_PV
}
__device__ __forceinline__ void p2_decode_split(Frame& F, int item, int half) {
    const int tid_ = tid_fresh(), lane_ = tid_ & 63, wave_ = __builtin_amdgcn_readfirstlane(tid_ >> 6);
    const int bt = item >> 3, sp = item & 7, h = wave_, kq = lane_ & 15, g = lane_ >> 4;
    const float* QS = (const float*)(F.ws + WS_QS); float* PART = (float*)(F.ws + (half ? WS_PART2 : WS_PART)) + (size_t)((bt * NSPLIT + sp) * NH + h) * PART_STRIDE;
    const int* PT = (const int*)INP(I_PT);
    f32x4 q4 = *(const f32x4*)(QS + (size_t)bt * 512 + h * 64 + 4 * kq); q4 = q4 * 0.125f;
    float m = -1e30f, l = 0.f, csum = 0.f; f32x4 o4 = {0.f, 0.f, 0.f, 0.f};
    const int cbeg = half * 32, cend = cbeg + 32;
    DecK K0, K1, K2, K3; DecV V0, V1, V2, V3, V4, V5, V6, V7;
    const int pgv = PT[bt * NPAGES + sp * 8 + (lane_ & 7)];
#define DL(KX, VX, c) do { __builtin_amdgcn_sched_barrier(0); dec_ld(F, KX, VX, pgv, h, (c), cend, g, kq); __builtin_amdgcn_sched_barrier(0); } while (0)
#define DLF(S) dec_lf(F, pgv, h, (S), cend >> 2, lane_)
#define DU(A, B, C, D, LFV) dec_update(A, B, C, D, LFV, sm, m, l, csum, o4, lane_, g, kq)
    DL(K0, V0, cbeg); DL(K1, V1, cbeg + 1); DL(K2, V2, cbeg + 2);
    float lfA = DLF(cbeg >> 2), lfB;
#pragma unroll 1
    for (int c = cbeg; c < cend; c += 8) {
        float sm = 0.f;
        DL(K3, V3, c + 3); dec_dot<0>(K0, q4, sm, kq);
        DL(K0, V4, c + 4); dec_dot<1>(K1, q4, sm, kq);
        DL(K1, V5, c + 5); dec_dot<2>(K2, q4, sm, kq);
        DL(K2, V6, c + 6); dec_dot<3>(K3, q4, sm, kq);
        lfB = DLF((c >> 2) + 1);
        DU(V0, V1, V2, V3, lfA);
        sm = 0.f;
        DL(K3, V7, c + 7); dec_dot<0>(K0, q4, sm, kq);
        DL(K0, V0, c + 8); dec_dot<1>(K1, q4, sm, kq);
        DL(K1, V1, c + 9); dec_dot<2>(K2, q4, sm, kq);
        DL(K2, V2, c + 10); dec_dot<3>(K3, q4, sm, kq);
        lfA = DLF((c >> 2) + 2);
        DU(V4, V5, V6, V7, lfB);
    }
#undef DL
#undef DLF
#undef DU
#pragma unroll
    for (int e = 0; e < 4; ++e) { float t = o4[e]; t += __shfl_xor(t, 16); t += __shfl_xor(t, 32); o4[e] = t; }
    if (g == 0) *(f32x4*)(PART + 16 + 4 * kq) = o4;
    if (lane_ == 0) { PART[0] = m; PART[1] = l; PART[2] = csum; }
}

__device__ __forceinline__ void p2_scan_sample(Frame& F, int item) {
    const int tid_ = tid_fresh(), lane_ = tid_ & 63, wave_ = __builtin_amdgcn_readfirstlane(tid_ >> 6); (void)lane_; (void)wave_;
    const int bt = item >> 3, h = item & 7, v = tid_ >> 3, k8 = tid_ & 7;
    const float* PR = (const float*)(F.ws + WS_PR); constexpr size_t PS = PSTRIDE / 4;
    float* Y = (float*)(F.ws + WS_Y);
    const size_t ro = (size_t)(ROW_SAMP + bt) * 512 + h * 64, so = ((size_t)(bt * 8 + h) * 64 + v) * 64 + 8 * k8;
    const float vv = PR[3 * PS + ro + v];
    float u = 0.f; f32x4 S[2];
#pragma unroll
    for (int e = 0; e < 2; ++e) { S[e] = *(const f32x4*)(INP(I_SWKV) + so + 4 * e); const f32x4 kk4 = *(const f32x4*)(PR + 4 * PS + ro + 8 * k8 + 4 * e);
        u += (S[e][0] * kk4[0] + S[e][1] * kk4[1]) + (S[e][2] * kk4[2] + S[e][3] * kk4[3]); }
    u += __shfl_xor(u, 1); u += __shfl_xor(u, 2); u += __shfl_xor(u, 4);
    float y = 0.f;
#pragma unroll
    for (int e = 0; e < 2; ++e) { const f32x4 w4 = *(const f32x4*)(PR + PS + ro + 8 * k8 + 4 * e), b4 = *(const f32x4*)(PR + 5 * PS + ro + 8 * k8 + 4 * e),
                                              k4 = *(const f32x4*)(PR + 2 * PS + ro + 8 * k8 + 4 * e), r4 = *(const f32x4*)(PR + ro + 8 * k8 + 4 * e);
        S[e] = S[e] * w4 + k4 * vv - b4 * u;
        y += (S[e][0] * r4[0] + S[e][1] * r4[1]) + (S[e][2] * r4[2] + S[e][3] * r4[3]);
        *(f32x4*)(F.out + O_WKVS + so + 4 * e) = S[e]; }
    y += __shfl_xor(y, 1); y += __shfl_xor(y, 2); y += __shfl_xor(y, 4);
    if (k8 == 0) Y[ro + v] = y;
}

__device__ __forceinline__ void p2_post(Frame& F) {
    const int tid_ = tid_fresh(), lane_ = tid_ & 63, wave_ = __builtin_amdgcn_readfirstlane(tid_ >> 6); (void)lane_; (void)wave_;
    const float* PR = (const float*)(F.ws + WS_PR); constexpr size_t PS = PSTRIDE / 4;
    const float* Y = (const float*)(F.ws + WS_Y); bf16* OC = (bf16*)(F.ws + WS_OC);
    const int c = tid_;
    const float lw = INP(I_LNW)[c], lb = INP(I_LNB)[c], rk = INP(I_RK)[c];
    for (int row = ROW_SAMP + F.vcu; row < M_VALID; row += F.G) {
        const size_t o = (size_t)row * 512 + c;
        const float y = Y[o], r = PR[o], k = PR[2 * PS + o], v = PR[3 * PS + o], g = PR[6 * PS + o];
        const float mu = wave_sum(y) * (1.f / 64.f), d = y - mu, var = wave_sum(d * d) * (1.f / 64.f);
        const float yn = d * (1.0f / sqrtf(var + GN_EPS)) * lw + lb;
        const float bonus = wave_sum(r * k * rk) * v;
        const float ov = (yn + bonus) * g;
        const float on = __shfl_down(ov, 1);
        if ((lane_ & 1) == 0) *(unsigned*)(OC + (size_t)row * 1024 + c) = pk2(ov, on);
    }
}
__device__ __forceinline__ void p2_decode_combine(Frame& F, int bt) {
    const int tid_ = tid_fresh(), lane_ = tid_ & 63, wave_ = __builtin_amdgcn_readfirstlane(tid_ >> 6); (void)lane_; (void)wave_;
    const int h = wave_, d = lane_;
    const float* QS = (const float*)(F.ws + WS_QS); const float* PART = (const float*)(F.ws + WS_PART) + (size_t)(bt * NSPLIT * NH + h) * PART_STRIDE;
    const float* LF = (const float*)(F.ws + WS_LF); bf16* OC = (bf16*)(F.ws + WS_OC);
    const float kn = F.out[O_KS + (size_t)bt * 512 + h * 64 + d], vn = F.out[O_VS + (size_t)bt * 512 + h * 64 + d], qn = QS[(size_t)bt * 512 + h * 64 + d];
    const float snew = wave_sum(qn * kn) * 0.125f;
    float off = LF[(size_t)(ROW_SAMP + bt) * 8 + h];
    const float* PART2 = (const float*)(F.ws + WS_PART2) + (size_t)(bt * NSPLIT * NH + h) * PART_STRIDE;
    float Ms[2 * NSPLIT]; float M = snew;
#pragma unroll
    for (int j = 2 * NSPLIT - 1; j >= 0; --j) { const float* P = ((j & 1) ? PART2 : PART) + (size_t)(j >> 1) * NH * PART_STRIDE; Ms[j] = P[0] + P[2] + off; off += P[2]; M = fmaxf(M, Ms[j]); }
    float w = __expf(snew - M), L = w, o = w * vn;
#pragma unroll
    for (int j = 0; j < 2 * NSPLIT; ++j) { const float* P = ((j & 1) ? PART2 : PART) + (size_t)(j >> 1) * NH * PART_STRIDE; w = __expf(Ms[j] - M); L += w * P[1]; o += w * P[16 + d]; }
    const float ov = o / L, on = __shfl_down(ov, 1);
    if ((d & 1) == 0) *(unsigned*)(OC + (size_t)(ROW_SAMP + bt) * 1024 + 512 + h * 64 + d) = pk2(ov, on);
}

__device__ __forceinline__ void p6_norm_final(Frame& F) {
    const int tid_ = tid_fresh(), lane_ = tid_ & 63, wave_ = __builtin_amdgcn_readfirstlane(tid_ >> 6);
    const int gw = F.vcu * NWAVES + wave_, NGW = F.G * NWAVES;
    const bf16* XB = (const bf16*)(F.ws + WS_X1);
    const float* gf = INP(I_NFIN);
    const f32x4 g0 = *(const f32x4*)(gf + 8 * lane_), g1 = *(const f32x4*)(gf + 8 * lane_ + 4), g2 = *(const f32x4*)(gf + 512 + 8 * lane_), g3 = *(const f32x4*)(gf + 516 + 8 * lane_);
    for (int m = gw; m < M_VALID; m += NGW) {
        if (m >= M_REAL && m < ROW_SAMP) continue;
        const v4u wa = *(const v4u*)(XB + (size_t)m * DMOD + 8 * lane_), wb = *(const v4u*)(XB + (size_t)m * DMOD + 512 + 8 * lane_);
        const f32x4 v0 = {bflo(wa.x), bfhi(wa.x), bflo(wa.y), bfhi(wa.y)}, v1 = {bflo(wa.z), bfhi(wa.z), bflo(wa.w), bfhi(wa.w)}, v2 = {bflo(wb.x), bfhi(wb.x), bflo(wb.y), bfhi(wb.y)}, v3 = {bflo(wb.z), bfhi(wb.z), bflo(wb.w), bfhi(wb.w)};
        const f32x4 sq = (v0 * v0 + v1 * v1) + (v2 * v2 + v3 * v3);
        const float rstd = 1.0f / sqrtf(wave_sum((sq[0] + sq[1]) + (sq[2] + sq[3])) * (1.f / DMOD) + RMS_EPS);
        float* o = F.out + (m < M_REAL ? O_YP + (size_t)m * DMOD : O_YS + (size_t)(m - ROW_SAMP) * DMOD);
        *(f32x4*)(o + 8 * lane_) = v0 * rstd * g0; *(f32x4*)(o + 8 * lane_ + 4) = v1 * rstd * g1; *(f32x4*)(o + 512 + 8 * lane_) = v2 * rstd * g2; *(f32x4*)(o + 516 + 8 * lane_) = v3 * rstd * g3;
    }
}

constexpr int NCH = 129, NUNIT = 16 * NCH, TPB = 72;
constexpr int RA_KK = 0, RA_BB = 9216, RA_KT = 18432, RA_RT = 27648, RA_KET = 36864, RA_BET = 46080, RA_VMT = 55296, RA_AB = 64512, RA_BM = 73728, RA_ARK = 82944, RA_ARB = 92160,
              RA_XT = 101376, RA_DIAG = 119808, RA_ZS = 123904, RA_GC = 134144, RA_SEG = 134400, RA_END = 136448;
constexpr int RA_ACTW = 0, RA_ACTA = 9216, RA_ACTG = 18432, RA_WLF = 64512, RA_ALF = 81920, RA_GLF = 99328, RA_GAM = 116736, RA_BVF = RA_BB;
constexpr int FP = 68, ZP = 20, GP = 136;
static_assert(RA_END <= RING_BYTES && RA_GAM + 64 * FP * 4 <= RA_GC && RA_ACTG + 64 * GP * 2 <= RA_AB, "rwkv chunk LDS map");
constexpr size_t UE = 4096;

__device__ __forceinline__ int chunk_row(int b, int c, int t) { return c == 0 ? (t < NMETA ? ROW_META + t : -1) : b * TREAL + 64 * (c - 1) + t; }
#define FRAG_L(base, pitch, row, k) (*(const LAS bf16x8*)((const LAS bf16*)(base) + (row) * (pitch) + (k)))
#define FRAG_G(base, pitch, row, k) (*(const bf16x8*)((const bf16*)(base) + (size_t)(row) * (pitch) + (k)))
#define MMA16(acc, af, bf_) acc = __builtin_amdgcn_mfma_f32_16x16x32_bf16(af, bf_, acc, 0, 0, 0)
__device__ __forceinline__ f32x4 prod_ll(const LAS unsigned char* X, const LAS unsigned char* Y, int r0, int c0, int l15, int kg, f32x4 acc) {
#pragma unroll
    for (int k0 = 0; k0 < 64; k0 += 32) MMA16(acc, FRAG_L(Y, TPB, c0 + l15, k0 + 8 * kg), FRAG_L(X, TPB, r0 + l15, k0 + 8 * kg));
    return acc;
}
__device__ __forceinline__ v2u pk4(f32x4 v) { v2u w; w.x = pk2(v[0], v[1]); w.y = pk2(v[2], v[3]); return w; }
__device__ __forceinline__ f32x4 unpk4(v2u w) { return (f32x4){bflo(w.x), bfhi(w.x), bflo(w.y), bfhi(w.y)}; }
__device__ __forceinline__ float fsig(float x) { return __builtin_amdgcn_rcpf(1.0f + __builtin_amdgcn_exp2f(-LOG2E * x)); }
struct F8 { f32x4 a, b; };
__device__ __forceinline__ F8 ld8(const float* p) { F8 r; r.a = *(const f32x4*)p; r.b = *(const f32x4*)(p + 4); return r; }
__device__ __forceinline__ F8 ld8b(const bf16* p) { const v4u w = *(const v4u*)p; F8 r; r.a = (f32x4){bflo(w.x), bfhi(w.x), bflo(w.y), bfhi(w.y)}; r.b = (f32x4){bflo(w.z), bfhi(w.z), bflo(w.w), bfhi(w.w)}; return r; }
__device__ __forceinline__ F8 ld8l(const LAS float* p) { F8 r; r.a = *(const LAS f32x4*)p; r.b = *(const LAS f32x4*)(p + 4); return r; }
__device__ __forceinline__ float f8g(const F8& x, int e) { return e < 4 ? x.a[e] : x.b[e - 4]; }
__device__ __forceinline__ v4u pk8(const float (&v)[8]) { v4u w; w.x = pk2(v[0], v[1]); w.y = pk2(v[2], v[3]); w.z = pk2(v[4], v[5]); w.w = pk2(v[6], v[7]); return w; }

#define LBAR() asm volatile("s_waitcnt lgkmcnt(0)\n\ts_barrier" ::: "memory")
constexpr int DLIM = 32;
struct DecS { f32x4 k[4], v[4]; float lf; };
struct DecCtx { f32x4 q4, o4; float m, l, csum; int pgv, c; };
__device__ __forceinline__ void decs_load(const Frame& F, DecS& B, const DecCtx& D, int c, int hd, int lane) {
    const int kq = lane & 15, g = lane >> 4;
    const int page = __builtin_amdgcn_readlane(D.pgv, c >> 3), pos0 = (c & 7) * 16;
    const size_t off = (size_t)page * (PAGE * 512) + hd * 64 + 4 * kq + (size_t)(pos0 + g) * 512;
    const float* Kp = F.in[I_CK] + off; const float* Vp = F.in[I_CV] + off;
#pragma unroll
    for (int i = 0; i < 4; ++i) B.k[i] = __builtin_nontemporal_load((const f32x4*)(Kp + (size_t)(4 * i) * 512));
#pragma unroll
    for (int i = 0; i < 4; ++i) B.v[i] = __builtin_nontemporal_load((const f32x4*)(Vp + (size_t)(4 * i) * 512));
    B.lf = F.in[I_CLF][(size_t)page * (PAGE * 8) + (size_t)(pos0 + kq) * 8 + hd];
}
__device__ __forceinline__ void decs_use(const DecS& B, DecCtx& D, int lane) {
    const int kq = lane & 15, g = lane >> 4;
    float smine = 0.f;
#pragma unroll
    for (int i = 0; i < 4; ++i) { float d = (B.k[i][0] * D.q4[0] + B.k[i][1] * D.q4[1]) + (B.k[i][2] * D.q4[2] + B.k[i][3] * D.q4[3]);
        d = red16(d); smine = ((kq & 3) == i) ? d : smine; }
    float inc = B.lf;
    inc += dpp_f<0x111>(inc); inc += dpp_f<0x112>(inc); inc += dpp_f<0x114>(inc); inc += dpp_f<0x118>(inc);
    const float cpos = __shfl(inc, 4 * (kq & 3) + g);
    const float ctot = __uint_as_float(__builtin_amdgcn_readlane(__float_as_uint(inc), 15));
    const float s = smine - (D.csum + cpos);
    D.csum += ctot;
    const float mc = wred_max(s), mn = fmaxf(D.m, mc), alpha = __expf(D.m - mn), p = __expf(s - mn);
    D.l = D.l * alpha + 0.25f * wred_sum(p); D.m = mn; D.o4 = D.o4 * alpha;
    D.o4 += B.v[0] * dpp_f<0x00>(p); D.o4 += B.v[1] * dpp_f<0x55>(p); D.o4 += B.v[2] * dpp_f<0xAA>(p); D.o4 += B.v[3] * dpp_f<0xFF>(p);
}
__device__ __forceinline__ F8 unb(v4u w) { F8 r; r.a = (f32x4){bflo(w.x), bfhi(w.x), bflo(w.y), bfhi(w.y)}; r.b = (f32x4){bflo(w.z), bfhi(w.z), bflo(w.w), bfhi(w.w)}; return r; }
struct RaPre { v4u cw, pw, ca, pa, cg0, pg0, cg1, pg1; };
__device__ __forceinline__ void ra_prefetch(Frame& F, int u, RaPre& P) {
    const int tid = tid_fresh(); const int bh = u / NCH, c = u - bh * NCH, b = bh >> 3, h = bh & 7, t = tid >> 3, j8 = tid & 7, row = chunk_row(b, c, t);
    const bf16* UR = (const bf16*)(F.ws + WS_UR);
    const bf16* zr = (const bf16*)(F.ctl + CW_ZERO);
    const bf16* cur = row >= 0 ? UR + (size_t)row * DSHIFT : zr; const bf16* prv = row >= 0 ? prev_row(F, UR, row) : zr; (void)h;
    P.cw = *(const v4u*)(cur + 1536 + 8 * j8); P.pw = *(const v4u*)(prv + 1536 + 8 * j8); P.ca = *(const v4u*)(cur + 1600 + 8 * j8); P.pa = *(const v4u*)(prv + 1600 + 8 * j8);
    P.cg0 = *(const v4u*)(cur + 1664 + 16 * j8); P.pg0 = *(const v4u*)(prv + 1664 + 16 * j8); P.cg1 = *(const v4u*)(cur + 1672 + 16 * j8); P.pg1 = *(const v4u*)(prv + 1672 + 16 * j8);
}
__device__ __forceinline__ void rwkv_chunk_unit(Frame& F, int u, const RaPre& P, int un, RaPre& Pn, int uprev, DecCtx& D, DecS& DA) {
    const int tid = tid_fresh(), lane = tid & 63, wave = __builtin_amdgcn_readfirstlane(tid >> 6), l15 = lane & 15, kg = lane >> 4;
    const int bh = u / NCH, c = u - bh * NCH, b = bh >> 3, h = bh & 7;
    const int dc0 = D.c; const bool dgo = dc0 + 4 <= DLIM; DecS DB;
    LAS unsigned char* L = F.lds + RING_OFF;
    const int t = tid >> 3, j8 = tid & 7;
    const int row = chunk_row(b, c, t);
    const float* mu = INP(I_MU);
    const int r0 = 16 * (wave >> 1), cb = 32 * (wave & 1);
    float vr[8], vk2[8], vv[8], vkk[8], vb[8];
    if (row >= 0) {
        const int n0 = h * 64 + 8 * j8;
        const bf16* UR = (const bf16*)(F.ws + WS_UR); const bf16* cur = UR + (size_t)row * DSHIFT; const bf16* prv = prev_row(F, UR, row);
        const F8 cr = ld8b(cur + n0), pr = ld8b(prv + n0), mr = ld8(mu + n0), ck = ld8b(cur + 512 + n0), pk = ld8b(prv + 512 + n0), mk = ld8(mu + 512 + n0), cv = ld8b(cur + 1024 + n0), pv = ld8b(prv + 1024 + n0), mv = ld8(mu + 1024 + n0);
#pragma unroll
        for (int e = 0; e < 8; ++e) { const float ur = f8g(cr, e), uk = f8g(ck, e), uv = f8g(cv, e);
            vr[e] = ur + f8g(mr, e) * (f8g(pr, e) - ur); vk2[e] = uk + f8g(mk, e) * (f8g(pk, e) - uk); vv[e] = uv + f8g(mv, e) * (f8g(pv, e) - uv); }
    }
    LBAR();
    {
        float aw[8], aa[8], ag[16];
        if (row >= 0) {
            const F8 cw = unb(P.cw), pw = unb(P.pw), mw = ld8(mu + 1536 + 8 * j8);
            const F8 ca = unb(P.ca), pa = unb(P.pa), ma = ld8(mu + 1600 + 8 * j8);
#pragma unroll
            for (int e = 0; e < 8; ++e) { const float x = f8g(cw, e), y = f8g(ca, e); aw[e] = 2.0f * fsig(2.0f * (x + f8g(mw, e) * (f8g(pw, e) - x))) - 1.0f; aa[e] = y + f8g(ma, e) * (f8g(pa, e) - y); }
#pragma unroll
            for (int hh = 0; hh < 2; ++hh) { const F8 cg = unb(hh ? P.cg1 : P.cg0), pg = unb(hh ? P.pg1 : P.pg0), mg = ld8(mu + 1664 + 16 * j8 + 8 * hh);
#pragma unroll
                for (int e = 0; e < 8; ++e) { const float x = f8g(cg, e); ag[8 * hh + e] = fsig(x + f8g(mg, e) * (f8g(pg, e) - x)); } }
        } else {
#pragma unroll
            for (int e = 0; e < 8; ++e) { aw[e] = 0.f; aa[e] = 0.f; ag[e] = 0.f; ag[8 + e] = 0.f; }
        }
        v4u w; w.x = pk2(aw[0], aw[1]); w.y = pk2(aw[2], aw[3]); w.z = pk2(aw[4], aw[5]); w.w = pk2(aw[6], aw[7]);
        *(LAS v4u*)(L + RA_ACTW + (t * TPB + 8 * j8) * 2) = w;
        w.x = pk2(aa[0], aa[1]); w.y = pk2(aa[2], aa[3]); w.z = pk2(aa[4], aa[5]); w.w = pk2(aa[6], aa[7]);
        *(LAS v4u*)(L + RA_ACTA + (t * TPB + 8 * j8) * 2) = w;
        w.x = pk2(ag[0], ag[1]); w.y = pk2(ag[2], ag[3]); w.z = pk2(ag[4], ag[5]); w.w = pk2(ag[6], ag[7]);
        *(LAS v4u*)(L + RA_ACTG + (t * GP + 16 * j8) * 2) = w;
        w.x = pk2(ag[8], ag[9]); w.y = pk2(ag[10], ag[11]); w.z = pk2(ag[12], ag[13]); w.w = pk2(ag[14], ag[15]);
        *(LAS v4u*)(L + RA_ACTG + (t * GP + 16 * j8 + 8) * 2) = w;
    }
    LBAR();
    {
        const bf16* WdT = (const bf16*)(F.ws + WS_WDT) + (size_t)h * 64 * 64; const bf16* WaT = (const bf16*)(F.ws + WS_WAT) + (size_t)h * 64 * 64; const bf16* WgT = (const bf16*)(F.ws + WS_WGT) + (size_t)h * 64 * 128;
#pragma unroll
        for (int q = 0; q < 2; ++q) { const int c0 = cb + 16 * q; f32x4 xw = {0.f, 0.f, 0.f, 0.f}, xa = xw, xg = xw;
#pragma unroll
            for (int k0 = 0; k0 < 64; k0 += 32) { MMA16(xw, FRAG_G(WdT, 64, c0 + l15, k0 + 8 * kg), FRAG_L(L + RA_ACTW, TPB, r0 + l15, k0 + 8 * kg));
                                                  MMA16(xa, FRAG_G(WaT, 64, c0 + l15, k0 + 8 * kg), FRAG_L(L + RA_ACTA, TPB, r0 + l15, k0 + 8 * kg)); }
#pragma unroll
            for (int k0 = 0; k0 < 128; k0 += 32) MMA16(xg, FRAG_G(WgT, 128, c0 + l15, k0 + 8 * kg), FRAG_L(L + RA_ACTG, GP, r0 + l15, k0 + 8 * kg));
            const int o = ((r0 + l15) * FP + c0 + 4 * kg) * 4;
            *(LAS f32x4*)(L + RA_WLF + o) = xw; *(LAS f32x4*)(L + RA_ALF + o) = xa; *(LAS f32x4*)(L + RA_GLF + o) = xg; }
    }
    LBAR();
    asm volatile("s_waitcnt vmcnt(0)" ::: "memory");
    {
        const int n0 = h * 64 + 8 * j8;
        float wv[8], g1[8], g2[8];
        if (row >= 0) {
            const F8 w0 = ld8(INP(I_W0) + n0), a0 = ld8(INP(I_A0) + n0), kkc = ld8(INP(I_KK) + n0), kac = ld8(INP(I_KA) + n0), rkc = ld8(INP(I_RK) + n0), lw = ld8(INP(I_LNW) + n0), lb = ld8(INP(I_LNB) + n0);
            const F8 wl = ld8l((const LAS float*)(L + RA_WLF) + t * FP + 8 * j8), al_ = ld8l((const LAS float*)(L + RA_ALF) + t * FP + 8 * j8), gl = ld8l((const LAS float*)(L + RA_GLF) + t * FP + 8 * j8);
            float nrm = 0.f, bs = 0.f, av[8], gv[8];
#pragma unroll
            for (int e = 0; e < 8; ++e) {
                const float r = vr[e], k = vk2[e], v = vv[e];
                const float x = f8g(w0, e) + f8g(wl, e);
                wv[e] = __builtin_amdgcn_exp2f(-(0.60653066f * LOG2E) * fsig(x));
                const float a = fsig(f8g(a0, e) + f8g(al_, e));
                const float kr = k * f8g(kkc, e), k2 = k * (1.0f + (a - 1.0f) * f8g(kac, e));
                nrm += kr * kr; bs += r * k2 * f8g(rkc, e);
                vr[e] = r; vk2[e] = k2; vv[e] = v; vkk[e] = kr; av[e] = a; gv[e] = f8g(gl, e);
            }
            nrm += __shfl_xor(nrm, 1); nrm += __shfl_xor(nrm, 2); nrm += __shfl_xor(nrm, 4);
            bs += __shfl_xor(bs, 1); bs += __shfl_xor(bs, 2); bs += __shfl_xor(bs, 4);
            const float rn = __builtin_amdgcn_rsqf(fmaxf(nrm, 1e-24f));
#pragma unroll
            for (int e = 0; e < 8; ++e) { vkk[e] *= rn; vb[e] = vkk[e] * av[e]; g1[e] = f8g(lw, e) * gv[e]; g2[e] = (f8g(lb, e) + bs * vv[e]) * gv[e]; }
        } else {
#pragma unroll
            for (int e = 0; e < 8; ++e) { vr[e] = 0.f; vk2[e] = 0.f; vv[e] = 0.f; vkk[e] = 0.f; vb[e] = 0.f; wv[e] = 1.0f; g1[e] = 0.f; g2[e] = 0.f; }
        }
        LAS float* gm = (LAS float*)(L + RA_GAM) + t * FP + 8 * j8;
        *(LAS f32x4*)gm = (f32x4){wv[0], wv[1], wv[2], wv[3]}; *(LAS f32x4*)(gm + 4) = (f32x4){wv[4], wv[5], wv[6], wv[7]};
        *(v4u*)((bf16*)(F.ws + WS_G1G) + (size_t)u * UE + t * 64 + 8 * j8) = pk8(g1); *(v4u*)((bf16*)(F.ws + WS_G2G) + (size_t)u * UE + t * 64 + 8 * j8) = pk8(g2);
    }
    LBAR();
    if (dgo) { decs_load(F, DB, D, dc0 + 1, wave, lane); decs_use(DA, D, lane); decs_load(F, DA, D, dc0 + 2, wave, lane); }
    if (uprev >= 0 && tid == 0) __hip_atomic_store(F.ctl + CW_FLAG + 16 * uprev, 1u, __ATOMIC_RELAXED, __HIP_MEMORY_SCOPE_AGENT);
    {
        const int n = tid & 63, seg = tid >> 6; LAS float* G = (LAS float*)(L + RA_GAM); LAS float* SG = (LAS float*)(L + RA_SEG);
        float p = 1.0f, loc[8];
#pragma unroll
        for (int i = 0; i < 8; ++i) { p *= G[(8 * seg + i) * FP + n]; loc[i] = p; }
        SG[seg * 64 + n] = p;
        LBAR();
        float pre = 1.0f;
        for (int s = 0; s < seg; ++s) pre *= SG[s * 64 + n];
#pragma unroll
        for (int i = 0; i < 8; ++i) G[(8 * seg + i) * FP + n] = loc[i] * pre;
        if (seg == 7) ((LAS float*)(L + RA_GC))[n] = loc[7] * pre;
    }
    LBAR();
    {
        const LAS float* G = (const LAS float*)(L + RA_GAM);
        const F8 gt = ld8l(G + t * FP + 8 * j8), gc = ld8l((const LAS float*)(L + RA_GC) + 8 * j8);
        F8 gp; if (t > 0) gp = ld8l(G + (t - 1) * FP + 8 * j8); else { gp.a = (f32x4){1.f, 1.f, 1.f, 1.f}; gp.b = gp.a; }
        float xkk[8], xbb[8], xkt[8], xrt[8], xke[8], xbe[8];
#pragma unroll
        for (int e = 0; e < 8; ++e) { const float g = f8g(gt, e), rg = __builtin_amdgcn_rcpf(g), ce = f8g(gc, e) * rg;
            xkk[e] = vkk[e] * f8g(gp, e); xbb[e] = vb[e] * rg; xkt[e] = vk2[e] * rg; xrt[e] = vr[e] * g; xke[e] = vk2[e] * ce; xbe[e] = vb[e] * ce; }
        const int o = (t * TPB + 8 * j8) * 2;
        *(LAS v4u*)(L + RA_KK + o) = pk8(xkk); *(LAS v4u*)(L + RA_BB + o) = pk8(xbb); *(LAS v4u*)(L + RA_KT + o) = pk8(xkt); *(LAS v4u*)(L + RA_RT + o) = pk8(xrt);
        *(LAS v4u*)(L + RA_AB + o) = pk8(xke); *(LAS v4u*)(L + RA_BM + o) = pk8(xbe); *(LAS v4u*)(L + RA_ARK + o) = pk8(vv);
    }
    LBAR();
    if (un < NUNIT) ra_prefetch(F, un, Pn);
    {
        const int n = tid & 63, t8 = tid >> 6;
#pragma unroll
        for (int q = 0; q < 3; ++q) { const LAS unsigned short* src = (const LAS unsigned short*)(L + (q == 0 ? RA_AB : q == 1 ? RA_BM : RA_ARK)) + (8 * t8) * TPB + n;
            v4u w; w.x = (unsigned)src[0] | ((unsigned)src[TPB] << 16); w.y = (unsigned)src[2 * TPB] | ((unsigned)src[3 * TPB] << 16); w.z = (unsigned)src[4 * TPB] | ((unsigned)src[5 * TPB] << 16); w.w = (unsigned)src[6 * TPB] | ((unsigned)src[7 * TPB] << 16);
            *(LAS v4u*)(L + (q == 0 ? RA_KET : q == 1 ? RA_BET : RA_VMT) + (n * TPB + 8 * t8) * 2) = w; }
    }
    LBAR();
#pragma unroll
    for (int q = 0; q < 2; ++q) { const int c0 = cb + 16 * q, tt = r0 + l15, i0 = c0 + 4 * kg; const f32x4 z = {0.f, 0.f, 0.f, 0.f};
        f32x4 a = prod_ll(L + RA_KK, L + RA_BB, r0, c0, l15, kg, z), bm = prod_ll(L + RA_KK, L + RA_KT, r0, c0, l15, kg, z),
              rk = prod_ll(L + RA_RT, L + RA_KT, r0, c0, l15, kg, z), rb = prod_ll(L + RA_RT, L + RA_BB, r0, c0, l15, kg, z);
#pragma unroll
        for (int e = 0; e < 4; ++e) { const bool st = (i0 + e) < tt, le = (i0 + e) <= tt; a[e] = st ? a[e] : 0.f; bm[e] = st ? bm[e] : 0.f; rk[e] = le ? rk[e] : 0.f; rb[e] = le ? rb[e] : 0.f; }
        const int o = (tt * TPB + i0) * 2;
        *(LAS v2u*)(L + RA_AB + o) = pk4(a); *(LAS v2u*)(L + RA_BM + o) = pk4(bm); *(LAS v2u*)(L + RA_ARK + o) = pk4(rk); *(LAS v2u*)(L + RA_ARB + o) = pk4(rb);
        if (c0 == r0) *(LAS f32x4*)(L + RA_DIAG + (((r0 >> 4) * 16 + l15) * 16 + 4 * kg) * 4) = a;
    }
    for (int i = tid; i < 128 * TPB * 2 / 16; i += NTHR) *(LAS v4u*)(L + RA_XT + i * 16) = (v4u){0u, 0u, 0u, 0u};
    if (dgo) { decs_use(DB, D, lane); decs_load(F, DB, D, dc0 + 3, wave, lane); }
    LBAR();
#pragma unroll
    for (int q = 0; q < 2; ++q) { const int c0 = cb + 16 * q; const f32x4 bv = prod_ll(L + RA_BM, L + RA_VMT, r0, c0, l15, kg, (f32x4){0.f, 0.f, 0.f, 0.f});
        *(LAS f32x4*)(L + RA_BVF + ((r0 + l15) * FP + c0 + 4 * kg) * 4) = bv; }
    LBAR();
    if (wave < 4 && lane < 16) { const LAS float* Dg = (const LAS float*)(L + RA_DIAG) + wave * 256; float x[16];
#pragma unroll
        for (int i = 0; i < 16; ++i) { float s = (i == lane) ? 1.0f : 0.0f;
#pragma unroll
            for (int jj = 0; jj < i; ++jj) s -= Dg[i * 16 + jj] * x[jj];
            x[i] = s; }
#pragma unroll
        for (int i = 0; i < 16; ++i) { LAS unsigned short* tp = (LAS unsigned short*)(L + RA_BM) + (wave * 16 + i) * 32; tp[lane] = (unsigned short)f2bf(x[i]); tp[16 + lane] = 0; } }
    for (int i = tid; i < 128 * 32 * 2 / 16; i += NTHR) *(LAS v4u*)(L + RA_ZS + i * 16) = (v4u){0u, 0u, 0u, 0u};
    if (dgo) { decs_use(DA, D, lane); if (dc0 + 4 < DLIM) decs_load(F, DA, D, dc0 + 4, wave, lane); }
    LBAR();
    for (int p = 0; p < 4; ++p) {
        const int c0 = 16 * wave, tt = 16 * p + l15, cc = c0 + 4 * kg; f32x4 acc = {0.f, 0.f, 0.f, 0.f};
        if (p >= 1) MMA16(acc, FRAG_L(L + RA_XT, TPB, c0 + l15, 8 * kg), FRAG_L(L + RA_AB, TPB, tt, 8 * kg));
        if (p == 3) MMA16(acc, FRAG_L(L + RA_XT, TPB, c0 + l15, 32 + 8 * kg), FRAG_L(L + RA_AB, TPB, tt, 32 + 8 * kg));
        f32x4 rhs; if (wave < 4) rhs = unpk4(*(const LAS v2u*)(L + RA_KK + (tt * TPB + cc) * 2)); else rhs = *(const LAS f32x4*)(L + RA_BVF + (tt * FP + cc - 64) * 4);
        const f32x4 zv = rhs - acc; LAS unsigned short* ZT = (LAS unsigned short*)(L + RA_ZS);
#pragma unroll
        for (int e = 0; e < 4; ++e) ZT[(cc + e) * 32 + l15] = (unsigned short)f2bf(zv[e]);
        asm volatile("s_waitcnt lgkmcnt(0)" ::: "memory");
        f32x4 xa = {0.f, 0.f, 0.f, 0.f};
        MMA16(xa, FRAG_L(L + RA_ZS, 32, c0 + l15, 8 * kg), FRAG_L(L + RA_BM, 32, 16 * p + l15, 8 * kg));
        LAS unsigned short* XTs = (LAS unsigned short*)(L + RA_XT);
#pragma unroll
        for (int e = 0; e < 4; ++e) XTs[(cc + e) * TPB + 16 * p + l15] = (unsigned short)f2bf(xa[e]);
        asm volatile("s_waitcnt lgkmcnt(0)" ::: "memory");
    }
    if (dgo) { decs_use(DB, D, lane); D.c = dc0 + 4; }
    LBAR();
    {
        bf16* W2g = (bf16*)(F.ws + WS_W2G) + (size_t)u * UE; bf16* YLg = (bf16*)(F.ws + WS_YLG) + (size_t)u * UE; float* SLg = (float*)(F.ws + WS_SLG) + (size_t)u * UE;
        bf16* MTh = (bf16*)(F.ws + WS_MTH) + (size_t)u * UE; bf16* MTl = (bf16*)(F.ws + WS_MTL) + (size_t)u * UE;
        const LAS unsigned char* W1T = L + RA_XT; const LAS unsigned char* ULT = L + RA_XT + 64 * TPB * 2;
#pragma unroll
        for (int q = 0; q < 2; ++q) { const int c0 = cb + 16 * q, rr = r0 + l15, cc = c0 + 4 * kg; const f32x4 z = {0.f, 0.f, 0.f, 0.f};
            const f32x4 aw = prod_ll(L + RA_ARB, W1T, r0, c0, l15, kg, z);
            const f32x4 w2 = unpk4(*(const LAS v2u*)(L + RA_RT + (rr * TPB + cc) * 2)) - aw;
            *(v2u*)(W2g + rr * 64 + cc) = pk4(w2);
            const f32x4 yl = prod_ll(L + RA_ARK, L + RA_VMT, r0, c0, l15, kg, z) - prod_ll(L + RA_ARB, ULT, r0, c0, l15, kg, z);
            *(v2u*)(YLg + ((wave * 2 + q) * 64 + lane) * 4) = pk4(yl);
            f32x4 mt = prod_ll(L + RA_BET, W1T, r0, c0, l15, kg, z); const float gcv = ((const LAS float*)(L + RA_GC))[rr];
#pragma unroll
            for (int e = 0; e < 4; ++e) mt[e] = ((cc + e) == rr ? gcv : 0.f) - mt[e];
            const v2u mh = pk4(mt); const f32x4 mres = mt - unpk4(mh);
            { const v2u ml = pk4(mres);
              __hip_atomic_store((unsigned long long*)(MTh + rr * 64 + cc), (unsigned long long)mh.x | ((unsigned long long)mh.y << 32), __ATOMIC_RELAXED, __HIP_MEMORY_SCOPE_AGENT);
              __hip_atomic_store((unsigned long long*)(MTl + rr * 64 + cc), (unsigned long long)ml.x | ((unsigned long long)ml.y << 32), __ATOMIC_RELAXED, __HIP_MEMORY_SCOPE_AGENT); }
            const f32x4 sl = prod_ll(L + RA_VMT, L + RA_KET, r0, c0, l15, kg, z) - prod_ll(ULT, L + RA_BET, r0, c0, l15, kg, z);
            { unsigned long long* sp_ = (unsigned long long*)(SLg + ((wave * 2 + q) * 64 + lane) * 4);
              __hip_atomic_store(sp_, (unsigned long long)__float_as_uint(sl[0]) | ((unsigned long long)__float_as_uint(sl[1]) << 32), __ATOMIC_RELAXED, __HIP_MEMORY_SCOPE_AGENT);
              __hip_atomic_store(sp_ + 1, (unsigned long long)__float_as_uint(sl[2]) | ((unsigned long long)__float_as_uint(sl[3]) << 32), __ATOMIC_RELAXED, __HIP_MEMORY_SCOPE_AGENT); } }
    }
}

constexpr int RB_DEPTH = 4, RB_MT0 = 36864, RB_MTS = 18432;
struct RbSet { v4u mh, ml; f32x4 sl[2]; };
__device__ __forceinline__ void rwkv_chain(Frame& F, int bh) {
    const int tid = tid_fresh(), lane = tid & 63, wave = __builtin_amdgcn_readfirstlane(tid >> 6), l15 = lane & 15, kg = lane >> 4;
    const int r0 = 16 * (wave >> 1), cb = 32 * (wave & 1);
    const int mrow = 8 * wave + (lane >> 3), mpc = lane & 7;
    LAS unsigned char* L = F.lds + RING_OFF;
    bf16* S0g = (bf16*)(F.ws + WS_S0G);
    const bf16* MTh = (const bf16*)(F.ws + WS_MTH); const bf16* MTl = (const bf16*)(F.ws + WS_MTL); const float* SLg = (const float*)(F.ws + WS_SLG);
    __syncthreads();
    for (int i = tid; i < 4 * 9216 / 16; i += NTHR) *(LAS v4u*)(L + i * 16) = (v4u){0u, 0u, 0u, 0u};
    for (int i = tid; i < 4096 / 8; i += NTHR) *(v4u*)(S0g + (size_t)(bh * NCH) * UE + i * 8) = (v4u){0u, 0u, 0u, 0u};
    RbSet R[RB_DEPTH];
#define RB_WAITN(first, n) do { const int cc_ = (first) + (lane & 7); gu32* fl_ = F.ctl + CW_FLAG + 16 * (bh * NCH + (cc_ < NCH ? cc_ : NCH - 1)); unsigned sp_ = 0u; \
        for (;;) { const unsigned v_ = ((lane & 7) < (n) && cc_ < NCH) ? __hip_atomic_load(fl_, __ATOMIC_RELAXED, __HIP_MEMORY_SCOPE_AGENT) : 1u; if (__all(v_ != 0u)) break; __builtin_amdgcn_s_sleep(2); if (++sp_ > (1u << 20)) break; } \
        __builtin_amdgcn_fence(__ATOMIC_ACQUIRE, "agent"); } while (0)
#define RB_LOAD(S, uu) do { S.mh = *(const v4u*)(MTh + (size_t)(uu) * UE + mrow * 64 + mpc * 8); S.ml = *(const v4u*)(MTl + (size_t)(uu) * UE + mrow * 64 + mpc * 8); \
        _Pragma("unroll") for (int q = 0; q < 2; ++q) S.sl[q] = *(const f32x4*)(SLg + (size_t)(uu) * UE + ((wave * 2 + q) * 64 + lane) * 4); } while (0)
#define RB_PUT(S, slot) do { LAS unsigned char* d_ = L + RB_MT0 + (slot) * RB_MTS + (mrow * TPB + mpc * 8) * 2; *(LAS v4u*)d_ = S.mh; *(LAS v4u*)(d_ + 9216) = S.ml; } while (0)
    RB_WAITN(0, RB_DEPTH);
#pragma unroll
    for (int d = 0; d < RB_DEPTH; ++d) RB_LOAD(R[d], bh * NCH + d);
    RB_PUT(R[0], 0);
    __syncthreads();
#define RB_STEP(S, SN, c) do { const int u = bh * NCH + (c), cur = (c) & 1, nxt = cur ^ 1; \
        const LAS unsigned char* SH = L + cur * 18432; const LAS unsigned char* SL = SH + 9216; const LAS unsigned char* MH = L + RB_MT0 + cur * RB_MTS; const LAS unsigned char* ML = MH + 9216; f32x4 acc[2]; \
        _Pragma("unroll") for (int q = 0; q < 2; ++q) { const int c0 = cb + 16 * q; acc[q] = S.sl[q]; \
            _Pragma("unroll") for (int kk = 0; kk < 2; ++kk) { const bf16x8 bh_ = FRAG_L(SH, TPB, r0 + l15, 32 * kk + 8 * kg), bl_ = FRAG_L(SL, TPB, r0 + l15, 32 * kk + 8 * kg); \
                const bf16x8 ah_ = FRAG_L(MH, TPB, c0 + l15, 32 * kk + 8 * kg), al_ = FRAG_L(ML, TPB, c0 + l15, 32 * kk + 8 * kg); \
                MMA16(acc[q], al_, bh_); MMA16(acc[q], ah_, bl_); MMA16(acc[q], ah_, bh_); } } \
        if ((c) + 1 < NCH) RB_PUT(SN, nxt);                         \
        if ((c) + RB_DEPTH < NCH) RB_LOAD(S, u + RB_DEPTH); \
        _Pragma("unroll") for (int q = 0; q < 2; ++q) { const int rr = r0 + l15, cc = cb + 16 * q + 4 * kg; \
            const v2u hi = pk4(acc[q]); const f32x4 res = acc[q] - unpk4(hi); \
            *(LAS v2u*)(L + nxt * 18432 + (rr * TPB + cc) * 2) = hi; *(LAS v2u*)(L + nxt * 18432 + 9216 + (rr * TPB + cc) * 2) = pk4(res); \
            if ((c) + 1 < NCH) *(v2u*)(S0g + (size_t)(u + 1) * UE + rr * 64 + cc) = hi; \
            else *(f32x4*)(F.out + O_WKVP + ((size_t)(bh * 64 + rr) * 64 + cc)) = acc[q]; } \
        asm volatile("s_waitcnt lgkmcnt(0)\n\ts_barrier" ::: "memory"); } while (0)
    int c = 0;
    for (; c + RB_DEPTH <= NCH; c += RB_DEPTH) { if ((c & 7) == 0) RB_WAITN(c + RB_DEPTH, 8);
        RB_STEP(R[0], R[1], c); RB_STEP(R[1], R[2], c + 1); RB_STEP(R[2], R[3], c + 2); RB_STEP(R[3], R[0], c + 3); }
    if (c < NCH) { RB_STEP(R[0], R[1], c); ++c; }
    if (c < NCH) { RB_STEP(R[1], R[2], c); ++c; }
    if (c < NCH) { RB_STEP(R[2], R[3], c); ++c; }
    asm volatile("s_waitcnt vmcnt(0)" ::: "memory");
    __syncthreads();
#undef RB_LOAD
#undef RB_PUT
#undef RB_WAITN
#undef RB_STEP
}

struct RcPre { bf16x8 s0[2][2], w2[2]; v2u yl[2]; v4u g1, g2; };
__device__ __forceinline__ void rc_prefetch(Frame& F, int u, RcPre& P) {
    const int tid = tid_fresh(), lane = tid & 63, wave = __builtin_amdgcn_readfirstlane(tid >> 6), l15 = lane & 15, kg = lane >> 4;
    const int r0 = 16 * (wave >> 1), cb = 32 * (wave & 1), t = tid >> 3, j8 = tid & 7;
    const bf16* W2g = (const bf16*)(F.ws + WS_W2G) + (size_t)u * UE; const bf16* S0g = (const bf16*)(F.ws + WS_S0G) + (size_t)u * UE; const bf16* YLg = (const bf16*)(F.ws + WS_YLG) + (size_t)u * UE;
#pragma unroll
    for (int kk = 0; kk < 2; ++kk) { P.w2[kk] = FRAG_G(W2g, 64, r0 + l15, 32 * kk + 8 * kg);
#pragma unroll
        for (int q = 0; q < 2; ++q) P.s0[q][kk] = FRAG_G(S0g, 64, cb + 16 * q + l15, 32 * kk + 8 * kg); }
#pragma unroll
    for (int q = 0; q < 2; ++q) P.yl[q] = *(const v2u*)(YLg + ((wave * 2 + q) * 64 + lane) * 4);
    P.g1 = *(const v4u*)((const bf16*)(F.ws + WS_G1G) + (size_t)u * UE + t * 64 + 8 * j8); P.g2 = *(const v4u*)((const bf16*)(F.ws + WS_G2G) + (size_t)u * UE + t * 64 + 8 * j8);
}
__device__ __forceinline__ void rwkv_fix_unit(Frame& F, int u, const RcPre& P, int un, RcPre& Pn) {
    const int tid = tid_fresh(), lane = tid & 63, wave = __builtin_amdgcn_readfirstlane(tid >> 6), l15 = lane & 15, kg = lane >> 4;
    const int bh = u / NCH, c = u - bh * NCH, b = bh >> 3, h = bh & 7;
    const int r0 = 16 * (wave >> 1), cb = 32 * (wave & 1);
    LAS unsigned char* L = F.lds + RING_OFF;
    LBAR();
#pragma unroll
    for (int q = 0; q < 2; ++q) { const int c0 = cb + 16 * q; f32x4 acc = unpk4(P.yl[q]);
#pragma unroll
        for (int kk = 0; kk < 2; ++kk) MMA16(acc, P.s0[q][kk], P.w2[kk]);
        *(LAS f32x4*)(L + ((r0 + l15) * FP + c0 + 4 * kg) * 4) = acc; }
    const F8 g1 = unb(P.g1), g2 = unb(P.g2);
    if (un < NUNIT) rc_prefetch(F, un, Pn);
    LBAR();
    const int t = tid >> 3, j8 = tid & 7, row = chunk_row(b, c, t);
    const F8 y = ld8l((const LAS float*)L + t * FP + 8 * j8);
    float s = 0.f;
#pragma unroll
    for (int e = 0; e < 8; ++e) s += f8g(y, e);
    s += __shfl_xor(s, 1); s += __shfl_xor(s, 2); s += __shfl_xor(s, 4);
    const float mu = s * (1.f / 64.f); float q2 = 0.f;
#pragma unroll
    for (int e = 0; e < 8; ++e) { const float d = f8g(y, e) - mu; q2 += d * d; }
    q2 += __shfl_xor(q2, 1); q2 += __shfl_xor(q2, 2); q2 += __shfl_xor(q2, 4);
    const float rstd = 1.0f / sqrtf(q2 * (1.f / 64.f) + GN_EPS);
    float o[8];
#pragma unroll
    for (int e = 0; e < 8; ++e) o[e] = (f8g(y, e) - mu) * rstd * f8g(g1, e) + f8g(g2, e);
    if (row >= 0) *(v4u*)((bf16*)(F.ws + WS_OC) + (size_t)row * 1024 + h * 64 + 8 * j8) = pk8(o);
}


template <class Epi> __device__ __forceinline__ void skinny_gemm(Frame& F, const bf16* A, int lda, const bf16* Bt, int ldb, int K, int cbk, const Epi& epi) {
    const int tid = tid_fresh(), lane = tid & 63, wave = __builtin_amdgcn_readfirstlane(tid >> 6), l15 = lane & 15, kg = lane >> 4;
    LAS unsigned char* L = F.lds + RING_OFF;
    const bf16* Ar = A + (size_t)(ROW_META + l15) * lda + 8 * kg; const bf16* Br = Bt + (size_t)(16 * cbk + l15) * ldb + 8 * kg;
    const int kw = K >> 3, kbeg = wave * kw;
    f32x4 acc[3] = {{0.f, 0.f, 0.f, 0.f}, {0.f, 0.f, 0.f, 0.f}, {0.f, 0.f, 0.f, 0.f}};
#pragma unroll 8
    for (int k0 = kbeg; k0 < kbeg + kw; k0 += 32) {
        const bf16x8 wf = *(const bf16x8*)(Br + k0);
#pragma unroll
        for (int mt = 0; mt < 3; ++mt) { const bf16x8 af = *(const bf16x8*)(Ar + (size_t)(16 * mt) * lda + k0); MMA16(acc[mt], wf, af); }
    }
    __syncthreads();
#pragma unroll
    for (int mt = 0; mt < 3; ++mt) *(LAS f32x4*)(L + ((wave * 3 + mt) * 64 + lane) * 16) = acc[mt];
    __syncthreads();
    if (tid < 192) { const int mt = tid >> 6, ln = tid & 63; f32x4 s = {0.f, 0.f, 0.f, 0.f};
#pragma unroll
        for (int w = 0; w < 8; ++w) s += *(const LAS f32x4*)(L + ((w * 3 + mt) * 64 + ln) * 16);
        epi(16 * mt + (ln & 15), 16 * cbk + 4 * (ln >> 4), s); }
    __syncthreads();
}
struct SkBrA { bf16* TMP; const bf16* GB; __device__ __forceinline__ void operator()(int r, int c, f32x4 v) const { const size_t row = ROW_META + r; const v2u g = *(const v2u*)(GB + row * DG + c);
    v2u w; w.x = pk2(v[0] * bflo(g.x), v[1] * bfhi(g.x)); w.y = pk2(v[2] * bflo(g.y), v[3] * bfhi(g.y)); *(v2u*)(TMP + row * 1024 + c) = w; } };
struct SkBrB { const bf16* TMP; const bf16* GB; bf16* MG; __device__ __forceinline__ void operator()(int r, int c, f32x4 v) const { const size_t row = ROW_META + r; const v2u g = *(const v2u*)(GB + row * DG + 1024 + c);
    const f32x4 t = unpk4(*(const v2u*)(TMP + row * 1024 + c)); v2u w; w.x = pk2(t[0] + v[0] * bflo(g.x), t[1] + v[1] * bfhi(g.x)); w.y = pk2(t[2] + v[2] * bflo(g.y), t[3] + v[3] * bfhi(g.y)); *(v2u*)(MG + row * 1024 + c) = w; } };
struct SkOut { bf16* XB; float* SS48; const float* xm; const float* xs; int cbk; __device__ __forceinline__ void operator()(int r, int c, f32x4 v) const { const size_t row = ROW_META + r;
    const float* x = r < NMETA ? xm + (size_t)r * 1024 : xs + (size_t)(r - NMETA) * 1024; v += *(const f32x4*)(x + c);
    float ssq = (v[0] * v[0] + v[1] * v[1]) + (v[2] * v[2] + v[3] * v[3]); ssq += __shfl_xor(ssq, 16); ssq += __shfl_xor(ssq, 32);
    if ((c & 15) == 0) SS48[r * 64 + cbk] = ssq;
    v2u w; w.x = pk2(v[0], v[1]); w.y = pk2(v[2], v[3]); *(v2u*)(XB + row * 1024 + c) = w; } };
struct SkUp { bf16* HF; const float* SS48; __device__ __forceinline__ void operator()(int r, int c, f32x4 v) const { const size_t row = ROW_META + r;
    const f32x4* sp = (const f32x4*)(SS48 + r * 64); f32x4 s4 = sp[0];
#pragma unroll
    for (int i = 1; i < 16; ++i) s4 += sp[i];
    const float rstd = __builtin_amdgcn_rsqf(((s4[0] + s4[1]) + (s4[2] + s4[3])) * (1.f / 1024.f) + RMS_EPS);
    v = __builtin_elementwise_max(v * rstd, (f32x4){0.f, 0.f, 0.f, 0.f}); v = v * v;
    v2u w; w.x = pk2(v[0], v[1]); w.y = pk2(v[2], v[3]); *(v2u*)(HF + row * FF + c) = w; } };
struct SkDown { bf16* XB; __device__ __forceinline__ void operator()(int r, int c, f32x4 v) const { const size_t row = ROW_META + r; v += unpk4(*(const v2u*)(XB + row * 1024 + c));
    v2u w; w.x = pk2(v[0], v[1]); w.y = pk2(v[2], v[3]); *(v2u*)(XB + row * 1024 + c) = w; } };

__global__ void __launch_bounds__(NTHR, 2) fwd_kernel(Args args) {
    extern __shared__ __attribute__((aligned(16))) unsigned char lds[];
    Frame F;
    F.lds = (LAS unsigned char*)lds;
    F.MISC = (volatile LAS unsigned*)(F.lds + MISC_OFF);
    F.G = gridDim.x; { const int bx = blockIdx.x; F.vcu = (F.G % 8 == 0) ? (bx % 8) * (F.G / 8) + bx / 8 : bx; }
    F.ws = args.ws; F.out = args.out; F.ctl = (gu32*)(args.ws + WS_CTL);
#pragma unroll
    for (int i = 0; i < 30; ++i) F.in[i] = args.in[i];
    for (int u = threadIdx.x; u < (LDS_BYTES - LDSCTL_OFF) / 4; u += NTHR) ((LAS unsigned*)(F.lds + LDSCTL_OFF))[u] = 0u;
    __syncthreads();
    XcdBarrier bar = xcd_barrier_post((unsigned*)(F.ctl + CW_BAR), F.MISC + 8);
    unsigned char* ws = args.ws;
    using namespace pg8;

    p0_prologue(F);
    xcd_barrier(bar);

    if ((int)blockIdx.x >= (int)gridDim.x - 16) p1_cumsum(F, (int)blockIdx.x - ((int)gridDim.x - 16));
    {
        Gemm g{(const bf16_t*)(ws + WS_HN), (const bf16_t*)(ws + WS_WIN), M_PAD, N1, 1024, 1024}; StaticOrder S; S.init(M_PAD, N1, F.G, (int)blockIdx.x);
        EpiIn E{(bf16_t*)(ws + WS_UR), (bf16_t*)(ws + WS_QB), (bf16_t*)(ws + WS_KB), (bf16_t*)(ws + WS_VB), (bf16_t*)(ws + WS_GB), (float*)(ws + WS_QS), F.out};
        gemm_phase<EpiIn, StaticOrder, PG8_ALIGN, PG8_SP2>(F.lds + RING_OFF, g, S, E);
    }
    xcd_barrier(bar);

    {
        const int rank = F.vcu, NW_ = F.G;
#define RA_UNIT(i) (((i) & 15) * NCH + ((i) >> 4))
        RaPre PA, PB; int it = rank;
        DecCtx D; DecS DA;
        const int dlane = (int)threadIdx.x & 63, dwave = __builtin_amdgcn_readfirstlane((int)threadIdx.x >> 6); const bool ditem = F.vcu < NSAMP * NSPLIT;
        { const int bt = ditem ? F.vcu >> 3 : 0, sp = F.vcu & 7;
          D.q4 = *(const f32x4*)((const float*)(ws + WS_QS) + (size_t)bt * 512 + dwave * 64 + 4 * (dlane & 15)) * 0.125f; D.o4 = (f32x4){0.f, 0.f, 0.f, 0.f}; D.m = -1e30f; D.l = 0.f; D.csum = 0.f;
          D.pgv = ((const int*)INP(I_PT))[bt * NPAGES + sp * 8 + (dlane & 7)]; D.c = ditem ? 0 : DLIM;
          decs_load(F, DA, D, 0, dwave, dlane); }
        if (it < NUNIT) ra_prefetch(F, RA_UNIT(it), PA);
        int ulast = -1;
        for (; it < NUNIT; it += 2 * NW_) { rwkv_chunk_unit(F, RA_UNIT(it), PA, it + NW_ < NUNIT ? RA_UNIT(it + NW_) : NUNIT, PB, ulast, D, DA); ulast = RA_UNIT(it);
            if (it + NW_ < NUNIT) { rwkv_chunk_unit(F, RA_UNIT(it + NW_), PB, it + 2 * NW_ < NUNIT ? RA_UNIT(it + 2 * NW_) : NUNIT, PA, ulast, D, DA); ulast = RA_UNIT(it + NW_); } }
#undef RA_UNIT
        {
            while (D.c < DLIM) { decs_use(DA, D, dlane); if (D.c + 1 < DLIM) decs_load(F, DA, D, D.c + 1, dwave, dlane); D.c += 1; }
            if (ditem) { float* PART = (float*)(ws + WS_PART) + (size_t)(F.vcu * NH + dwave) * PART_STRIDE; f32x4 o4 = D.o4;
#pragma unroll
                for (int e = 0; e < 4; ++e) { float t = o4[e]; t += __shfl_xor(t, 16); t += __shfl_xor(t, 32); o4[e] = t; }
                if ((dlane >> 4) == 0) *(f32x4*)(PART + 16 + 4 * (dlane & 15)) = o4;
                if (dlane == 0) { PART[0] = D.m; PART[1] = D.l; PART[2] = D.csum; } }
        }
        asm volatile("s_waitcnt vmcnt(0)" ::: "memory"); __syncthreads();
        if (ulast >= 0 && threadIdx.x == 0) __hip_atomic_store(F.ctl + CW_FLAG + 16 * ulast, 1u, __ATOMIC_RELAXED, __HIP_MEMORY_SCOPE_AGENT);
        if (F.vcu == 1 || F.vcu == 2) { __syncthreads(); p2_prep(F, ROW_SAMP / 16 + F.vcu - 1); }
        if ((F.vcu & 15) == 0) { __syncthreads(); rwkv_chain(F, F.vcu >> 4); }
    }
    __syncthreads();
    if (F.vcu == F.G - 1) p2_meta_attn(F);
    __syncthreads();
    {
        const attn_body::bf16* Qp = (const attn_body::bf16*)(ws + WS_QB); const attn_body::bf16* Kp = (const attn_body::bf16*)(ws + WS_KB); const attn_body::bf16* Vp = (const attn_body::bf16*)(ws + WS_VB);
        attn_body::bf16* Op = (attn_body::bf16*)(ws + WS_OC); const float* NCLp = (const float*)(ws + WS_NCL);
        const int x0 = (int)(xb_xcc_id() & 7u);
        if (threadIdx.x == 0) F.MISC[1] = 0u;
        for (int kx = 0; kx < 8; ++kx) { const int x = (x0 + kx) & 7;
        if (kx == 1) {
            if (threadIdx.x < 8) { const unsigned hq = __hip_atomic_load(F.ctl + CW_QUEUE + 64 * (int)threadIdx.x, __ATOMIC_RELAXED, __HIP_MEMORY_SCOPE_AGENT);
                const unsigned long long bm = __ballot(hq >= 96u); if (threadIdx.x == 0) F.MISC[1] = (unsigned)(bm & 0xffull); }
        }
        __syncthreads();
        if (__builtin_amdgcn_readfirstlane((int)((F.MISC[1] >> x) & 1u))) { __syncthreads(); continue; }
        for (;;) {
            if (threadIdx.x == 0) F.MISC[0] = __hip_atomic_fetch_add(F.ctl + CW_QUEUE + 64 * x, 1u, __ATOMIC_RELAXED, __HIP_MEMORY_SCOPE_AGENT);
            __syncthreads();
            const int item = __builtin_amdgcn_readfirstlane((int)F.MISC[0]);
            __syncthreads();
            if (item >= 96) break;
            int ai; bool dec;
            if (item < 64) { dec = (item & 1) == 0; ai = item >> 1; } else { dec = false; ai = item - 32; }
            if (dec) { if (32 * x + ai >= F.G) p2_decode_split(F, 32 * x + ai, 0); p2_decode_split(F, 32 * x + ai, 1); }
            else { const int qb = 31 - (ai >> 1), bhh = 2 * x + (ai & 1);
                attn_body::attn_unit<8>(bhh >> 3, bhh & 7, qb, Qp, Kp, Vp, Op, NCLp + (size_t)bhh * attn_body::BIASN, (char*)lds + RING_OFF); }
        } }
    }
    xcd_barrier(bar);

    if (F.vcu >= NSAMP) {
        RcPre QA, QB, QC; const int NR_ = F.G - NSAMP; int u = F.vcu - NSAMP;
        if (u < NUNIT) rc_prefetch(F, u, QA);
        if (u + NR_ < NUNIT) rc_prefetch(F, u + NR_, QB);
        for (; u < NUNIT; u += 3 * NR_) { rwkv_fix_unit(F, u, QA, u + 2 * NR_, QC);
            if (u + NR_ < NUNIT) rwkv_fix_unit(F, u + NR_, QB, u + 3 * NR_, QA);
            if (u + 2 * NR_ < NUNIT) rwkv_fix_unit(F, u + 2 * NR_, QC, u + 4 * NR_, QB); }
        asm volatile("s_waitcnt vmcnt(0)" ::: "memory"); __syncthreads();
    }
    if (F.vcu < NSAMP) {
        for (int hh = 0; hh < NH; ++hh) p2_scan_sample(F, F.vcu * NH + hh);
        asm volatile("s_waitcnt vmcnt(0)" ::: "memory"); __syncthreads();
        p2_post(F); p2_decode_combine(F, F.vcu); }
    xcd_barrier(bar);

    {
    if (F.vcu < 64) {
        skinny_gemm(F, (const bf16*)(ws + WS_OC), 1024, (const bf16*)(ws + WS_WBR), 1024, 512, F.vcu, SkBrA{(bf16*)(ws + WS_TMP), (const bf16*)(ws + WS_GB)});
        skinny_gemm(F, (const bf16*)(ws + WS_OC) + 512, 1024, (const bf16*)(ws + WS_WBR) + 512, 1024, 512, F.vcu, SkBrB{(const bf16*)(ws + WS_TMP), (const bf16*)(ws + WS_GB), (bf16*)(ws + WS_MG)});
    }
    {
        Gemm g{(const bf16_t*)(ws + WS_OC), (const bf16_t*)(ws + WS_WBR), M_REAL, 1024, 512, 1024}; StaticOrder S; S.init(M_REAL, 1024, F.G, (int)blockIdx.x);
        EpiBrA E{(bf16_t*)(ws + WS_TMP), (const bf16_t*)(ws + WS_GB)};
        gemm_phase<EpiBrA, StaticOrder, PG8_ALIGN, PG8_SP2>(F.lds + RING_OFF, g, S, E);
    }
    {
        Gemm g{(const bf16_t*)(ws + WS_OC) + 512, (const bf16_t*)(ws + WS_WBR) + 512, M_REAL, 1024, 512, 1024}; StaticOrder S; S.init(M_REAL, 1024, F.G, (int)blockIdx.x);
        EpiBrB E{(const bf16_t*)(ws + WS_TMP), (const bf16_t*)(ws + WS_GB), (bf16_t*)(ws + WS_MG)};
        gemm_phase<EpiBrB, StaticOrder, PG8_ALIGN, PG8_SP2>(F.lds + RING_OFF, g, S, E);
    }
        }
    xcd_barrier(bar);

    if (F.vcu < 64) skinny_gemm(F, (const bf16*)(ws + WS_MG), 1024, (const bf16*)(ws + WS_WOUT), 1024, 1024, F.vcu, SkOut{(bf16*)(ws + WS_X1), (float*)(ws + WS_SS48), INP(I_META), INP(I_XS), F.vcu});
    {
        Gemm g{(const bf16_t*)(ws + WS_MG), (const bf16_t*)(ws + WS_WOUT), M_REAL, 1024, 1024, 1024}; StaticOrder S; S.init(M_REAL, 1024, F.G, (int)blockIdx.x);
        EpiRes<false> E{(bf16_t*)(ws + WS_X1), (float*)(ws + WS_SS), INP(I_XP)};
        gemm_phase<EpiRes<false>, StaticOrder, PG8_ALIGN, PG8_SP2>(F.lds + RING_OFF, g, S, E);
    }
    xcd_barrier(bar);

    for (int cbk = F.vcu; cbk < FF / 16; cbk += F.G) skinny_gemm(F, (const bf16*)(ws + WS_X1), 1024, (const bf16*)(ws + WS_WUP), 1024, 1024, cbk, SkUp{(bf16*)(ws + WS_HF), (const float*)(ws + WS_SS48)});
    {
        Gemm g{(const bf16_t*)(ws + WS_X1), (const bf16_t*)(ws + WS_WUP), M_REAL, FF, 1024, 1024}; StaticOrder S; S.init(M_REAL, FF, F.G, (int)blockIdx.x);
        EpiUp E{(bf16_t*)(ws + WS_HF), (const float*)(ws + WS_SS)};
        gemm_phase<EpiUp, StaticOrder, PG8_ALIGN, PG8_SP2>(F.lds + RING_OFF, g, S, E);
    }
    xcd_barrier(bar);

    if (F.vcu < 64) skinny_gemm(F, (const bf16*)(ws + WS_HF), FF, (const bf16*)(ws + WS_WDN), FF, FF, F.vcu, SkDown{(bf16*)(ws + WS_X1)});
    {
        Gemm g{(const bf16_t*)(ws + WS_HF), (const bf16_t*)(ws + WS_WDN), M_REAL, 1024, FF, FF}; StaticOrder S; S.init(M_REAL, 1024, F.G, (int)blockIdx.x);
        EpiRes<true> E{(bf16_t*)(ws + WS_X1), nullptr, nullptr};
        gemm_phase<EpiRes<true>, StaticOrder, PG8_ALIGN, PG8_SP2>(F.lds + RING_OFF, g, S, E);
    }
    xcd_barrier(bar);

    p6_norm_final(F);
}

extern "C" void kernel_launch(void* const* d_in, const int* in_sizes, int n_in, void* d_out, int out_size, void* d_ws, size_t ws_size, hipStream_t stream) {
    static int grid = 0;
    if (grid == 0) {
        if (n_in != 30 || (size_t)out_size != O_END || ws_size < WS_END) { fprintf(stderr, "kernel_launch: unexpected sizes: n_in %d out %d ws %zu (need %zu)\n", n_in, out_size, ws_size, (size_t)WS_END); grid = -1; return; }
        int dev = 0, cus = 0, per_cu = 0;
        if (hipGetDevice(&dev) != hipSuccess || hipDeviceGetAttribute(&cus, hipDeviceAttributeMultiprocessorCount, dev) != hipSuccess) { grid = -1; return; }
        if (hipFuncSetAttribute((const void*)fwd_kernel, hipFuncAttributeMaxDynamicSharedMemorySize, LDS_BYTES) != hipSuccess) { fprintf(stderr, "kernel_launch: hipFuncSetAttribute failed\n"); grid = -1; return; }
        if (hipOccupancyMaxActiveBlocksPerMultiprocessor(&per_cu, (const void*)fwd_kernel, NTHR, LDS_BYTES) != hipSuccess || per_cu < 1) { fprintf(stderr, "kernel_launch: occupancy query says %d\n", per_cu); }
        (void)hipGetLastError();
        grid = cus;
        if (grid != 256) fprintf(stderr, "kernel_launch: grid %d (built for 256)\n", grid);
    }
    if (grid < 0) return;
    (void)in_sizes;
    if (hipMemsetAsync((char*)d_ws + WS_CTL, 0, CTL_ZERO_BYTES, stream) != hipSuccess) return;
    Args a{};
    for (int i = 0; i < 30; ++i) a.in[i] = (const float*)d_in[i];
    a.out = (float*)d_out; a.ws = (unsigned char*)d_ws;
    hipLaunchKernelGGL(fwd_kernel, dim3(grid), dim3(NTHR), LDS_BYTES, stream, a);
}
```

```cpp
#include <hip/hip_runtime.h>
#include <hip/hip_bf16.h>
#include <cstdio>
#include <cstdint>
#include <cmath>
__device__ __forceinline__ int tid_fresh() { int t = (int)threadIdx.x; asm volatile("" : "+v"(t)); return t; }
namespace pg8 {
#define PG8_LAS __attribute__((address_space(3)))
typedef unsigned short bf16_t;
typedef short bf16x8 __attribute__((ext_vector_type(8)));
typedef float f32x4 __attribute__((ext_vector_type(4)));
typedef unsigned u32x4 __attribute__((ext_vector_type(4)));
constexpr int BM = 256, BK = 64, HALF = 128, HTB = HALF * BK * 2  , STAGE_BYTES = 8 * HTB, NXCD = 8, WGM = 8;

__host__ __device__ __forceinline__ int lds_byte(int r, int c) { const int st = (r >> 4) * 2 + (c >> 5), rr = r & 15, cc = c & 31, ob = rr * 64 + cc * 2; return st * 1024 + (ob ^ (((ob >> 9) & 1) << 5)); }
__host__ __device__ __forceinline__ void stage_rc(int b, int& R, int& C) { const int st = b / 1024, sb = b % 1024, swz = sb ^ (((sb >> 9) & 1) << 5); R = (st >> 1) * 16 + swz / 64; C = (st & 1) * 32 + (swz % 64) / 2; }
__host__ __device__ __forceinline__ int perm32(int rho) { const int n = rho >> 4, i = rho & 15; return 8 * (i >> 2) + 4 * n + (i & 3); }

struct Unit { int pm, pn; };
struct Gemm { const bf16_t* A; const bf16_t* Bt; int M, N, K, ld; };

struct StaticOrder {
    int nM, nN, nwg, G, c;
    __host__ __device__ void init(int M, int N, int G_, int c_) { nM = M / BM; nN = N / BM; nwg = nM * nN; G = G_; c = c_; }
    __host__ __device__ bool next(int i, Unit& u) const {
        const long L = (long)i * G + c; if (L >= nwg) return false;
        int wgid = (int)L; { const int q = nwg / NXCD, r = nwg % NXCD, xcd = wgid % NXCD, off = wgid / NXCD; wgid = (xcd < r ? xcd * (q + 1) : r * (q + 1) + (xcd - r) * q) + off; }
        const int nig = WGM * nN, gid = wgid / nig, fm = gid * WGM, gsz = (nM - fm) < WGM ? (nM - fm) : WGM;
        u.pm = fm + ((wgid % nig) % gsz); u.pn = (wgid % nig) / gsz; return true;
    }
    __device__ __forceinline__ void a_ready(const Unit&) const {}
    __device__ __forceinline__ void done(const Unit&) const {}
};

typedef float f32x2c __attribute__((ext_vector_type(2))); typedef __bf16 bf16x2c __attribute__((ext_vector_type(2)));
__device__ __forceinline__ unsigned cvt_pk_bf16(float lo, float hi) { const f32x2c v = {lo, hi}; return __builtin_bit_cast(unsigned, __builtin_convertvector(v, bf16x2c)); }
typedef float f32x2 __attribute__((ext_vector_type(2)));
template <class Epi, class Sched, bool ALIGN_EPI = false, bool SP2 = false>
__device__ __forceinline__ void gemm_phase(PG8_LAS unsigned char* lds, const Gemm g, const Sched& S, const Epi& E) {
    const int tid = tid_fresh(), wid = __builtin_amdgcn_readfirstlane(tid >> 6), lane = tid & 63, wr = wid >> 2, wc = wid & 3, fr = lane & 15, fq = lane >> 4;
    const int K = g.K, nt = K / BK, LD = g.ld;
    unsigned voffA[2], voffB[2];
#pragma unroll
    for (int i = 0; i < 2; ++i) { int R, C; stage_rc(tid * 16 + i * 8192, R, C); const int Rb = Epi::PERM ? ((R & ~31) + perm32(R & 31)) : R;
        voffA[i] = (unsigned)(R * LD + C) * 2u; voffB[i] = (unsigned)(Rb * LD + C) * 2u; }
    const size_t kstep = (size_t)(BK * 2);
    const size_t hstep = (size_t)HALF * LD * 2;
    const size_t tstep = 2 * hstep;
    const unsigned ldsw = (unsigned)wid * 1024u;
    const int aoff = lds_byte(wr * 64 + fr, fq * 8), boff = lds_byte(wc * 32 + fr, fq * 8);
#define PG8_SA(b, h) (((b) * 2 + (h)) * HTB)
#define PG8_SB(b, h) ((4 + (b) * 2 + (h)) * HTB)
#define PG8_STAGE(bufoff, gbase, voff) do { _Pragma("unroll") for (int _i = 0; _i < 2; ++_i) \
        __builtin_amdgcn_global_load_lds((const unsigned*)((const char*)(gbase) + (voff)[_i]), (PG8_LAS unsigned*)(lds + (bufoff) + ldsw + _i * 8192), 16, 0, 0); } while (0)
#define PG8_LDA(dst, b, h) do { _Pragma("unroll") for (int m = 0; m < 4; ++m) _Pragma("unroll") for (int k = 0; k < 2; ++k) dst[m][k] = *(const PG8_LAS bf16x8*)(lds + PG8_SA(b, h) + aoff + m * 2048 + k * 1024); } while (0)
#define PG8_LDB(dst, b, h) do { _Pragma("unroll") for (int n = 0; n < 2; ++n) _Pragma("unroll") for (int k = 0; k < 2; ++k) dst[n][k] = *(const PG8_LAS bf16x8*)(lds + PG8_SB(b, h) + boff + n * 2048 + k * 1024); } while (0)
#define PG8_MMA(ai, bj, At, Bt) do { __builtin_amdgcn_s_setprio(1); _Pragma("unroll") for (int m = 0; m < 4; ++m) _Pragma("unroll") for (int n = 0; n < 2; ++n) _Pragma("unroll") for (int k = 0; k < 2; ++k) \
        acc[ai][bj][m][n] = __builtin_amdgcn_mfma_f32_16x16x32_bf16(Bt[n][k], At[m][k], acc[ai][bj][m][n], 0, 0, 0); __builtin_amdgcn_s_setprio(0); } while (0)
#define PG8_WAIT_V(n) asm volatile("s_waitcnt vmcnt(" #n ")" ::: "memory")
#define PG8_WAIT_L(n) asm volatile("s_waitcnt lgkmcnt(" #n ")" ::: "memory")
#define PG8_BAR __builtin_amdgcn_s_barrier()
#define PG8_SCHED __builtin_amdgcn_sched_barrier(0)
    Unit cur, nxt; int ui = 0;
    if (!S.next(0, cur)) return;
    f32x4 acc[2][2][4][2];
#pragma unroll
    for (int a = 0; a < 2; ++a)
#pragma unroll
        for (int b = 0; b < 2; ++b)
#pragma unroll
            for (int m = 0; m < 4; ++m)
#pragma unroll
                for (int n = 0; n < 2; ++n) acc[a][b][m][n] = (f32x4){0.f, 0.f, 0.f, 0.f};
    bf16x8 At[4][2], B0[2][2], B1[2][2];
    const char* cA = (const char*)g.A + (size_t)cur.pm * tstep; const char* cB = (const char*)g.Bt + (size_t)cur.pn * tstep;
    S.a_ready(cur);
    if constexpr (SP2) {
        PG8_STAGE(PG8_SB(0, 0), cB, voffB); PG8_STAGE(PG8_SB(0, 1), cB + hstep, voffB); PG8_STAGE(PG8_SA(0, 0), cA, voffA); PG8_STAGE(PG8_SA(0, 1), cA + hstep, voffA);
        if (wr == 1) PG8_BAR;
        PG8_WAIT_V(2); PG8_BAR;
        PG8_STAGE(PG8_SB(1, 0), cB + kstep, voffB); PG8_STAGE(PG8_SA(1, 0), cA + kstep, voffA); PG8_STAGE(PG8_SB(1, 1), cB + hstep + kstep, voffB);
        PG8_WAIT_V(6); PG8_BAR;
    } else {
        PG8_STAGE(PG8_SB(0, 0), cB, voffB); PG8_STAGE(PG8_SA(0, 0), cA, voffA); PG8_STAGE(PG8_SB(0, 1), cB + hstep, voffB); PG8_STAGE(PG8_SA(0, 1), cA + hstep, voffA);
        if (wr == 1) PG8_BAR;
        PG8_WAIT_V(4); PG8_BAR;
        PG8_STAGE(PG8_SB(1, 0), cB + kstep, voffB); PG8_STAGE(PG8_SA(1, 0), cA + kstep, voffA); PG8_STAGE(PG8_SB(1, 1), cB + hstep + kstep, voffB);
        PG8_WAIT_V(6); PG8_BAR;
    }
    for (;;) {
        const bool has_next = S.next(ui + 1, nxt);
        const char* nA = has_next ? (const char*)g.A + (size_t)nxt.pm * tstep : cA; const char* nB = has_next ? (const char*)g.Bt + (size_t)nxt.pn * tstep : cB;
        for (int t = 0; t < nt; t += 2) {
            const bool last = (t == nt - 2);
            const char* a1 = cA + (size_t)(t + 1) * kstep;
            const char* a2 = last ? nA : cA + (size_t)(t + 2) * kstep; const char* b2 = last ? nB : cB + (size_t)(t + 2) * kstep;
            const char* a3 = a2 + kstep; const char* b3 = b2 + kstep;
            if (last && has_next) S.a_ready(nxt);
            if constexpr (SP2) {
            PG8_LDB(B0, 0, 0); PG8_LDB(B1, 0, 1); PG8_SCHED; PG8_LDA(At, 0, 0); PG8_STAGE(PG8_SA(1, 1), a1 + hstep, voffA);
            PG8_WAIT_V(8); PG8_WAIT_L(0); PG8_BAR; PG8_MMA(0, 0, At, B0); PG8_MMA(0, 1, At, B1); PG8_BAR; PG8_SCHED;
            PG8_LDA(At, 0, 1); PG8_STAGE(PG8_SB(0, 0), b2, voffB); PG8_STAGE(PG8_SB(0, 1), b2 + hstep, voffB); PG8_STAGE(PG8_SA(0, 0), a2, voffA);
            PG8_WAIT_V(8); PG8_WAIT_L(0); PG8_BAR; PG8_MMA(1, 0, At, B0); PG8_MMA(1, 1, At, B1); PG8_BAR; PG8_SCHED;
            PG8_LDB(B0, 1, 0); PG8_LDB(B1, 1, 1); PG8_SCHED; PG8_LDA(At, 1, 0); PG8_STAGE(PG8_SA(0, 1), a2 + hstep, voffA);
            PG8_WAIT_V(8); PG8_WAIT_L(0); PG8_BAR; PG8_MMA(0, 0, At, B0); PG8_MMA(0, 1, At, B1); PG8_BAR; PG8_SCHED;
            PG8_LDA(At, 1, 1); PG8_STAGE(PG8_SB(1, 0), b3, voffB); PG8_STAGE(PG8_SB(1, 1), b3 + hstep, voffB); PG8_STAGE(PG8_SA(1, 0), a3, voffA);
            PG8_WAIT_V(8); PG8_WAIT_L(0); PG8_BAR; PG8_MMA(1, 0, At, B0); PG8_MMA(1, 1, At, B1); PG8_BAR; PG8_SCHED;
            } else {
            PG8_LDB(B0, 0, 0); PG8_SCHED; PG8_LDA(At, 0, 0); PG8_STAGE(PG8_SA(1, 1), a1 + hstep, voffA);
            PG8_WAIT_L(8); PG8_BAR; PG8_WAIT_L(0); PG8_MMA(0, 0, At, B0); PG8_BAR; PG8_SCHED;
            PG8_LDB(B1, 0, 1); PG8_STAGE(PG8_SB(0, 0), b2, voffB);
            PG8_BAR; PG8_WAIT_L(0); PG8_MMA(0, 1, At, B1); PG8_BAR;
            PG8_LDA(At, 0, 1); PG8_STAGE(PG8_SA(0, 0), a2, voffA);
            PG8_BAR; PG8_WAIT_L(0); PG8_MMA(1, 0, At, B0); PG8_BAR; PG8_SCHED;
            PG8_STAGE(PG8_SB(0, 1), b2 + hstep, voffB);
            PG8_WAIT_V(6); PG8_BAR; PG8_MMA(1, 1, At, B1); PG8_BAR;
            PG8_LDB(B0, 1, 0); PG8_SCHED; PG8_LDA(At, 1, 0); PG8_STAGE(PG8_SA(0, 1), a2 + hstep, voffA);
            PG8_WAIT_L(8); PG8_BAR; PG8_WAIT_L(0); PG8_MMA(0, 0, At, B0); PG8_BAR; PG8_SCHED;
            PG8_LDB(B1, 1, 1); PG8_STAGE(PG8_SB(1, 0), b3, voffB);
            PG8_BAR; PG8_WAIT_L(0); PG8_MMA(0, 1, At, B1); PG8_BAR;
            PG8_LDA(At, 1, 1); PG8_STAGE(PG8_SA(1, 0), a3, voffA);
            PG8_BAR; PG8_WAIT_L(0); PG8_MMA(1, 0, At, B0); PG8_BAR; PG8_SCHED;
            PG8_STAGE(PG8_SB(1, 1), b3 + hstep, voffB);
            PG8_WAIT_V(6); PG8_BAR; PG8_MMA(1, 1, At, B1); PG8_BAR;
            }
        }
        if constexpr (ALIGN_EPI) { if (wr == 0) PG8_BAR; }
        if constexpr (!Epi::AFTER_DRAIN) { E(acc, cur, wr, wc, fr, fq); S.done(cur); }
        if (!has_next) break;
#pragma unroll
        for (int a = 0; a < 2; ++a)
#pragma unroll
            for (int b = 0; b < 2; ++b)
#pragma unroll
                for (int m = 0; m < 4; ++m)
#pragma unroll
                    for (int n = 0; n < 2; ++n) acc[a][b][m][n] = (f32x4){0.f, 0.f, 0.f, 0.f};
        cur = nxt; cA = nA; cB = nB; ++ui;
        if constexpr (ALIGN_EPI) { if (wr == 1) PG8_BAR; }
    }
    PG8_WAIT_V(0);
    if constexpr (!ALIGN_EPI) { if (wr == 0) PG8_BAR; }
    PG8_BAR;
    if constexpr (Epi::AFTER_DRAIN) { E.fused(acc, cur, wr, wc, fr, fq, lds, wid, lane); S.done(cur); }
#undef PG8_SA
#undef PG8_SB
#undef PG8_STAGE
#undef PG8_LDA
#undef PG8_LDB
#undef PG8_MMA
#undef PG8_WAIT_V
#undef PG8_WAIT_L
#undef PG8_BAR
#undef PG8_SCHED
}
}
#define PG8_SP2 true
#define PG8_ALIGN true
namespace attn_body {
using bf16=__hip_bfloat16;
using bf16x8=__attribute__((ext_vector_type(8)))short;
using s16x4=__attribute__((ext_vector_type(4)))short;
using f32x16=__attribute__((ext_vector_type(16)))float;
using u32x4=__attribute__((ext_vector_type(4)))unsigned;
using f32x4=__attribute__((ext_vector_type(4)))float;
constexpr int BATCH=2,NHEAD=8,SEQ=8192,D=64,DM=NHEAD*D,OPITCH=1024,OCOL0=512,METAROW=16384,BIASN=8320;
constexpr int NW=8,QBLK=32,QB=QBLK*NW,KVBLK=64,NQB=SEQ/QB;
constexpr int ATTN_PITCH=DM, ATTN_UNIT_ROWS=QB;
__device__ __forceinline__ int crow(int r,int hi){return (r&3)+8*(r>>2)+4*hi;}
#define SBAR() __builtin_amdgcn_sched_barrier(0)
__device__ __forceinline__ void cmask(f32x16&p0,f32x16&p1,int jb,int qrel,int hi){
  const float NEG=-INFINITY; int kb=64*jb+4*hi;
  #pragma unroll
  for(int r=0;r<16;++r){int kv=kb+(r&3)+8*(r>>2); if(kv>qrel)p0[r]=NEG; if(kv+32>qrel)p1[r]=NEG;}
}

constexpr int NSLOT=3, SLOTB=8192;
constexpr int LDS_K=0, LDS_V=NSLOT*SLOTB, LDS_WS=2*NSLOT*SLOTB, LDS_OST=LDS_WS+NW*64*4, LDS_BIAS=LDS_OST+NW*4096, LDS_BYTES=LDS_BIAS+BIASN*4;
constexpr float C2=0.125f*1.4426950408889634f;
__device__ __forceinline__ void glds16(const void*gsrc,unsigned lds_dst){unsigned keep;
  asm volatile("s_mov_b32 %0, m0\n\ts_mov_b32 m0, %2\n\ts_nop 0\n\tglobal_load_lds_dwordx4 %1, off\n\ts_mov_b32 m0, %0":"=&s"(keep):"v"(gsrc),"s"(lds_dst):"memory");}
__device__ __forceinline__ float max3f(float a,float b,float c){float r;asm("v_max3_f32 %0, %1, %2, %3":"=v"(r):"v"(a),"v"(b),"v"(c));return r;}
__device__ __forceinline__ float max2f(float a,float b){float r;asm("v_max_f32_e32 %0, %1, %2":"=v"(r):"v"(a),"v"(b));return r;}
__device__ __forceinline__ float fadd_s(float a,float b){float r;asm("v_add_f32_e32 %0, %1, %2":"=v"(r):"v"(a),"v"(b));return r;}
__device__ __forceinline__ float fsub_s(float a,float b){float r;asm("v_sub_f32_e32 %0, %1, %2":"=v"(r):"v"(a),"v"(b));return r;}
typedef float f32x2_t __attribute__((ext_vector_type(2))); typedef __bf16 bf16x2_t __attribute__((ext_vector_type(2)));
__device__ __forceinline__ unsigned cvtpk_s(float lo,float hi){f32x2_t v={lo,hi};bf16x2_t b=__builtin_convertvector(v,bf16x2_t);return __builtin_bit_cast(unsigned,b);}
#define WAIT_BAR(N) asm volatile("s_waitcnt vmcnt(" #N ") lgkmcnt(0)\n\ts_barrier":::"memory")

__device__ __forceinline__ void qkt(f32x16&p0,f32x16&p1,const char*Kslot,const bf16x8*qr,const f32x16&cb0,const f32x16&cb1,int r32,int hi){
  const char*kb=Kslot+hi*1024+r32*16;
  #pragma unroll
  for(int d0=0;d0<4;++d0){
    const bf16x8 b0=*reinterpret_cast<const bf16x8*>(kb+d0*2048);
    const bf16x8 b1=*reinterpret_cast<const bf16x8*>(kb+d0*2048+512);
    if(d0==0){p0=__builtin_amdgcn_mfma_f32_32x32x16_bf16(b0,qr[0],cb0,0,0,0);p1=__builtin_amdgcn_mfma_f32_32x32x16_bf16(b1,qr[0],cb1,0,0,0);}
    else{p0=__builtin_amdgcn_mfma_f32_32x32x16_bf16(b0,qr[d0],p0,0,0,0);p1=__builtin_amdgcn_mfma_f32_32x32x16_bf16(b1,qr[d0],p1,0,0,0);}}
}
typedef __attribute__((address_space(3))) const char* lds_cptr;
typedef short v4i16_t __attribute__((ext_vector_type(4)));
__device__ __forceinline__ void kload8(bf16x8*kf,lds_cptr kp){
  kf[0]=*(const __attribute__((address_space(3))) bf16x8*)(kp);      kf[1]=*(const __attribute__((address_space(3))) bf16x8*)(kp+512);
  kf[2]=*(const __attribute__((address_space(3))) bf16x8*)(kp+2048); kf[3]=*(const __attribute__((address_space(3))) bf16x8*)(kp+2560);
  kf[4]=*(const __attribute__((address_space(3))) bf16x8*)(kp+4096); kf[5]=*(const __attribute__((address_space(3))) bf16x8*)(kp+4608);
  kf[6]=*(const __attribute__((address_space(3))) bf16x8*)(kp+6144); kf[7]=*(const __attribute__((address_space(3))) bf16x8*)(kp+6656);
}
__device__ __forceinline__ void kload2(bf16x8*kf,lds_cptr kp,int j){ kf[2*j]=*(const __attribute__((address_space(3))) bf16x8*)(kp+j*2048); kf[2*j+1]=*(const __attribute__((address_space(3))) bf16x8*)(kp+j*2048+512); }
__device__ __forceinline__ s16x4 vtr(lds_cptr p){ return __builtin_bit_cast(s16x4,__builtin_amdgcn_ds_read_tr16_b64_v4i16((__attribute__((address_space(3))) v4i16_t*)p)); }
__device__ __forceinline__ float rowmax(const f32x16&p0,const f32x16&p1){
  float a=max3f(p0[0],p0[1],p1[0]),b=max3f(p0[2],p0[3],p1[1]);a=max3f(a,p1[2],p1[3]);
  #pragma unroll
  for(int r=4;r<16;r+=4){a=max3f(a,p0[r],p0[r+1]);b=max3f(b,p0[r+2],p0[r+3]);a=max3f(a,p1[r],p1[r+1]);b=max3f(b,p1[r+2],p1[r+3]);}
  const float m=max2f(a,b);
  auto rr=__builtin_amdgcn_permlane32_swap(__float_as_uint(m),__float_as_uint(m),false,false);
  return max2f(__uint_as_float(rr[0]),__uint_as_float(rr[1]));
}
__device__ __forceinline__ void pv(f32x16*o,int vb,bf16x8 pa0,bf16x8 pa1,bf16x8 pa2,bf16x8 pa3){
  #pragma unroll
  for(int d0=0;d0<2;++d0){s16x4 lo[4],hi[4];
    #pragma unroll
    for(int ks=0;ks<4;++ks){
      asm volatile("ds_read_b64_tr_b16 %0,%1 offset:%c2":"=&v"(lo[ks]):"v"(vb),"i"(d0*4096+ks*1024):"memory");
      asm volatile("ds_read_b64_tr_b16 %0,%1 offset:%c2":"=&v"(hi[ks]):"v"(vb),"i"(d0*4096+ks*1024+512):"memory");}
    asm volatile("s_waitcnt lgkmcnt(0)":::"memory");SBAR();
    #define PK(k) (bf16x8){lo[k][0],lo[k][1],lo[k][2],lo[k][3],hi[k][0],hi[k][1],hi[k][2],hi[k][3]}
    o[d0]=__builtin_amdgcn_mfma_f32_32x32x16_bf16(pa0,PK(0),o[d0],0,0,0);
    o[d0]=__builtin_amdgcn_mfma_f32_32x32x16_bf16(pa1,PK(1),o[d0],0,0,0);
    o[d0]=__builtin_amdgcn_mfma_f32_32x32x16_bf16(pa2,PK(2),o[d0],0,0,0);
    o[d0]=__builtin_amdgcn_mfma_f32_32x32x16_bf16(pa3,PK(3),o[d0],0,0,0);
    #undef PK
  }
}

#ifndef ATTN_STORE16
#define ATTN_STORE16(p,v) (*(u32x4*)(p)=(v))
#endif
template<int THRL> __device__ __forceinline__ void attn_unit(int b,int h,int qb,const bf16*Q,const bf16*__restrict__ K,const bf16*__restrict__ V,bf16*O,const float*__restrict__ NCL,char*shm){
  const int tid=tid_fresh(),lane=tid&63,r32=lane&31,hi=lane>>5; const int wid=__builtin_amdgcn_readfirstlane(tid>>6);
  const long rowbase=(long)b*SEQ; const int q0=qb*QB;
  const bf16*Qw=Q+(rowbase+q0+wid*QBLK)*DM+h*D;
  const bf16*Kh=K+(rowbase-128)*DM+h*D,*Vh=V+(rowbase-128)*DM+h*D;
  const bf16*Khm=K+(long)METAROW*DM+h*D,*Vhm=V+(long)METAROW*DM+h*D;
  const unsigned lds0=(unsigned)(uintptr_t)shm;
  float*wsf=(float*)(shm+LDS_WS)+wid*64;
  const bf16*ksrc=Kh+(long)lane*DM+wid*8;
  const bf16*vsrc=Vh+(long)(16*(wid&3)+(lane>>2))*DM+(wid>>2)*32+(lane&3)*8;
  const bf16*ksrcm=Khm+(long)lane*DM+wid*8;
  const bf16*vsrcm=Vhm+(long)(16*(wid&3)+(lane>>2))*DM+(wid>>2)*32+(lane&3)*8;
  const unsigned kdst=lds0+LDS_K+wid*1024, vdst=lds0+LDS_V+wid*1024;
  #define DMA_K(t,slot) glds16(ksrc+(long)(t)*KVBLK*DM,(unsigned)__builtin_amdgcn_readfirstlane(kdst+(slot)))
  #define DMA_V(t,slot) glds16(vsrc+(long)(t)*KVBLK*DM,(unsigned)__builtin_amdgcn_readfirstlane(vdst+(slot)))
  #define DMA_KM(slot) glds16(ksrcm,(unsigned)__builtin_amdgcn_readfirstlane(kdst+(slot)))
  #define DMA_VM(slot) glds16(vsrcm,(unsigned)__builtin_amdgcn_readfirstlane(vdst+(slot)))
  const int vb0=(int)(lds0+LDS_V)+((lane>>4)&1)*32+(lane&3)*8+(4*hi+((lane&15)>>2))*64;
  const char*Kbase=shm+LDS_K; bf16x8 kf[8];
  const lds_cptr shm3=(lds_cptr)shm; const lds_cptr kp0=shm3+LDS_K+hi*1024+r32*16; const lds_cptr vp0=shm3+LDS_V+((lane>>4)&1)*32+(lane&3)*8+(4*hi+((lane&15)>>2))*64;
  const int NT=(q0+QB)/KVBLK+2;
  { float*BLw=(float*)(shm+LDS_BIAS); const float ref=NCL[128+q0]; for(int j=tid;j<NT*KVBLK;j+=NW*64) BLw[j]=NCL[j]-ref; }
  const __attribute__((address_space(3))) f32x4*BLp=(const __attribute__((address_space(3))) f32x4*)((lds_cptr)shm+LDS_BIAS)+hi;
  DMA_KM(0);DMA_VM(0);DMA_KM(SLOTB);
  bf16x8 qr[4];
  #pragma unroll
  for(int d0=0;d0<4;++d0)qr[d0]=*reinterpret_cast<const bf16x8*>(&Qw[(long)r32*DM+d0*16+hi*8]);
  float mhat=0.f,l_reg=0.f;f32x16 o[2];o[0]=f32x16{};o[1]=f32x16{};float nm=0.f;
  const int qrel=wid*QBLK+r32;
  #define CMASK(P0,P1,t) do{int jb_=(t)-(NT-4); if(jb_>=0)cmask(P0,P1,jb_,qrel,hi);}while(0)
  bool resc=false;
  #define START(P0,P1) do{ const float rm=rowmax(P0,P1); resc=false; \
    { const float dl=rm; mhat=fadd_s(mhat,dl); \
      _Pragma("unroll") for(int r=0;r<16;++r){P0[r]=fsub_s(P0[r],dl);P1[r]=fsub_s(P1[r],dl);} \
      nm=-mhat; } \
    _Pragma("unroll") for(int r=0;r<16;++r)P0[r]=__builtin_amdgcn_exp2f(P0[r]); }while(0)
  #define RESC() do{ if(resc){ asm volatile("s_waitcnt lgkmcnt(0)":::"memory"); \
      _Pragma("unroll") for(int d_=0;d_<2;++d_) _Pragma("unroll") for(int r=0;r<16;++r)o[d_][r]*=wsf[crow(r,hi)]; } }while(0)
  f32x16 pA0,pA1,pB0,pB1;
  int sl_prev=0,sl_cur=0,sl_next=SLOTB;
  #define ROT() do{sl_prev=sl_cur;sl_cur=sl_next;sl_next=(sl_next==(NSLOT-1)*SLOTB)?0:sl_next+SLOTB;}while(0)
  DMA_K(2,2*SLOTB);
  WAIT_BAR(3);
  #define CBIAS(X0,X1,t) do{ _Pragma("unroll") for(int g_=0;g_<4;++g_){ const f32x4 a_=BLp[16*(t)+2*g_], b_=BLp[16*(t)+8+2*g_]; \
      X0[4*g_]=a_[0]+nm;X0[4*g_+1]=a_[1]+nm;X0[4*g_+2]=a_[2]+nm;X0[4*g_+3]=a_[3]+nm; X1[4*g_]=b_[0]+nm;X1[4*g_+1]=b_[1]+nm;X1[4*g_+2]=b_[2]+nm;X1[4*g_+3]=b_[3]+nm; } }while(0)
  { f32x16 cb0,cb1; CBIAS(cb0,cb1,0); qkt(pA0,pA1,Kbase,qr,cb0,cb1,r32,hi); }asm volatile("s_nop 15\n\ts_nop 7":"+v"(pA0),"+v"(pA1));CMASK(pA0,pA1,0);
  START(pA0,pA1);
  _Pragma("unroll") for(int r=0;r<16;++r)pA1[r]=__builtin_amdgcn_exp2f(pA1[r]);
  WAIT_BAR(0);
  DMA_K(3,0);DMA_VM(SLOTB);
  ROT();
  kload8(kf,kp0+sl_cur);
  WAIT_BAR(2);
  s16x4 vlo[8],vhi[8]; u32x4 pw0,pw1,pw2,pw3;
  #define PKW(P,B) cvtpk_s(P[B],P[B+1])
  #define PAF(k) __builtin_bit_cast(bf16x8,pw##k)
  #define VFR(i) (bf16x8){vlo[i][0],vlo[i][1],vlo[i][2],vlo[i][3],vhi[i][0],vhi[i][1],vhi[i][2],vhi[i][3]}
  #define PIN(x) asm volatile("":"+v"(x))
  #define MX3(a,b,c) __builtin_fmaxf(__builtin_fmaxf((a),(b)),(c))
  #define GAPA(MF,A0,A1,A2,A3,W0,W1,PW) do{ MF; sacc+=A0; sacc+=A1; sacc+=A2; sacc+=A3; PIN(sacc); W0; W1; PIN(PW); SBAR(); }while(0)
  #define EX(v) __builtin_amdgcn_exp2f(v)
  #define GAPB(MF,X,B) do{ MF; X[B]=EX(X[B]); X[B+1]=EX(X[B+1]); X[B+2]=EX(X[B+2]); X[B+3]=EX(X[B+3]); PIN(X); SBAR(); }while(0)
  #define VRD(i) do{ vlo[i]=vtr(vp_+(((i)>>2)*4096+((i)&3)*1024)); vhi[i]=vtr(vp_+(((i)>>2)*4096+((i)&3)*1024+512)); }while(0)
  #define KRD(G,j) do{ if(G){ kload2(kf,kp0+sl_next,j); SBAR(); } }while(0)
  #define STEP(C0,C1,P0,P1,t,GK,GV,GL) do{ SBAR(); \
    const lds_cptr vp_=vp0+sl_prev; CBIAS(C0,C1,t); SBAR(); \
    VRD(0); SBAR(); float sacc=(P0[0]+P0[1]); \
    GAPA(C0=__builtin_amdgcn_mfma_f32_32x32x16_bf16(kf[0],qr[0],C0,0,0,0), P0[2],P0[3],P0[4],P0[5],     pw0[0]=PKW(P0,0), pw0[1]=PKW(P0,2), pw0); \
    VRD(4); SBAR(); GAPA(C1=__builtin_amdgcn_mfma_f32_32x32x16_bf16(kf[1],qr[0],C1,0,0,0), P0[6],P0[7],P0[8],P0[9],     pw0[2]=PKW(P0,4), pw0[3]=PKW(P0,6), pw0); \
    VRD(1); SBAR(); GAPA(C0=__builtin_amdgcn_mfma_f32_32x32x16_bf16(kf[2],qr[1],C0,0,0,0),   P0[10],P0[11],P0[12],P0[13], pw1[0]=PKW(P0,8), pw1[1]=PKW(P0,10), pw1); \
    VRD(5); SBAR(); GAPA(C1=__builtin_amdgcn_mfma_f32_32x32x16_bf16(kf[3],qr[1],C1,0,0,0),   P0[14],P0[15],P1[0],P1[1],   pw1[2]=PKW(P0,12),pw1[3]=PKW(P0,14), pw1); \
    VRD(2); SBAR(); GAPA(C0=__builtin_amdgcn_mfma_f32_32x32x16_bf16(kf[4],qr[2],C0,0,0,0),   P1[2],P1[3],P1[4],P1[5],     pw2[0]=PKW(P1,0), pw2[1]=PKW(P1,2), pw2); \
    VRD(6); SBAR(); GAPA(C1=__builtin_amdgcn_mfma_f32_32x32x16_bf16(kf[5],qr[2],C1,0,0,0),   P1[6],P1[7],P1[8],P1[9],     pw2[2]=PKW(P1,4), pw2[3]=PKW(P1,6), pw2); \
    VRD(3); SBAR(); GAPA(C0=__builtin_amdgcn_mfma_f32_32x32x16_bf16(kf[6],qr[3],C0,0,0,0),   P1[10],P1[11],P1[12],P1[13], pw3[0]=PKW(P1,8), pw3[1]=PKW(P1,10), pw3); \
    VRD(7); SBAR(); GAPA(C1=__builtin_amdgcn_mfma_f32_32x32x16_bf16(kf[7],qr[3],C1,0,0,0),   P1[14],P1[15],0.f,0.f,       pw3[2]=PKW(P1,12),pw3[3]=PKW(P1,14), pw3); \
    l_reg+=sacc; \
    if(GK){DMA_K((t)+3,sl_cur);} if(GV){DMA_V((t)+1,sl_next);} \
    CMASK(C0,C1,t); \
    { float a=MX3(C0[0],C0[1],C1[0]),b=MX3(C0[2],C0[3],C1[1]); a=MX3(a,C1[2],C1[3]); \
      _Pragma("unroll") for(int r=4;r<16;r+=4){a=MX3(a,C0[r],C0[r+1]);b=MX3(b,C0[r+2],C0[r+3]);a=MX3(a,C1[r],C1[r+1]);b=MX3(b,C1[r+2],C1[r+3]);} \
      float rm=__builtin_fmaxf(a,b); { auto rr=__builtin_amdgcn_permlane32_swap(__float_as_uint(rm),__float_as_uint(rm),false,false); rm=__builtin_fmaxf(__uint_as_float(rr[0]),__uint_as_float(rr[1])); } \
      resc=false; \
      if(__builtin_expect(__any(rm>(float)THRL),0)){ const float dl=__builtin_fmaxf(rm,0.f); mhat+=dl; \
        _Pragma("unroll") for(int r=0;r<16;++r){C0[r]-=dl;C1[r]-=dl;} \
        nm=-mhat; \
        const float f=__builtin_amdgcn_exp2f(-dl); l_reg*=f; if(hi==0)wsf[r32]=f; resc=true; } } \
    SBAR(); \
    GAPB(o[0]=__builtin_amdgcn_mfma_f32_32x32x16_bf16(PAF(0),VFR(0),o[0],0,0,0), C0,0); \
    GAPB(o[1]=__builtin_amdgcn_mfma_f32_32x32x16_bf16(PAF(0),VFR(4),o[1],0,0,0), C0,4); \
    KRD(GL,0); GAPB(o[0]=__builtin_amdgcn_mfma_f32_32x32x16_bf16(PAF(1),VFR(1),o[0],0,0,0), C0,8); \
    KRD(GL,1); GAPB(o[1]=__builtin_amdgcn_mfma_f32_32x32x16_bf16(PAF(1),VFR(5),o[1],0,0,0), C0,12); \
    KRD(GL,2); GAPB(o[0]=__builtin_amdgcn_mfma_f32_32x32x16_bf16(PAF(2),VFR(2),o[0],0,0,0), C1,0); \
    KRD(GL,3); GAPB(o[1]=__builtin_amdgcn_mfma_f32_32x32x16_bf16(PAF(2),VFR(6),o[1],0,0,0), C1,4); \
    GAPB(o[0]=__builtin_amdgcn_mfma_f32_32x32x16_bf16(PAF(3),VFR(3),o[0],0,0,0), C1,8); \
    GAPB(o[1]=__builtin_amdgcn_mfma_f32_32x32x16_bf16(PAF(3),VFR(7),o[1],0,0,0), C1,12); \
    }while(0)
  int t=1;
  #undef CMASK
  #define CMASK(P0,P1,t) do{}while(0)
  for(;t+5<NT;t+=2){
    STEP(pB0,pB1,pA0,pA1,t,true,true,true);     WAIT_BAR(2); RESC(); ROT();
    STEP(pA0,pA1,pB0,pB1,t+1,true,true,true);   WAIT_BAR(2); RESC(); ROT();
  }
  #undef CMASK
  #define CMASK(P0,P1,t) do{int jb_=(t)-(NT-4); if(jb_>=0)cmask(P0,P1,jb_,qrel,hi);}while(0)
  #define ENDW(tt) do{ if((tt)+3<NT){WAIT_BAR(2);} else if((tt)+2<NT){WAIT_BAR(1);} else {WAIT_BAR(0);} }while(0)
  for(;t+1<NT;t+=2){
    STEP(pB0,pB1,pA0,pA1,t,(t+3<NT),(t+1<NT),(t+1<NT));       ENDW(t);   RESC(); ROT();
    STEP(pA0,pA1,pB0,pB1,t+1,(t+4<NT),(t+2<NT),(t+2<NT));     ENDW(t+1); RESC(); ROT();
  }
  STEP(pB0,pB1,pA0,pA1,NT-1,false,false,false); RESC();
  { float sacc=pB0[0]+pB0[1]; _Pragma("unroll") for(int r=2;r<16;++r)sacc+=pB0[r]; _Pragma("unroll") for(int r=0;r<16;++r)sacc+=pB1[r]; l_reg+=sacc;
    pw0=(u32x4){PKW(pB0,0),PKW(pB0,2),PKW(pB0,4),PKW(pB0,6)};pw1=(u32x4){PKW(pB0,8),PKW(pB0,10),PKW(pB0,12),PKW(pB0,14)};pw2=(u32x4){PKW(pB1,0),PKW(pB1,2),PKW(pB1,4),PKW(pB1,6)};pw3=(u32x4){PKW(pB1,8),PKW(pB1,10),PKW(pB1,12),PKW(pB1,14)};
    SBAR(); pv(o,vb0+sl_cur,PAF(0),PAF(1),PAF(2),PAF(3)); }
  #undef PKW
  #undef PAF
  #undef VFR
  #undef PIN
  #undef MX3
  #undef GAPA
  #undef GAPB
  #undef EX
  #undef VRD
  #undef KRD
  #undef STEP
  #undef ENDW
  {auto rr=__builtin_amdgcn_permlane32_swap(__float_as_uint(l_reg),__float_as_uint(l_reg),false,false);l_reg=__uint_as_float(rr[0])+__uint_as_float(rr[1]);}
  if(hi==0)wsf[32+r32]=l_reg;asm volatile("s_waitcnt lgkmcnt(0)":::"memory");
  float rli[16];
  #pragma unroll
  for(int r=0;r<16;++r)rli[r]=__builtin_amdgcn_rcpf(wsf[32+crow(r,hi)]);
  bf16*Ow=O+(rowbase+q0+wid*QBLK)*OPITCH+OCOL0+h*D;
  { bf16*stg=(bf16*)(shm+LDS_OST)+wid*2048;
    #pragma unroll
    for(int r=0;r<16;++r){const int orow=crow(r,hi);
      #pragma unroll
      for(int d0=0;d0<2;++d0)stg[orow*64+d0*32+r32]=__float2bfloat16(o[d0][r]*rli[r]);}
    asm volatile("s_waitcnt lgkmcnt(0)":::"memory");
    #pragma unroll
    for(int i=0;i<4;++i){const int row=i*8+(lane>>3),ch=lane&7; const u32x4 v=*(const u32x4*)(stg+row*64+ch*8); ATTN_STORE16(Ow+(long)row*OPITCH+ch*8,v);} }
  asm volatile("s_waitcnt lgkmcnt(0)\n\ts_barrier":::"memory");
  #undef DMA_K
  #undef DMA_V
  #undef DMA_KM
  #undef DMA_VM
  #undef CBIAS
  #undef CMASK
  #undef START
  #undef RESC
  #undef ROT
}
constexpr int ATTN_LDS_BYTES=LDS_BYTES;
struct AttnTensors { const bf16* Q; const bf16* K; const bf16* V; bf16* O; const float* NCL; };
struct AttnUnit { int bh; int qb; };
struct StaticOrder {
  int vcu;
  __device__ __forceinline__ explicit StaticOrder(int grid,int block):vcu((block%8)*(grid/8)+block/8){}
  __device__ __forceinline__ bool next(int i,AttnUnit&u)const{ if(i>=2)return false; const int s=vcu&15; u.bh=vcu>>4; u.qb=(i==0)?s:31-s; return true; }
  __device__ __forceinline__ void a_ready(const AttnUnit&)const{}
  __device__ __forceinline__ void done(const AttnUnit&)const{}
};
template<class Sched,int THRL=8> __device__ __forceinline__ void attn_phase(char*lds,const AttnTensors&T,const Sched&S){
  AttnUnit u;
  for(int i=0;S.next(i,u);++i){ S.a_ready(u); attn_unit<THRL>(u.bh/NHEAD,u.bh%NHEAD,u.qb,T.Q,T.K,T.V,T.O,T.NCL+(long)u.bh*BIASN,lds); S.done(u); }
}
#undef SBAR
#undef WAIT_BAR
}
#define GAS __attribute__((address_space(1)))
#define LAS __attribute__((address_space(3)))
typedef unsigned short bf16;
typedef unsigned v4u __attribute__((ext_vector_type(4)));
typedef float f32x4 __attribute__((ext_vector_type(4)));
typedef short bf16x8 __attribute__((ext_vector_type(8)));
typedef GAS unsigned gu32;
typedef GAS unsigned long long gu64;
#define RLX_AGENT __ATOMIC_RELAXED, __HIP_MEMORY_SCOPE_AGENT
#define LDS_WAIT() asm volatile("s_waitcnt lgkmcnt(0)" ::: "memory")
#define VM_WAIT() asm volatile("s_waitcnt vmcnt(0)" ::: "memory")
__device__ __forceinline__ unsigned long long rt() { return __builtin_amdgcn_s_memrealtime(); }
__device__ __forceinline__ unsigned f2bf(float f) { unsigned u = __builtin_bit_cast(unsigned, f); return (u + 0x7fffu + ((u >> 16) & 1u)) >> 16; }
__device__ __forceinline__ unsigned pk2(float lo, float hi) { return f2bf(lo) | (f2bf(hi) << 16); }

#define XB_TMO      128
#define XB_XCNT(j)  (256  + 64 * (j))
#define XB_XSUB(j)  (1280 + 64 * (j))
#define XB_XGEN(j)  (2304 + 64 * (j))
#define XB_TOP      3328
#define XB_TOPGEN   3392
#define XCD_BAR_WORDS 3456
#define XB_SPIN_CAP (1u << 18)

__device__ __forceinline__ unsigned xb_ld(unsigned* p)              { return __hip_atomic_load(p, __ATOMIC_RELAXED, __HIP_MEMORY_SCOPE_AGENT); }
__device__ __forceinline__ unsigned xb_add(unsigned* p, unsigned v) { return __hip_atomic_fetch_add(p, v, __ATOMIC_RELAXED, __HIP_MEMORY_SCOPE_AGENT); }
__device__ __forceinline__ unsigned xb_xcc_id() { return (unsigned)__builtin_amdgcn_s_getreg((3 << 11) | 20) & 0xFu; }
#define XB_SPIN(cond, bar) do { unsigned _sp = 0; while (cond) { __builtin_amdgcn_s_sleep(1); \
    if ((++_sp & 255u) == 0u) { if (xb_ld(&(bar)[XB_TMO])) break; if (_sp > XB_SPIN_CAP) { atomicAdd(&(bar)[XB_TMO], 1u); break; } } } } while (0)

struct XcdBarrier {
    unsigned* bar; unsigned x;
    volatile LAS unsigned* st;
};

__device__ __forceinline__ XcdBarrier xcd_barrier_post(unsigned* bar, volatile LAS unsigned* st) {
    XcdBarrier b; b.bar = bar; b.x = xb_xcc_id(); b.st = st;
    if (threadIdx.x == 0) (void)xb_add(&bar[XB_XCNT(b.x)], 1u);
    return b;
}
__device__ __forceinline__ void xcd_barrier_complete(unsigned* bar, unsigned x, unsigned& nloc, unsigned& nx) {
    const unsigned G = gridDim.x * gridDim.y * gridDim.z;
    unsigned sum, cnt, mine, sp = 0u;
    for (;;) {
        sum = 0u; cnt = 0u; mine = 0u;
#pragma unroll
        for (unsigned j = 0; j < 16; ++j) { const unsigned c = xb_ld(&bar[XB_XCNT(j)]); sum += c; cnt += (c > 0u) ? 1u : 0u; mine = (j == x) ? c : mine; }
        if (sum == G) break;
        __builtin_amdgcn_s_sleep(1);
        if ((++sp & 255u) == 0u) { if (xb_ld(&bar[XB_TMO])) break; if (sp > XB_SPIN_CAP) { atomicAdd(&bar[XB_TMO], 1u); break; } }
    }
    nloc = mine > 0u ? mine : 1u; nx = cnt > 0u ? cnt : 1u;
}

__device__ __forceinline__ void xcd_barrier(const XcdBarrier& b) {
    asm volatile("s_waitcnt vmcnt(0)" ::: "memory");
    __syncthreads();
    if (threadIdx.x == 0) {
        unsigned* bar = b.bar;
        __builtin_amdgcn_s_waitcnt(0);
        unsigned nloc = b.st[0], nx = b.st[1];
        if (nloc == 0u) { xcd_barrier_complete(bar, b.x, nloc, nx); b.st[0] = nloc; b.st[1] = nx; }
        const unsigned old = xb_add(&bar[XB_XSUB(b.x)], 1u);
        const unsigned gen = old / nloc;
        if (old + 1u == (gen + 1u) * nloc) {
            __builtin_amdgcn_fence(__ATOMIC_RELEASE, "agent");
            asm volatile("s_waitcnt vmcnt(0)" ::: "memory");
            const unsigned og = xb_add(&bar[XB_TOP], 1u);
            const unsigned tg = og / nx;
            if (og + 1u == (tg + 1u) * nx) xb_add(&bar[XB_TOPGEN], 1u);
            else XB_SPIN(xb_ld(&bar[XB_TOPGEN]) == tg, bar);
            __builtin_amdgcn_fence(__ATOMIC_ACQUIRE, "agent");
            xb_add(&bar[XB_XGEN(b.x)], 1u);
            asm volatile("s_waitcnt vmcnt(0)" ::: "memory");
        } else {
            XB_SPIN(xb_ld(&bar[XB_XGEN(b.x)]) == gen, bar);
            __builtin_amdgcn_fence(__ATOMIC_ACQUIRE, "agent");
            asm volatile("s_waitcnt vmcnt(0)" ::: "memory");
        }
    }
    __syncthreads();
}

constexpr int NWAVES = 8, NTHR = NWAVES * 64;
constexpr int DMOD = 1024, TREAL = 8192, NBATCH = 2, NMETA = 16, TPOS = TREAL + NMETA, NSAMP = 32;
constexpr int M_REAL = NBATCH * TREAL, ROW_META = M_REAL, ROW_SAMP = ROW_META + NMETA, M_VALID = ROW_SAMP + NSAMP, M_PAD = 16640;
constexpr int DSHIFT = 1792, DIN = 5384, N1 = 5376, DR = 512, NH = 8, HD = 64, FF = 4096, DG = 2048;
constexpr int COL_Q = 1792, COL_K = 2304, COL_V = 2816, COL_F = 3328, COL_G = 3328;
constexpr int NPAGES = 64, PAGE = 128, NSPLIT = 8;
constexpr float RMS_EPS = 1e-6f, GN_EPS = 64e-5f, LOG2E = 1.4426950408889634f;
constexpr size_t O_YP = 0, O_YS = O_YP + (size_t)M_REAL * DMOD, O_SHP = O_YS + (size_t)NSAMP * DMOD, O_WKVP = O_SHP + 2 * DSHIFT, O_KP = O_WKVP + 2 * 8 * 64 * 64,
                 O_VP = O_KP + (size_t)2 * TPOS * 512, O_LFP = O_VP + (size_t)2 * TPOS * 512, O_SHS = O_LFP + (size_t)2 * TPOS * 8, O_WKVS = O_SHS + (size_t)NSAMP * DSHIFT,
                 O_KS = O_WKVS + (size_t)NSAMP * 8 * 64 * 64, O_VS = O_KS + NSAMP * 512, O_LFS = O_VS + NSAMP * 512, O_END = O_LFS + NSAMP * 8;
static_assert(O_END == 34959360, "d_out size");
constexpr size_t MiB = 1u << 20;
constexpr size_t al(size_t x) { return (x + MiB - 1) / MiB * MiB; }
constexpr size_t WS_CTL = 0, CTL_ZERO_BYTES = 1 * MiB;
constexpr size_t WS_WIN = 1 * MiB;
constexpr size_t WS_WBR = WS_WIN + al((size_t)N1 * 1024 * 2);
constexpr size_t WS_WOUT = WS_WBR + 2 * MiB;
constexpr size_t WS_WUP = WS_WOUT + 2 * MiB;
constexpr size_t WS_WDN = WS_WUP + 8 * MiB;
constexpr size_t WS_HN = WS_WDN + 8 * MiB;
constexpr size_t WS_UR = WS_HN + al((size_t)M_PAD * 1024 * 2);
constexpr size_t WS_QB = WS_UR + al((size_t)M_PAD * DSHIFT * 4);
constexpr size_t WS_KB = WS_QB + al((size_t)M_PAD * 512 * 2);
constexpr size_t WS_VB = WS_KB + al((size_t)M_PAD * 512 * 2);
constexpr size_t WS_GB = WS_VB + al((size_t)M_PAD * 512 * 2);
constexpr size_t WS_OC = WS_GB + al((size_t)M_PAD * DG * 2);
constexpr size_t WS_LF = WS_OC + al((size_t)M_PAD * 1024 * 2);
constexpr size_t WS_NCL = WS_LF + al((size_t)M_PAD * 8 * 4);
constexpr size_t WS_PR = WS_NCL + 1 * MiB;
constexpr size_t PSTRIDE = al((size_t)M_PAD * 512 * 4);
constexpr size_t WS_Y = WS_PR + 7 * PSTRIDE;
constexpr size_t WS_TMP = WS_UR;
constexpr size_t WS_MG = WS_QB;
constexpr size_t WS_X1 = WS_HN;
constexpr size_t WS_HF = WS_UR;
static_assert(WS_QB + (size_t)M_PAD * 1024 * 2 <= WS_VB && WS_UR + (size_t)M_PAD * FF * 2 <= WS_OC, "overlay map");
constexpr size_t WS_QS = WS_Y + PSTRIDE;
constexpr size_t WS_PART = WS_QS + 1 * MiB;
constexpr size_t WS_SS = WS_PART + 1 * MiB, WS_SS48 = WS_SS + 2 * MiB;
constexpr size_t WS_WDT = WS_SS48 + 1 * MiB;
constexpr size_t WS_WAT = WS_WDT + 1 * MiB, WS_WGT = WS_WAT + 1 * MiB;
constexpr size_t UNIT_B16 = (size_t)2064 * 4096 * 2, UNIT_F32 = (size_t)2064 * 4096 * 4;
constexpr size_t WS_MTH = WS_WGT + 1 * MiB, WS_MTL = WS_MTH + al(UNIT_B16), WS_SLG = WS_MTL + al(UNIT_B16), WS_W2G = WS_SLG + al(UNIT_F32), WS_YLG = WS_W2G + al(UNIT_B16),
                 WS_G1G = WS_YLG + al(UNIT_F32), WS_G2G = WS_G1G + al(UNIT_F32), WS_S0G = WS_G2G + al(UNIT_F32);
constexpr size_t WS_PART2 = WS_S0G + al(UNIT_B16 + 8192);
constexpr size_t WS_END = WS_PART2 + 1 * MiB;
constexpr int CW_BAR = 4096;
constexpr int CW_QUEUE = 8192;
constexpr int CW_ZERO = 65536;
constexpr int CW_FLAG = 131072;
constexpr int RING_OFF = 0, RING_BYTES = 139264, LDSCTL_OFF = RING_BYTES, MISC_OFF = LDSCTL_OFF + 320, LDS_BYTES = 147456;

typedef unsigned v2u __attribute__((ext_vector_type(2)));
__device__ __forceinline__ float bflo(unsigned w) { return __uint_as_float(w << 16); }
__device__ __forceinline__ float bfhi(unsigned w) { return __uint_as_float(w & 0xffff0000u); }
template <int CTRL> __device__ __forceinline__ float dpp_f(float x) { return __builtin_bit_cast(float, __builtin_amdgcn_update_dpp(0, __builtin_bit_cast(int, x), CTRL, 0xF, 0xF, true)); }
__device__ __forceinline__ float red16(float x) {
    x += dpp_f<0xB1>(x); x += dpp_f<0x4E>(x); x += dpp_f<0x141>(x); x += dpp_f<0x128>(x); return x;
}
__device__ __forceinline__ float wred_sum(float x) {
    x = red16(x);
    { auto rr = __builtin_amdgcn_permlane16_swap(__float_as_uint(x), __float_as_uint(x), false, false); x = __uint_as_float(rr[0]) + __uint_as_float(rr[1]); }
    { auto rr = __builtin_amdgcn_permlane32_swap(__float_as_uint(x), __float_as_uint(x), false, false); x = __uint_as_float(rr[0]) + __uint_as_float(rr[1]); }
    return x;
}
__device__ __forceinline__ float wred_max(float x) {
    x = fmaxf(x, dpp_f<0xB1>(x)); x = fmaxf(x, dpp_f<0x4E>(x)); x = fmaxf(x, dpp_f<0x141>(x)); x = fmaxf(x, dpp_f<0x128>(x));
    { auto rr = __builtin_amdgcn_permlane16_swap(__float_as_uint(x), __float_as_uint(x), false, false); x = fmaxf(__uint_as_float(rr[0]), __uint_as_float(rr[1])); }
    { auto rr = __builtin_amdgcn_permlane32_swap(__float_as_uint(x), __float_as_uint(x), false, false); x = fmaxf(__uint_as_float(rr[0]), __uint_as_float(rr[1])); }
    return x;
}
__device__ __forceinline__ float wave_sum(float v) { return wred_sum(v); }
__device__ __forceinline__ float wave_max(float v) { return wred_max(v); }
__device__ __forceinline__ float sigmoidf_(float x) { return 1.0f / (1.0f + __expf(-x)); }

struct Args { const float* in[30]; float* out; unsigned char* ws; };

struct Frame {
    LAS unsigned char* lds;
    volatile LAS unsigned* MISC;
    gu32* ctl;
    int vcu, G;
    const float* in[30]; float* out; unsigned char* ws;
};
#define INP(i) (F.in[i])
enum { I_XP = 0, I_XS, I_SSHIFT, I_SWKV, I_CK, I_CV, I_CLF, I_PT, I_META, I_NMIX, I_WIN, I_MU, I_W0, I_WDEC, I_A0, I_WA, I_WG, I_KK, I_KA, I_RK, I_LNW, I_LNB, I_BF, I_WBR, I_WBF, I_WOUT, I_NFFN, I_WUP, I_WDN, I_NFIN };

__device__ __forceinline__ const float* xrow(const Frame& F, int m) {
    if (m < M_REAL) return F.in[I_XP] + (size_t)m * DMOD;
    if (m < ROW_SAMP) return F.in[I_META] + (size_t)(m - ROW_META) * DMOD;
    if (m < M_VALID) return F.in[I_XS] + (size_t)(m - ROW_SAMP) * DMOD;
    return nullptr;
}

__device__ __forceinline__ void p0_transpose_item(const float* W, int ldw, int nblk, int K, bf16* WT, int ldt, int row_off, int col_off, LAS float* scr, int item, int lane, const float* kscale = nullptr) {
    const int kb = item / nblk, nb = item % nblk, k0 = 64 * kb, n0 = 32 * nb;
#pragma unroll 8
    for (int i = 0; i < 32; ++i) { const int kk = 2 * i + (lane >> 5); scr[kk * 33 + (lane & 31)] = W[(size_t)(k0 + kk) * ldw + n0 + (lane & 31)] * (kscale ? kscale[k0 + kk] : 1.0f); }
    LDS_WAIT(); asm volatile("" ::: "memory");
    const int c = lane & 7;
#pragma unroll
    for (int j = 0; j < 4; ++j) { const int n = (lane >> 3) + 8 * j; const LAS float* s = scr + (8 * c) * 33 + n;
        v4u o; o.x = pk2(s[0 * 33], s[1 * 33]); o.y = pk2(s[2 * 33], s[3 * 33]); o.z = pk2(s[4 * 33], s[5 * 33]); o.w = pk2(s[6 * 33], s[7 * 33]);
        *(GAS v4u*)(WT + (size_t)(row_off + n0 + n) * ldt + col_off + k0 + 8 * c) = o; }
    LDS_WAIT(); asm volatile("" ::: "memory");
    (void)K;
}
__device__ __forceinline__ float log_sigmoid_(float z) { return fminf(z, 0.f) - log1pf(expf(-fabsf(z))); }

__device__ __forceinline__ void p0_prologue(Frame& F) {
    const int tid_ = tid_fresh(), lane_ = tid_ & 63, wave_ = __builtin_amdgcn_readfirstlane(tid_ >> 6); (void)lane_; (void)wave_;
    LAS float* scr = (LAS float*)(F.lds + RING_OFF + wave_ * 16384);
    const int gw = F.vcu * NWAVES + wave_, NGW = F.G * NWAVES;
    unsigned char* ws = F.ws;
    constexpr int I_A = 16 * 104, I_B = 16 * 64, I_BR = 8 * 32, I_O = 16 * 32, I_U = 16 * 128, I_D = 64 * 32;
    constexpr int I_L = 16, I_LG = 32;
    constexpr int NITEMS = I_A + I_B + 2 * I_BR + I_O + I_U + I_D + 2 * I_L + I_LG;
    for (int it = gw; it < NITEMS; it += NGW) {
        int r = it;
        if (r < I_A) { p0_transpose_item(INP(I_WIN), DIN, 104, 1024, (bf16*)(ws + WS_WIN), 1024, 0, 0, scr, r, lane_); continue; } r -= I_A;
        if (r < I_B) { p0_transpose_item(INP(I_WIN) + (COL_F + 8), DIN, 64, 1024, (bf16*)(ws + WS_WIN), 1024, COL_G, 0, scr, r, lane_); continue; } r -= I_B;
        if (r < I_BR) { p0_transpose_item(INP(I_WBR), 1024, 32, 512, (bf16*)(ws + WS_WBR), 1024, 0, 0, scr, r, lane_); continue; } r -= I_BR;
        if (r < I_BR) { p0_transpose_item(INP(I_WBF), 1024, 32, 512, (bf16*)(ws + WS_WBR), 1024, 0, 512, scr, r, lane_); continue; } r -= I_BR;
        if (r < I_O) { p0_transpose_item(INP(I_WOUT), 1024, 32, 1024, (bf16*)(ws + WS_WOUT), 1024, 0, 0, scr, r, lane_); continue; } r -= I_O;
        if (r < I_U) { p0_transpose_item(INP(I_WUP), FF, 128, 1024, (bf16*)(ws + WS_WUP), 1024, 0, 0, scr, r, lane_, INP(I_NFFN)); continue; } r -= I_U;
        if (r < I_D) { p0_transpose_item(INP(I_WDN), 1024, 32, FF, (bf16*)(ws + WS_WDN), FF, 0, 0, scr, r, lane_); continue; } r -= I_D;
        if (r < I_L) { p0_transpose_item(INP(I_WDEC), 512, 16, 64, (bf16*)(ws + WS_WDT), 64, 0, 0, scr, r, lane_); continue; } r -= I_L;
        if (r < I_L) { p0_transpose_item(INP(I_WA), 512, 16, 64, (bf16*)(ws + WS_WAT), 64, 0, 0, scr, r, lane_); continue; } r -= I_L;
        p0_transpose_item(INP(I_WG), 512, 16, 128, (bf16*)(ws + WS_WGT), 128, 0, 0, scr, r, lane_);
    }
    __syncthreads();
    LAS float* WF = (LAS float*)(F.lds + RING_OFF);
    for (int e = tid_; e < 8 * 1024; e += NTHR) { const int k = e >> 3, j = e & 7; WF[j * 1024 + k] = INP(I_NMIX)[k] * INP(I_WIN)[(size_t)k * DIN + COL_F + j]; }
    __syncthreads();
    f32x4 gm[4];
#pragma unroll
    for (int j = 0; j < 4; ++j) gm[j] = *((const GAS f32x4*)INP(I_NMIX) + lane_ + 64 * j);
    const float bfv = INP(I_BF)[lane_ & 7];
    bf16* HN = (bf16*)(ws + WS_HN); float* LF = (float*)(ws + WS_LF);
    f32x4 vnx[4];
    { const float* p0_ = gw < M_PAD ? xrow(F, gw) : nullptr; const GAS f32x4* xr = (const GAS f32x4*)(p0_ ? p0_ : F.in[I_XP]) + lane_;
#pragma unroll
      for (int j = 0; j < 4; ++j) vnx[j] = xr[64 * j]; }
    for (int m = gw; m < M_PAD; m += NGW) {
        const float* xr_ = xrow(F, m);
        GAS unsigned long long* o8 = (GAS unsigned long long*)(HN + (size_t)m * DMOD) + lane_;
        f32x4 v[4];
#pragma unroll
        for (int j = 0; j < 4; ++j) v[j] = vnx[j];
        { const int mn = m + NGW; const float* pn_ = mn < M_PAD ? xrow(F, mn) : nullptr; const GAS f32x4* xn = (const GAS f32x4*)(pn_ ? pn_ : F.in[I_XP]) + lane_;
#pragma unroll
          for (int j = 0; j < 4; ++j) vnx[j] = xn[64 * j]; }
        if (xr_ == nullptr) {
#pragma unroll
            for (int j = 0; j < 4; ++j) o8[64 * j] = 0ull;
            if (lane_ < 8) LF[(size_t)m * 8 + lane_] = 0.f;
            continue;
        }
        float s2 = 0.f;
#pragma unroll
        for (int j = 0; j < 4; ++j) { s2 += (v[j].x * v[j].x + v[j].y * v[j].y) + (v[j].z * v[j].z + v[j].w * v[j].w); }
        const float rstd = 1.0f / sqrtf(wave_sum(s2) * (1.f / DMOD) + RMS_EPS);
        float fa[8];
#pragma unroll
        for (int q = 0; q < 8; ++q) { float a = 0.f;
#pragma unroll
            for (int j = 0; j < 4; ++j) { const f32x4 w = *((const LAS f32x4*)(WF + q * 1024) + lane_ + 64 * j); a += (v[j].x * w.x + v[j].y * w.y) + (v[j].z * w.z + v[j].w * w.w); }
            fa[q] = wave_sum(a); }
        float mine = fa[0];
#pragma unroll
        for (int q = 1; q < 8; ++q) mine = ((lane_ & 7) == q) ? fa[q] : mine;
        const float lf = log_sigmoid_(mine * rstd + bfv);
        if (lane_ < 8) {
            LF[(size_t)m * 8 + lane_] = lf;
            if (m < M_REAL) F.out[O_LFP + ((size_t)(m >> 13) * TPOS + NMETA + (m & 8191)) * 8 + lane_] = lf;
            else if (m < ROW_SAMP) { F.out[O_LFP + (size_t)(m - ROW_META) * 8 + lane_] = lf; F.out[O_LFP + ((size_t)TPOS + (m - ROW_META)) * 8 + lane_] = lf; }
            else F.out[O_LFS + (size_t)(m - ROW_SAMP) * 8 + lane_] = lf;
        }
#pragma unroll
        for (int j = 0; j < 4; ++j) { const f32x4 h = v[j] * rstd * gm[j]; o8[64 * j] = (unsigned long long)pk2(h.x, h.y) | ((unsigned long long)pk2(h.z, h.w) << 32); }
    }
}

__device__ __forceinline__ void p1_cumsum(Frame& F, int bh) {
    const int tid_ = tid_fresh(), lane_ = tid_ & 63, wave_ = __builtin_amdgcn_readfirstlane(tid_ >> 6); (void)lane_; (void)wave_;
    const float* LF = (const float*)(F.ws + WS_LF); float* NCL = (float*)(F.ws + WS_NCL) + (size_t)bh * attn_body::BIASN;
    const int b = bh >> 3, h = bh & 7; constexpr int PER = 17;
    LAS float* wt = (LAS float*)(F.lds + RING_OFF);
    const int i0 = tid_ * PER;
    float s = 0.f;
    for (int i = 0; i < PER; ++i) { const int p = i0 + i; if (p < TPOS) { const int row = p < NMETA ? ROW_META + p : b * TREAL + (p - NMETA); s += LF[(size_t)row * 8 + h]; } }
    float inc = s;
#pragma unroll
    for (int o = 1; o < 64; o <<= 1) { const float t = __shfl_up(inc, o); if (lane_ >= o) inc += t; }
    if (lane_ == 63) wt[wave_] = inc;
    __syncthreads();
    float base = inc - s;
    for (int w = 0; w < wave_; ++w) base += wt[w];
    float c = base;
    for (int i = 0; i < PER; ++i) { const int p = i0 + i; if (p < TPOS) { const int row = p < NMETA ? ROW_META + p : b * TREAL + (p - NMETA); c += LF[(size_t)row * 8 + h];
        NCL[p < NMETA ? p : 128 + (p - NMETA)] = -c * LOG2E; } }
    if (tid_ >= 16 && tid_ < 128) NCL[tid_] = -1e30f;
    __syncthreads();
}

namespace pg8 {
struct EpiIn {
    static constexpr bool PERM = true, AFTER_DRAIN = false;
    bf16_t* UR; bf16_t* QB; bf16_t* KB; bf16_t* VB; bf16_t* GB; float* QS; float* out;
    static __device__ __forceinline__ float sg(float x) { return __builtin_amdgcn_rcpf(1.0f + __builtin_amdgcn_exp2f(-1.4426950408889634f * x)); }
    __device__ __forceinline__ void operator()(const f32x4 (&acc)[2][2][4][2], const Unit& u, int wr, int wc, int fr, int fq) const {
        const int row0 = u.pm * BM + wr * 64 + fr, col0 = u.pn * BM + wc * 32 + 8 * fq; const int pn = u.pn;
        const bool real = u.pm < 64;
        const bool tail = (u.pm & 31) == 31;
#pragma unroll
        for (int ai = 0; ai < 2; ++ai)
#pragma unroll
            for (int m = 0; m < 4; ++m) { const int r = row0 + ai * HALF + m * 16;
#pragma unroll
                for (int bj = 0; bj < 2; ++bj) { const int c = col0 + bj * HALF; const f32x4 v0 = acc[ai][bj][m][0], v1 = acc[ai][bj][m][1];
                    if (pn < 7) {
                        { u32x4 w; w.x = cvt_pk_bf16(v0[0], v0[1]); w.y = cvt_pk_bf16(v0[2], v0[3]); w.z = cvt_pk_bf16(v1[0], v1[1]); w.w = cvt_pk_bf16(v1[2], v1[3]); *(u32x4*)(UR + (size_t)r * DSHIFT + c) = w; }
                        if (real) { if (tail && (r & 8191) == 8191) { float* q = out + O_SHP + (size_t)(r >> 13) * DSHIFT + c; *(f32x4*)q = v0; *(f32x4*)(q + 4) = v1; } }
                        else if (r >= ROW_SAMP && r < M_VALID) { float* q = out + O_SHS + (size_t)(r - ROW_SAMP) * DSHIFT + c; *(f32x4*)q = v0; *(f32x4*)(q + 4) = v1; }
                    } else if (pn < 9) {
                        const int cc = c - COL_Q; const float sc = attn_body::C2;
                        u32x4 w; w.x = cvt_pk_bf16(v0[0] * sc, v0[1] * sc); w.y = cvt_pk_bf16(v0[2] * sc, v0[3] * sc); w.z = cvt_pk_bf16(v1[0] * sc, v1[1] * sc); w.w = cvt_pk_bf16(v1[2] * sc, v1[3] * sc);
                        *(u32x4*)(QB + (size_t)r * 512 + cc) = w;
                        if (!real) { if (r >= ROW_SAMP && r < M_VALID) { float* q = QS + (size_t)(r - ROW_SAMP) * 512 + cc; *(f32x4*)q = v0; *(f32x4*)(q + 4) = v1; } }
                    } else if (pn < 13) {
                        const bool isk = pn < 11; const int cc = c - (isk ? COL_K : COL_V);
                        u32x4 w; w.x = cvt_pk_bf16(v0[0], v0[1]); w.y = cvt_pk_bf16(v0[2], v0[3]); w.z = cvt_pk_bf16(v1[0], v1[1]); w.w = cvt_pk_bf16(v1[2], v1[3]);
                        *(u32x4*)((isk ? KB : VB) + (size_t)r * 512 + cc) = w;
                        float* op = out + (isk ? O_KP : O_VP);
                        if (real) { float* q = op + ((size_t)(r >> 13) * TPOS + NMETA + (r & 8191)) * 512 + cc; __builtin_nontemporal_store(v0, (f32x4*)q); __builtin_nontemporal_store(v1, (f32x4*)(q + 4)); }
                        else if (r < ROW_SAMP) { float* q = op + (size_t)(r - ROW_META) * 512 + cc; *(f32x4*)q = v0; *(f32x4*)(q + 4) = v1; q += (size_t)TPOS * 512; *(f32x4*)q = v0; *(f32x4*)(q + 4) = v1; }
                        else if (r < M_VALID) { float* q = out + (isk ? O_KS : O_VS) + (size_t)(r - ROW_SAMP) * 512 + cc; *(f32x4*)q = v0; *(f32x4*)(q + 4) = v1; }
                    } else {
                        const int cc = c - COL_G;
                        u32x4 w; w.x = cvt_pk_bf16(sg(v0[0]), sg(v0[1])); w.y = cvt_pk_bf16(sg(v0[2]), sg(v0[3])); w.z = cvt_pk_bf16(sg(v1[0]), sg(v1[1])); w.w = cvt_pk_bf16(sg(v1[2]), sg(v1[3]));
                        *(u32x4*)(GB + (size_t)r * DG + cc) = w;
                    }
                } }
    }
};
struct EpiBrA {
    static constexpr bool PERM = true, AFTER_DRAIN = false;
    bf16_t* TMP; const bf16_t* GB;
    __device__ __forceinline__ void operator()(const f32x4 (&acc)[2][2][4][2], const Unit& u, int wr, int wc, int fr, int fq) const {
        const int row0 = u.pm * BM + wr * 64 + fr, col0 = u.pn * BM + wc * 32 + 8 * fq;
#pragma unroll
        for (int ai = 0; ai < 2; ++ai)
#pragma unroll
            for (int m = 0; m < 4; ++m) { const int r = row0 + ai * HALF + m * 16;
#pragma unroll
                for (int bj = 0; bj < 2; ++bj) { const int c = col0 + bj * HALF; const f32x4 v0 = acc[ai][bj][m][0], v1 = acc[ai][bj][m][1];
                    const u32x4 g = *(const u32x4*)(GB + (size_t)r * DG + c);
                    u32x4 w; w.x = cvt_pk_bf16(v0[0] * bflo(g.x), v0[1] * bfhi(g.x)); w.y = cvt_pk_bf16(v0[2] * bflo(g.y), v0[3] * bfhi(g.y)); w.z = cvt_pk_bf16(v1[0] * bflo(g.z), v1[1] * bfhi(g.z)); w.w = cvt_pk_bf16(v1[2] * bflo(g.w), v1[3] * bfhi(g.w));
                    *(u32x4*)(TMP + (size_t)r * 1024 + c) = w; } }
    }
};
struct EpiBrB {
    static constexpr bool PERM = true, AFTER_DRAIN = false;
    const bf16_t* TMP; const bf16_t* GB; bf16_t* MG;
    __device__ __forceinline__ void operator()(const f32x4 (&acc)[2][2][4][2], const Unit& u, int wr, int wc, int fr, int fq) const {
        const int row0 = u.pm * BM + wr * 64 + fr, col0 = u.pn * BM + wc * 32 + 8 * fq;
#pragma unroll
        for (int ai = 0; ai < 2; ++ai)
#pragma unroll
            for (int m = 0; m < 4; ++m) { const int r = row0 + ai * HALF + m * 16;
#pragma unroll
                for (int bj = 0; bj < 2; ++bj) { const int c = col0 + bj * HALF; const f32x4 v0 = acc[ai][bj][m][0], v1 = acc[ai][bj][m][1];
                    const u32x4 g = *(const u32x4*)(GB + (size_t)r * DG + 1024 + c);
                    const u32x4 tw = *(const u32x4*)(TMP + (size_t)r * 1024 + c); const f32x4 t0 = {bflo(tw.x), bfhi(tw.x), bflo(tw.y), bfhi(tw.y)}, t1 = {bflo(tw.z), bfhi(tw.z), bflo(tw.w), bfhi(tw.w)};
                    u32x4 w; w.x = cvt_pk_bf16(t0[0] + v0[0] * bflo(g.x), t0[1] + v0[1] * bfhi(g.x)); w.y = cvt_pk_bf16(t0[2] + v0[2] * bflo(g.y), t0[3] + v0[3] * bfhi(g.y));
                    w.z = cvt_pk_bf16(t1[0] + v1[0] * bflo(g.z), t1[1] + v1[1] * bfhi(g.z)); w.w = cvt_pk_bf16(t1[2] + v1[2] * bflo(g.w), t1[3] + v1[3] * bfhi(g.w));
                    *(u32x4*)(MG + (size_t)r * 1024 + c) = w; } }
    }
};
template <bool ADD> struct EpiRes {
    static constexpr bool PERM = true, AFTER_DRAIN = false;
    bf16_t* XB; float* SS; const float* xp;
    __device__ __forceinline__ void operator()(const f32x4 (&acc)[2][2][4][2], const Unit& u, int wr, int wc, int fr, int fq) const {
        const int row0 = u.pm * BM + wr * 64 + fr, col0 = u.pn * BM + wc * 32 + 8 * fq;
#pragma unroll
        for (int ai = 0; ai < 2; ++ai)
#pragma unroll
            for (int m = 0; m < 4; ++m) { const int r = row0 + ai * HALF + m * 16; float ssq = 0.f;
#pragma unroll
                for (int bj = 0; bj < 2; ++bj) { const int c = col0 + bj * HALF; f32x4 v0 = acc[ai][bj][m][0], v1 = acc[ai][bj][m][1];
                    if (ADD) { const u32x4 xw = *(const u32x4*)(XB + (size_t)r * 1024 + c); v0 += (f32x4){bflo(xw.x), bfhi(xw.x), bflo(xw.y), bfhi(xw.y)}; v1 += (f32x4){bflo(xw.z), bfhi(xw.z), bflo(xw.w), bfhi(xw.w)}; }
                    else { v0 += *(const f32x4*)(xp + (size_t)r * 1024 + c); v1 += *(const f32x4*)(xp + (size_t)r * 1024 + c + 4);
                        ssq += (v0[0] * v0[0] + v0[1] * v0[1]) + (v0[2] * v0[2] + v0[3] * v0[3]) + (v1[0] * v1[0] + v1[1] * v1[1]) + (v1[2] * v1[2] + v1[3] * v1[3]); }
                    u32x4 w; w.x = cvt_pk_bf16(v0[0], v0[1]); w.y = cvt_pk_bf16(v0[2], v0[3]); w.z = cvt_pk_bf16(v1[0], v1[1]); w.w = cvt_pk_bf16(v1[2], v1[3]);
                    *(u32x4*)(XB + (size_t)r * 1024 + c) = w; }
                if (!ADD) { ssq += __shfl_xor(ssq, 16); ssq += __shfl_xor(ssq, 32); if (fq == 0) SS[(size_t)r * 16 + u.pn * 4 + wc] = ssq; } }
    }
};
struct EpiUp {
    static constexpr bool PERM = true, AFTER_DRAIN = false;
    bf16_t* HF; const float* SS;
    __device__ __forceinline__ void operator()(const f32x4 (&acc)[2][2][4][2], const Unit& u, int wr, int wc, int fr, int fq) const {
        const int row0 = u.pm * BM + wr * 64 + fr, col0 = u.pn * BM + wc * 32 + 8 * fq;
#pragma unroll
        for (int ai = 0; ai < 2; ++ai)
#pragma unroll
            for (int m = 0; m < 4; ++m) { const int r = row0 + ai * HALF + m * 16;
                const f32x4* sp = (const f32x4*)(SS + (size_t)r * 16); const f32x4 s4 = (sp[0] + sp[1]) + (sp[2] + sp[3]);
                const float rstd = __builtin_amdgcn_rsqf(((s4[0] + s4[1]) + (s4[2] + s4[3])) * (1.f / 1024.f) + RMS_EPS);
#pragma unroll
                for (int bj = 0; bj < 2; ++bj) { const int c = col0 + bj * HALF; f32x4 v0 = acc[ai][bj][m][0] * rstd, v1 = acc[ai][bj][m][1] * rstd;
                    v0 = __builtin_elementwise_max(v0, (f32x4){0.f, 0.f, 0.f, 0.f}); v1 = __builtin_elementwise_max(v1, (f32x4){0.f, 0.f, 0.f, 0.f}); v0 = v0 * v0; v1 = v1 * v1;
                    u32x4 w; w.x = cvt_pk_bf16(v0[0], v0[1]); w.y = cvt_pk_bf16(v0[2], v0[3]); w.z = cvt_pk_bf16(v1[0], v1[1]); w.w = cvt_pk_bf16(v1[2], v1[3]);
                    *(u32x4*)(HF + (size_t)r * FF + c) = w; } }
    }
};
}

__device__ __forceinline__ const bf16* prev_row(const Frame& F, const bf16* UR, int row) {
    if (row < M_REAL) return (row & 8191) ? UR + (size_t)(row - 1) * DSHIFT : UR + (size_t)(ROW_SAMP - 1) * DSHIFT;
    return row > ROW_META ? UR + (size_t)(row - 1) * DSHIFT : (const bf16*)(F.ctl + CW_ZERO);
}
__device__ __forceinline__ void p2_prep(Frame& F, int tl) {
    const int tid_ = tid_fresh(), lane_ = tid_ & 63, wave_ = __builtin_amdgcn_readfirstlane(tid_ >> 6); (void)lane_; (void)wave_;
    float* PR = (float*)(F.ws + WS_PR); constexpr size_t PS = PSTRIDE / 4;
    LAS float* ACT = (LAS float*)(F.lds + RING_OFF);
    const int c = tid_;
    const float* mu = INP(I_MU);
    const float mu_r = mu[c], mu_k = mu[512 + c], mu_v = mu[1024 + c];
    const float w0 = INP(I_W0)[c], a0 = INP(I_A0)[c], kkc = INP(I_KK)[c], kac = INP(I_KA)[c];
    const float* Wd = INP(I_WDEC) + c; const float* Wa = INP(I_WA) + c; const float* Wg = INP(I_WG) + c;
    constexpr int NTILE = M_VALID / 16;
    (void)NTILE; {
        const int r0 = tl * 16;
        __syncthreads();
#pragma unroll
        for (int i = 0; i < 8; ++i) { const int e = tid_ + NTHR * i, rr = e >> 8, k = e & 255, row = r0 + rr;
            const float* cur = F.out + O_SHS + (size_t)(row - ROW_SAMP) * DSHIFT + 1536 + k; const float* prv = F.in[I_SSHIFT] + (size_t)(row - ROW_SAMP) * DSHIFT + 1536 + k;
            const float u = *cur, us = u + mu[1536 + k] * (*prv - u);
            ACT[k * 16 + rr] = k < 64 ? tanhf(us) : k < 128 ? us : sigmoidf_(us); }
        __syncthreads();
        float aw[16], aa[16], ag[16];
#pragma unroll
        for (int i = 0; i < 16; ++i) { aw[i] = 0.f; aa[i] = 0.f; ag[i] = 0.f; }
        for (int k = 0; k < 64; ++k) { const float wd = Wd[(size_t)k * 512], wa = Wa[(size_t)k * 512];
#pragma unroll
            for (int q = 0; q < 4; ++q) { const f32x4 x = *(const LAS f32x4*)(ACT + k * 16 + 4 * q), y = *(const LAS f32x4*)(ACT + (64 + k) * 16 + 4 * q);
                aw[4 * q] += x[0] * wd; aw[4 * q + 1] += x[1] * wd; aw[4 * q + 2] += x[2] * wd; aw[4 * q + 3] += x[3] * wd;
                aa[4 * q] += y[0] * wa; aa[4 * q + 1] += y[1] * wa; aa[4 * q + 2] += y[2] * wa; aa[4 * q + 3] += y[3] * wa; } }
        for (int k = 0; k < 128; ++k) { const float wg = Wg[(size_t)k * 512];
#pragma unroll
            for (int q = 0; q < 4; ++q) { const f32x4 x = *(const LAS f32x4*)(ACT + (128 + k) * 16 + 4 * q);
                ag[4 * q] += x[0] * wg; ag[4 * q + 1] += x[1] * wg; ag[4 * q + 2] += x[2] * wg; ag[4 * q + 3] += x[3] * wg; } }
#pragma unroll
        for (int i = 0; i < 16; ++i) { const int row = r0 + i;
            const float* cur = F.out + O_SHS + (size_t)(row - ROW_SAMP) * DSHIFT + c; const float* prv = F.in[I_SSHIFT] + (size_t)(row - ROW_SAMP) * DSHIFT + c;
            const float ur = cur[0], uk = cur[512], uv = cur[1024];
            const float r = ur + mu_r * (prv[0] - ur), k = uk + mu_k * (prv[512] - uk), v = uv + mu_v * (prv[1024] - uv);
            const float x = w0 + aw[i];
            const float sp = fmaxf(-x, 0.f) + log1pf(expf(-fabsf(x)));
            const float dec = expf(-expf(-sp - 0.5f));
            const float a = sigmoidf_(a0 + aa[i]);
            float kk = k * kkc; const float nrm = sqrtf(wave_sum(kk * kk)); kk = kk / fmaxf(nrm, 1e-12f);
            const float k2 = k * (1.0f + (a - 1.0f) * kac);
            const size_t o = (size_t)row * 512 + c;
            PR[o] = r; PR[PS + o] = dec; PR[2 * PS + o] = k2; PR[3 * PS + o] = v; PR[4 * PS + o] = kk; PR[5 * PS + o] = kk * a; PR[6 * PS + o] = ag[i]; }
    }
    __syncthreads();
}

__device__ __forceinline__ void p2_meta_attn(Frame& F) {
    const int tid_ = tid_fresh(), lane_ = tid_ & 63, wave_ = __builtin_amdgcn_readfirstlane(tid_ >> 6); (void)lane_; (void)wave_;
    const bf16* QB = (const bf16*)(F.ws + WS_QB); const bf16* KB = (const bf16*)(F.ws + WS_KB); const bf16* VB = (const bf16*)(F.ws + WS_VB); bf16* OC = (bf16*)(F.ws + WS_OC);
    const float* NCL = (const float*)(F.ws + WS_NCL);
    const int h = wave_, i = lane_ & 15, part = lane_ >> 4;
    float q[16];
    { const v4u* qp = (const v4u*)(QB + (size_t)(ROW_META + i) * 512 + h * 64 + part * 16); const v4u a = qp[0], b = qp[1];
      q[0] = bflo(a.x); q[1] = bfhi(a.x); q[2] = bflo(a.y); q[3] = bfhi(a.y); q[4] = bflo(a.z); q[5] = bfhi(a.z); q[6] = bflo(a.w); q[7] = bfhi(a.w);
      q[8] = bflo(b.x); q[9] = bfhi(b.x); q[10] = bflo(b.y); q[11] = bfhi(b.y); q[12] = bflo(b.z); q[13] = bfhi(b.z); q[14] = bflo(b.w); q[15] = bfhi(b.w); }
    float s[16]; const float nci = NCL[(size_t)h * attn_body::BIASN + i];
#pragma unroll
    for (int j = 0; j < 16; ++j) { const v4u* kp = (const v4u*)(KB + (size_t)(ROW_META + j) * 512 + h * 64 + part * 16); const v4u a = kp[0], b = kp[1];
        float d = q[0] * bflo(a.x) + q[1] * bfhi(a.x) + q[2] * bflo(a.y) + q[3] * bfhi(a.y) + q[4] * bflo(a.z) + q[5] * bfhi(a.z) + q[6] * bflo(a.w) + q[7] * bfhi(a.w)
                + q[8] * bflo(b.x) + q[9] * bfhi(b.x) + q[10] * bflo(b.y) + q[11] * bfhi(b.y) + q[12] * bflo(b.z) + q[13] * bfhi(b.z) + q[14] * bflo(b.w) + q[15] * bfhi(b.w);
        d += __shfl_xor(d, 16); d += __shfl_xor(d, 32);
        s[j] = (j <= i) ? d + NCL[(size_t)h * attn_body::BIASN + j] - nci : -INFINITY; }
    float mx = s[0];
#pragma unroll
    for (int j = 1; j < 16; ++j) mx = fmaxf(mx, s[j]);
    float l = 0.f; float o[16];
#pragma unroll
    for (int d = 0; d < 16; ++d) o[d] = 0.f;
#pragma unroll
    for (int j = 0; j < 16; ++j) { const float p = exp2f(s[j] - mx); l += p;
        const v4u* vp = (const v4u*)(VB + (size_t)(ROW_META + j) * 512 + h * 64 + part * 16); const v4u a = vp[0], b = vp[1];
        o[0] += p * bflo(a.x); o[1] += p * bfhi(a.x); o[2] += p * bflo(a.y); o[3] += p * bfhi(a.y); o[4] += p * bflo(a.z); o[5] += p * bfhi(a.z); o[6] += p * bflo(a.w); o[7] += p * bfhi(a.w);
        o[8] += p * bflo(b.x); o[9] += p * bfhi(b.x); o[10] += p * bflo(b.y); o[11] += p * bfhi(b.y); o[12] += p * bflo(b.z); o[13] += p * bfhi(b.z); o[14] += p * bflo(b.w); o[15] += p * bfhi(b.w); }
    const float rl = 1.0f / l;
    v4u w0, w1; w0.x = pk2(o[0] * rl, o[1] * rl); w0.y = pk2(o[2] * rl, o[3] * rl); w0.z = pk2(o[4] * rl, o[5] * rl); w0.w = pk2(o[6] * rl, o[7] * rl);
    w1.x = pk2(o[8] * rl, o[9] * rl); w1.y = pk2(o[10] * rl, o[11] * rl); w1.z = pk2(o[12] * rl, o[13] * rl); w1.w = pk2(o[14] * rl, o[15] * rl);
    v4u* op = (v4u*)(OC + (size_t)(ROW_META + i) * 1024 + 512 + h * 64 + part * 16); op[0] = w0; op[1] = w1;
}

constexpr int PART_STRIDE = 80;
struct DecK { f32x4 k[4]; };
struct DecV { f32x4 v[4]; };
__device__ __forceinline__ void dec_ld(const Frame& F, DecK& K, DecV& V, int pgv, int h, int c, int cend, int g, int kq) {
    c = c < cend ? c : cend - 1;
    const int page = __builtin_amdgcn_readlane(pgv, c >> 3), pos0 = (c & 7) * 16;
    const size_t off = (size_t)page * (PAGE * 512) + h * 64 + 4 * kq + (size_t)(pos0 + g) * 512;
    const float* Kp = F.in[I_CK] + off; const float* Vp = F.in[I_CV] + off;
#pragma unroll
    for (int i = 0; i < 4; ++i) K.k[i] = __builtin_nontemporal_load((const f32x4*)(Kp + (size_t)(4 * i) * 512));
#pragma unroll
    for (int i = 0; i < 4; ++i) V.v[i] = __builtin_nontemporal_load((const f32x4*)(Vp + (size_t)(4 * i) * 512));
}
__device__ __forceinline__ float dec_lf(const Frame& F, int pgv, int h, int S, int Send, int lane) {
    S = S < Send ? S : Send - 1;
    const int page = __builtin_amdgcn_readlane(pgv, S >> 1);
    return F.in[I_CLF][(size_t)page * (PAGE * 8) + (size_t)((S & 1) * 64 + lane) * 8 + h];
}
template <int CC> __device__ __forceinline__ void dec_dot(const DecK& K, const f32x4 q4, float& smine, int kq) {
#pragma unroll
    for (int i = 0; i < 4; ++i) { float d = (K.k[i][0] * q4[0] + K.k[i][1] * q4[1]) + (K.k[i][2] * q4[2] + K.k[i][3] * q4[3]);
        d = red16(d); smine = (kq == 4 * CC + i) ? d : smine; }
}
__device__ __forceinline__ void dec_update(const DecV& V0, const DecV& V1, const DecV& V2, const DecV& V3, float lf, float smine, float& m, float& l, float& csum, f32x4& o4, int lane, int g, int kq) {
    float inc = lf;
#pragma unroll
    for (int o = 1; o < 64; o <<= 1) { const float t = __shfl_up(inc, o); if (lane >= o) inc += t; }
    const float cpos = __shfl(inc, 16 * (kq >> 2) + 4 * (kq & 3) + g), ctot = __shfl(inc, 63);
    const float s = smine - (csum + cpos);
    csum += ctot;
    const float mc = wred_max(s), mn = fmaxf(m, mc), alpha = __expf(m - mn), p = __expf(s - mn);
    l = l * alpha + wred_sum(p); m = mn; o4 = o4 * alpha;
#define DEC_PV(V, CC) _Pragma("unroll") for (int i = 0; i < 4; ++i) { const float pi = __shfl(p, g * 16 + 4 * (CC) + i); o4 += V.v[i] * pi; }
    DEC_PV(V0, 0) DEC_PV(V1, 1) DEC_PV(V2, 2) DEC_PV(V3, 3)
#undef DEC_PV
}
__device__ __forceinline__ void p2_decode_split(Frame& F, int item, int half) {
    const int tid_ = tid_fresh(), lane_ = tid_ & 63, wave_ = __builtin_amdgcn_readfirstlane(tid_ >> 6);
    const int bt = item >> 3, sp = item & 7, h = wave_, kq = lane_ & 15, g = lane_ >> 4;
    const float* QS = (const float*)(F.ws + WS_QS); float* PART = (float*)(F.ws + (half ? WS_PART2 : WS_PART)) + (size_t)((bt * NSPLIT + sp) * NH + h) * PART_STRIDE;
    const int* PT = (const int*)INP(I_PT);
    f32x4 q4 = *(const f32x4*)(QS + (size_t)bt * 512 + h * 64 + 4 * kq); q4 = q4 * 0.125f;
    float m = -1e30f, l = 0.f, csum = 0.f; f32x4 o4 = {0.f, 0.f, 0.f, 0.f};
    const int cbeg = half * 32, cend = cbeg + 32;
    DecK K0, K1, K2, K3; DecV V0, V1, V2, V3, V4, V5, V6, V7;
    const int pgv = PT[bt * NPAGES + sp * 8 + (lane_ & 7)];
#define DL(KX, VX, c) do { __builtin_amdgcn_sched_barrier(0); dec_ld(F, KX, VX, pgv, h, (c), cend, g, kq); __builtin_amdgcn_sched_barrier(0); } while (0)
#define DLF(S) dec_lf(F, pgv, h, (S), cend >> 2, lane_)
#define DU(A, B, C, D, LFV) dec_update(A, B, C, D, LFV, sm, m, l, csum, o4, lane_, g, kq)
    DL(K0, V0, cbeg); DL(K1, V1, cbeg + 1); DL(K2, V2, cbeg + 2);
    float lfA = DLF(cbeg >> 2), lfB;
#pragma unroll 1
    for (int c = cbeg; c < cend; c += 8) {
        float sm = 0.f;
        DL(K3, V3, c + 3); dec_dot<0>(K0, q4, sm, kq);
        DL(K0, V4, c + 4); dec_dot<1>(K1, q4, sm, kq);
        DL(K1, V5, c + 5); dec_dot<2>(K2, q4, sm, kq);
        DL(K2, V6, c + 6); dec_dot<3>(K3, q4, sm, kq);
        lfB = DLF((c >> 2) + 1);
        DU(V0, V1, V2, V3, lfA);
        sm = 0.f;
        DL(K3, V7, c + 7); dec_dot<0>(K0, q4, sm, kq);
        DL(K0, V0, c + 8); dec_dot<1>(K1, q4, sm, kq);
        DL(K1, V1, c + 9); dec_dot<2>(K2, q4, sm, kq);
        DL(K2, V2, c + 10); dec_dot<3>(K3, q4, sm, kq);
        lfA = DLF((c >> 2) + 2);
        DU(V4, V5, V6, V7, lfB);
    }
#undef DL
#undef DLF
#undef DU
#pragma unroll
    for (int e = 0; e < 4; ++e) { float t = o4[e]; t += __shfl_xor(t, 16); t += __shfl_xor(t, 32); o4[e] = t; }
    if (g == 0) *(f32x4*)(PART + 16 + 4 * kq) = o4;
    if (lane_ == 0) { PART[0] = m; PART[1] = l; PART[2] = csum; }
}

__device__ __forceinline__ void p2_scan_sample(Frame& F, int item) {
    const int tid_ = tid_fresh(), lane_ = tid_ & 63, wave_ = __builtin_amdgcn_readfirstlane(tid_ >> 6); (void)lane_; (void)wave_;
    const int bt = item >> 3, h = item & 7, v = tid_ >> 3, k8 = tid_ & 7;
    const float* PR = (const float*)(F.ws + WS_PR); constexpr size_t PS = PSTRIDE / 4;
    float* Y = (float*)(F.ws + WS_Y);
    const size_t ro = (size_t)(ROW_SAMP + bt) * 512 + h * 64, so = ((size_t)(bt * 8 + h) * 64 + v) * 64 + 8 * k8;
    const float vv = PR[3 * PS + ro + v];
    float u = 0.f; f32x4 S[2];
#pragma unroll
    for (int e = 0; e < 2; ++e) { S[e] = *(const f32x4*)(INP(I_SWKV) + so + 4 * e); const f32x4 kk4 = *(const f32x4*)(PR + 4 * PS + ro + 8 * k8 + 4 * e);
        u += (S[e][0] * kk4[0] + S[e][1] * kk4[1]) + (S[e][2] * kk4[2] + S[e][3] * kk4[3]); }
    u += __shfl_xor(u, 1); u += __shfl_xor(u, 2); u += __shfl_xor(u, 4);
    float y = 0.f;
#pragma unroll
    for (int e = 0; e < 2; ++e) { const f32x4 w4 = *(const f32x4*)(PR + PS + ro + 8 * k8 + 4 * e), b4 = *(const f32x4*)(PR + 5 * PS + ro + 8 * k8 + 4 * e),
                                              k4 = *(const f32x4*)(PR + 2 * PS + ro + 8 * k8 + 4 * e), r4 = *(const f32x4*)(PR + ro + 8 * k8 + 4 * e);
        S[e] = S[e] * w4 + k4 * vv - b4 * u;
        y += (S[e][0] * r4[0] + S[e][1] * r4[1]) + (S[e][2] * r4[2] + S[e][3] * r4[3]);
        *(f32x4*)(F.out + O_WKVS + so + 4 * e) = S[e]; }
    y += __shfl_xor(y, 1); y += __shfl_xor(y, 2); y += __shfl_xor(y, 4);
    if (k8 == 0) Y[ro + v] = y;
}

__device__ __forceinline__ void p2_post(Frame& F) {
    const int tid_ = tid_fresh(), lane_ = tid_ & 63, wave_ = __builtin_amdgcn_readfirstlane(tid_ >> 6); (void)lane_; (void)wave_;
    const float* PR = (const float*)(F.ws + WS_PR); constexpr size_t PS = PSTRIDE / 4;
    const float* Y = (const float*)(F.ws + WS_Y); bf16* OC = (bf16*)(F.ws + WS_OC);
    const int c = tid_;
    const float lw = INP(I_LNW)[c], lb = INP(I_LNB)[c], rk = INP(I_RK)[c];
    for (int row = ROW_SAMP + F.vcu; row < M_VALID; row += F.G) {
        const size_t o = (size_t)row * 512 + c;
        const float y = Y[o], r = PR[o], k = PR[2 * PS + o], v = PR[3 * PS + o], g = PR[6 * PS + o];
        const float mu = wave_sum(y) * (1.f / 64.f), d = y - mu, var = wave_sum(d * d) * (1.f / 64.f);
        const float yn = d * (1.0f / sqrtf(var + GN_EPS)) * lw + lb;
        const float bonus = wave_sum(r * k * rk) * v;
        const float ov = (yn + bonus) * g;
        const float on = __shfl_down(ov, 1);
        if ((lane_ & 1) == 0) *(unsigned*)(OC + (size_t)row * 1024 + c) = pk2(ov, on);
    }
}
__device__ __forceinline__ void p2_decode_combine(Frame& F, int bt) {
    const int tid_ = tid_fresh(), lane_ = tid_ & 63, wave_ = __builtin_amdgcn_readfirstlane(tid_ >> 6); (void)lane_; (void)wave_;
    const int h = wave_, d = lane_;
    const float* QS = (const float*)(F.ws + WS_QS); const float* PART = (const float*)(F.ws + WS_PART) + (size_t)(bt * NSPLIT * NH + h) * PART_STRIDE;
    const float* LF = (const float*)(F.ws + WS_LF); bf16* OC = (bf16*)(F.ws + WS_OC);
    const float kn = F.out[O_KS + (size_t)bt * 512 + h * 64 + d], vn = F.out[O_VS + (size_t)bt * 512 + h * 64 + d], qn = QS[(size_t)bt * 512 + h * 64 + d];
    const float snew = wave_sum(qn * kn) * 0.125f;
    float off = LF[(size_t)(ROW_SAMP + bt) * 8 + h];
    const float* PART2 = (const float*)(F.ws + WS_PART2) + (size_t)(bt * NSPLIT * NH + h) * PART_STRIDE;
    float Ms[2 * NSPLIT]; float M = snew;
#pragma unroll
    for (int j = 2 * NSPLIT - 1; j >= 0; --j) { const float* P = ((j & 1) ? PART2 : PART) + (size_t)(j >> 1) * NH * PART_STRIDE; Ms[j] = P[0] + P[2] + off; off += P[2]; M = fmaxf(M, Ms[j]); }
    float w = __expf(snew - M), L = w, o = w * vn;
#pragma unroll
    for (int j = 0; j < 2 * NSPLIT; ++j) { const float* P = ((j & 1) ? PART2 : PART) + (size_t)(j >> 1) * NH * PART_STRIDE; w = __expf(Ms[j] - M); L += w * P[1]; o += w * P[16 + d]; }
    const float ov = o / L, on = __shfl_down(ov, 1);
    if ((d & 1) == 0) *(unsigned*)(OC + (size_t)(ROW_SAMP + bt) * 1024 + 512 + h * 64 + d) = pk2(ov, on);
}

__device__ __forceinline__ void p6_norm_final(Frame& F) {
    const int tid_ = tid_fresh(), lane_ = tid_ & 63, wave_ = __builtin_amdgcn_readfirstlane(tid_ >> 6);
    const int gw = F.vcu * NWAVES + wave_, NGW = F.G * NWAVES;
    const bf16* XB = (const bf16*)(F.ws + WS_X1);
    const float* gf = INP(I_NFIN);
    const f32x4 g0 = *(const f32x4*)(gf + 8 * lane_), g1 = *(const f32x4*)(gf + 8 * lane_ + 4), g2 = *(const f32x4*)(gf + 512 + 8 * lane_), g3 = *(const f32x4*)(gf + 516 + 8 * lane_);
    for (int m = gw; m < M_VALID; m += NGW) {
        if (m >= M_REAL && m < ROW_SAMP) continue;
        const v4u wa = *(const v4u*)(XB + (size_t)m * DMOD + 8 * lane_), wb = *(const v4u*)(XB + (size_t)m * DMOD + 512 + 8 * lane_);
        const f32x4 v0 = {bflo(wa.x), bfhi(wa.x), bflo(wa.y), bfhi(wa.y)}, v1 = {bflo(wa.z), bfhi(wa.z), bflo(wa.w), bfhi(wa.w)}, v2 = {bflo(wb.x), bfhi(wb.x), bflo(wb.y), bfhi(wb.y)}, v3 = {bflo(wb.z), bfhi(wb.z), bflo(wb.w), bfhi(wb.w)};
        const f32x4 sq = (v0 * v0 + v1 * v1) + (v2 * v2 + v3 * v3);
        const float rstd = 1.0f / sqrtf(wave_sum((sq[0] + sq[1]) + (sq[2] + sq[3])) * (1.f / DMOD) + RMS_EPS);
        float* o = F.out + (m < M_REAL ? O_YP + (size_t)m * DMOD : O_YS + (size_t)(m - ROW_SAMP) * DMOD);
        __builtin_nontemporal_store(v0 * rstd * g0, (f32x4*)(o + 8 * lane_)); __builtin_nontemporal_store(v1 * rstd * g1, (f32x4*)(o + 8 * lane_ + 4)); __builtin_nontemporal_store(v2 * rstd * g2, (f32x4*)(o + 512 + 8 * lane_)); __builtin_nontemporal_store(v3 * rstd * g3, (f32x4*)(o + 516 + 8 * lane_));
    }
}

constexpr int NCH = 129, NUNIT = 16 * NCH, TPB = 72;
constexpr int RA_KK = 0, RA_BB = 9216, RA_KT = 18432, RA_RT = 27648, RA_KET = 36864, RA_BET = 46080, RA_VMT = 55296, RA_AB = 64512, RA_BM = 73728, RA_ARK = 82944, RA_ARB = 92160,
              RA_XT = 101376, RA_DIAG = 119808, RA_ZS = 123904, RA_GC = 134144, RA_SEG = 134400, RA_END = 136448;
constexpr int RA_ACTW = 0, RA_ACTA = 9216, RA_ACTG = 18432, RA_WLF = 64512, RA_ALF = 81920, RA_GLF = 99328, RA_GAM = 116736, RA_BVF = RA_BB;
constexpr int FP = 68, ZP = 20, GP = 136;
static_assert(RA_END <= RING_BYTES && RA_GAM + 64 * FP * 4 <= RA_GC && RA_ACTG + 64 * GP * 2 <= RA_AB, "rwkv chunk LDS map");
constexpr size_t UE = 4096;

__device__ __forceinline__ int chunk_row(int b, int c, int t) { return c == 0 ? (t < NMETA ? ROW_META + t : -1) : b * TREAL + 64 * (c - 1) + t; }
#define FRAG_L(base, pitch, row, k) (*(const LAS bf16x8*)((const LAS bf16*)(base) + (row) * (pitch) + (k)))
#define FRAG_G(base, pitch, row, k) (*(const bf16x8*)((const bf16*)(base) + (size_t)(row) * (pitch) + (k)))
#define MMA16(acc, af, bf_) acc = __builtin_amdgcn_mfma_f32_16x16x32_bf16(af, bf_, acc, 0, 0, 0)
__device__ __forceinline__ f32x4 prod_ll(const LAS unsigned char* X, const LAS unsigned char* Y, int r0, int c0, int l15, int kg, f32x4 acc) {
#pragma unroll
    for (int k0 = 0; k0 < 64; k0 += 32) MMA16(acc, FRAG_L(Y, TPB, c0 + l15, k0 + 8 * kg), FRAG_L(X, TPB, r0 + l15, k0 + 8 * kg));
    return acc;
}
__device__ __forceinline__ v2u pk4(f32x4 v) { v2u w; w.x = pk2(v[0], v[1]); w.y = pk2(v[2], v[3]); return w; }
__device__ __forceinline__ f32x4 unpk4(v2u w) { return (f32x4){bflo(w.x), bfhi(w.x), bflo(w.y), bfhi(w.y)}; }
__device__ __forceinline__ float fsig(float x) { return __builtin_amdgcn_rcpf(1.0f + __builtin_amdgcn_exp2f(-LOG2E * x)); }
struct F8 { f32x4 a, b; };
__device__ __forceinline__ F8 ld8(const float* p) { F8 r; r.a = *(const f32x4*)p; r.b = *(const f32x4*)(p + 4); return r; }
__device__ __forceinline__ F8 ld8b(const bf16* p) { const v4u w = *(const v4u*)p; F8 r; r.a = (f32x4){bflo(w.x), bfhi(w.x), bflo(w.y), bfhi(w.y)}; r.b = (f32x4){bflo(w.z), bfhi(w.z), bflo(w.w), bfhi(w.w)}; return r; }
__device__ __forceinline__ F8 ld8l(const LAS float* p) { F8 r; r.a = *(const LAS f32x4*)p; r.b = *(const LAS f32x4*)(p + 4); return r; }
__device__ __forceinline__ float f8g(const F8& x, int e) { return e < 4 ? x.a[e] : x.b[e - 4]; }
__device__ __forceinline__ v4u pk8(const float (&v)[8]) { v4u w; w.x = pk2(v[0], v[1]); w.y = pk2(v[2], v[3]); w.z = pk2(v[4], v[5]); w.w = pk2(v[6], v[7]); return w; }

#define LBAR() asm volatile("s_waitcnt lgkmcnt(0)\n\ts_barrier" ::: "memory")
constexpr int DLIM = 32;
struct DecS { f32x4 k[4], v[4]; float lf; };
struct DecCtx { f32x4 q4, o4; float m, l, csum; int pgv, c; };
__device__ __forceinline__ void decs_load(const Frame& F, DecS& B, const DecCtx& D, int c, int hd, int lane) {
    const int kq = lane & 15, g = lane >> 4;
    const int page = __builtin_amdgcn_readlane(D.pgv, c >> 3), pos0 = (c & 7) * 16;
    const size_t off = (size_t)page * (PAGE * 512) + hd * 64 + 4 * kq + (size_t)(pos0 + g) * 512;
    const float* Kp = F.in[I_CK] + off; const float* Vp = F.in[I_CV] + off;
#pragma unroll
    for (int i = 0; i < 4; ++i) B.k[i] = __builtin_nontemporal_load((const f32x4*)(Kp + (size_t)(4 * i) * 512));
#pragma unroll
    for (int i = 0; i < 4; ++i) B.v[i] = __builtin_nontemporal_load((const f32x4*)(Vp + (size_t)(4 * i) * 512));
    B.lf = F.in[I_CLF][(size_t)page * (PAGE * 8) + (size_t)(pos0 + kq) * 8 + hd];
}
__device__ __forceinline__ void decs_use(const DecS& B, DecCtx& D, int lane) {
    const int kq = lane & 15, g = lane >> 4;
    float smine = 0.f;
#pragma unroll
    for (int i = 0; i < 4; ++i) { float d = (B.k[i][0] * D.q4[0] + B.k[i][1] * D.q4[1]) + (B.k[i][2] * D.q4[2] + B.k[i][3] * D.q4[3]);
        d = red16(d); smine = ((kq & 3) == i) ? d : smine; }
    float inc = B.lf;
    inc += dpp_f<0x111>(inc); inc += dpp_f<0x112>(inc); inc += dpp_f<0x114>(inc); inc += dpp_f<0x118>(inc);
    const float cpos = __shfl(inc, 4 * (kq & 3) + g);
    const float ctot = __uint_as_float(__builtin_amdgcn_readlane(__float_as_uint(inc), 15));
    const float s = smine - (D.csum + cpos);
    D.csum += ctot;
    const float mc = wred_max(s), mn = fmaxf(D.m, mc), alpha = __expf(D.m - mn), p = __expf(s - mn);
    D.l = D.l * alpha + 0.25f * wred_sum(p); D.m = mn; D.o4 = D.o4 * alpha;
    D.o4 += B.v[0] * dpp_f<0x00>(p); D.o4 += B.v[1] * dpp_f<0x55>(p); D.o4 += B.v[2] * dpp_f<0xAA>(p); D.o4 += B.v[3] * dpp_f<0xFF>(p);
}
__device__ __forceinline__ F8 unb(v4u w) { F8 r; r.a = (f32x4){bflo(w.x), bfhi(w.x), bflo(w.y), bfhi(w.y)}; r.b = (f32x4){bflo(w.z), bfhi(w.z), bflo(w.w), bfhi(w.w)}; return r; }
struct RaPre { v4u cw, pw, ca, pa, cg0, pg0, cg1, pg1; };
__device__ __forceinline__ void ra_prefetch(Frame& F, int u, RaPre& P) {
    const int tid = tid_fresh(); const int bh = u / NCH, c = u - bh * NCH, b = bh >> 3, h = bh & 7, t = tid >> 3, j8 = tid & 7, row = chunk_row(b, c, t);
    const bf16* UR = (const bf16*)(F.ws + WS_UR);
    const bf16* zr = (const bf16*)(F.ctl + CW_ZERO);
    const bf16* cur = row >= 0 ? UR + (size_t)row * DSHIFT : zr; const bf16* prv = row >= 0 ? prev_row(F, UR, row) : zr; (void)h;
    P.cw = *(const v4u*)(cur + 1536 + 8 * j8); P.pw = *(const v4u*)(prv + 1536 + 8 * j8); P.ca = *(const v4u*)(cur + 1600 + 8 * j8); P.pa = *(const v4u*)(prv + 1600 + 8 * j8);
    P.cg0 = *(const v4u*)(cur + 1664 + 16 * j8); P.pg0 = *(const v4u*)(prv + 1664 + 16 * j8); P.cg1 = *(const v4u*)(cur + 1672 + 16 * j8); P.pg1 = *(const v4u*)(prv + 1672 + 16 * j8);
}
__device__ __forceinline__ void rwkv_chunk_unit(Frame& F, int u, const RaPre& P, int un, RaPre& Pn, int uprev, DecCtx& D, DecS& DA) {
    const int tid = tid_fresh(), lane = tid & 63, wave = __builtin_amdgcn_readfirstlane(tid >> 6), l15 = lane & 15, kg = lane >> 4;
    const int bh = u / NCH, c = u - bh * NCH, b = bh >> 3, h = bh & 7;
    const int dc0 = D.c; const bool dgo = dc0 + 4 <= DLIM; DecS DB;
    LAS unsigned char* L = F.lds + RING_OFF;
    const int t = tid >> 3, j8 = tid & 7;
    const int row = chunk_row(b, c, t);
    const float* mu = INP(I_MU);
    const int r0 = 16 * (wave >> 1), cb = 32 * (wave & 1);
    float vr[8], vk2[8], vv[8], vkk[8], vb[8];
    if (row >= 0) {
        const int n0 = h * 64 + 8 * j8;
        const bf16* UR = (const bf16*)(F.ws + WS_UR); const bf16* cur = UR + (size_t)row * DSHIFT; const bf16* prv = prev_row(F, UR, row);
        const F8 cr = ld8b(cur + n0), pr = ld8b(prv + n0), mr = ld8(mu + n0), ck = ld8b(cur + 512 + n0), pk = ld8b(prv + 512 + n0), mk = ld8(mu + 512 + n0), cv = ld8b(cur + 1024 + n0), pv = ld8b(prv + 1024 + n0), mv = ld8(mu + 1024 + n0);
#pragma unroll
        for (int e = 0; e < 8; ++e) { const float ur = f8g(cr, e), uk = f8g(ck, e), uv = f8g(cv, e);
            vr[e] = ur + f8g(mr, e) * (f8g(pr, e) - ur); vk2[e] = uk + f8g(mk, e) * (f8g(pk, e) - uk); vv[e] = uv + f8g(mv, e) * (f8g(pv, e) - uv); }
    }
    LBAR();
    {
        float aw[8], aa[8], ag[16];
        if (row >= 0) {
            const F8 cw = unb(P.cw), pw = unb(P.pw), mw = ld8(mu + 1536 + 8 * j8);
            const F8 ca = unb(P.ca), pa = unb(P.pa), ma = ld8(mu + 1600 + 8 * j8);
#pragma unroll
            for (int e = 0; e < 8; ++e) { const float x = f8g(cw, e), y = f8g(ca, e); aw[e] = 2.0f * fsig(2.0f * (x + f8g(mw, e) * (f8g(pw, e) - x))) - 1.0f; aa[e] = y + f8g(ma, e) * (f8g(pa, e) - y); }
#pragma unroll
            for (int hh = 0; hh < 2; ++hh) { const F8 cg = unb(hh ? P.cg1 : P.cg0), pg = unb(hh ? P.pg1 : P.pg0), mg = ld8(mu + 1664 + 16 * j8 + 8 * hh);
#pragma unroll
                for (int e = 0; e < 8; ++e) { const float x = f8g(cg, e); ag[8 * hh + e] = fsig(x + f8g(mg, e) * (f8g(pg, e) - x)); } }
        } else {
#pragma unroll
            for (int e = 0; e < 8; ++e) { aw[e] = 0.f; aa[e] = 0.f; ag[e] = 0.f; ag[8 + e] = 0.f; }
        }
        v4u w; w.x = pk2(aw[0], aw[1]); w.y = pk2(aw[2], aw[3]); w.z = pk2(aw[4], aw[5]); w.w = pk2(aw[6], aw[7]);
        *(LAS v4u*)(L + RA_ACTW + (t * TPB + 8 * j8) * 2) = w;
        w.x = pk2(aa[0], aa[1]); w.y = pk2(aa[2], aa[3]); w.z = pk2(aa[4], aa[5]); w.w = pk2(aa[6], aa[7]);
        *(LAS v4u*)(L + RA_ACTA + (t * TPB + 8 * j8) * 2) = w;
        w.x = pk2(ag[0], ag[1]); w.y = pk2(ag[2], ag[3]); w.z = pk2(ag[4], ag[5]); w.w = pk2(ag[6], ag[7]);
        *(LAS v4u*)(L + RA_ACTG + (t * GP + 16 * j8) * 2) = w;
        w.x = pk2(ag[8], ag[9]); w.y = pk2(ag[10], ag[11]); w.z = pk2(ag[12], ag[13]); w.w = pk2(ag[14], ag[15]);
        *(LAS v4u*)(L + RA_ACTG + (t * GP + 16 * j8 + 8) * 2) = w;
    }
    LBAR();
    {
        const bf16* WdT = (const bf16*)(F.ws + WS_WDT) + (size_t)h * 64 * 64; const bf16* WaT = (const bf16*)(F.ws + WS_WAT) + (size_t)h * 64 * 64; const bf16* WgT = (const bf16*)(F.ws + WS_WGT) + (size_t)h * 64 * 128;
#pragma unroll
        for (int q = 0; q < 2; ++q) { const int c0 = cb + 16 * q; f32x4 xw = {0.f, 0.f, 0.f, 0.f}, xa = xw, xg = xw;
#pragma unroll
            for (int k0 = 0; k0 < 64; k0 += 32) { MMA16(xw, FRAG_G(WdT, 64, c0 + l15, k0 + 8 * kg), FRAG_L(L + RA_ACTW, TPB, r0 + l15, k0 + 8 * kg));
                                                  MMA16(xa, FRAG_G(WaT, 64, c0 + l15, k0 + 8 * kg), FRAG_L(L + RA_ACTA, TPB, r0 + l15, k0 + 8 * kg)); }
#pragma unroll
            for (int k0 = 0; k0 < 128; k0 += 32) MMA16(xg, FRAG_G(WgT, 128, c0 + l15, k0 + 8 * kg), FRAG_L(L + RA_ACTG, GP, r0 + l15, k0 + 8 * kg));
            const int o = ((r0 + l15) * FP + c0 + 4 * kg) * 4;
            *(LAS f32x4*)(L + RA_WLF + o) = xw; *(LAS f32x4*)(L + RA_ALF + o) = xa; *(LAS f32x4*)(L + RA_GLF + o) = xg; }
    }
    LBAR();
    asm volatile("s_waitcnt vmcnt(0)" ::: "memory");
    {
        const int n0 = h * 64 + 8 * j8;
        float wv[8], g1[8], g2[8];
        if (row >= 0) {
            const F8 w0 = ld8(INP(I_W0) + n0), a0 = ld8(INP(I_A0) + n0), kkc = ld8(INP(I_KK) + n0), kac = ld8(INP(I_KA) + n0), rkc = ld8(INP(I_RK) + n0), lw = ld8(INP(I_LNW) + n0), lb = ld8(INP(I_LNB) + n0);
            const F8 wl = ld8l((const LAS float*)(L + RA_WLF) + t * FP + 8 * j8), al_ = ld8l((const LAS float*)(L + RA_ALF) + t * FP + 8 * j8), gl = ld8l((const LAS float*)(L + RA_GLF) + t * FP + 8 * j8);
            float nrm = 0.f, bs = 0.f, av[8], gv[8];
#pragma unroll
            for (int e = 0; e < 8; ++e) {
                const float r = vr[e], k = vk2[e], v = vv[e];
                const float x = f8g(w0, e) + f8g(wl, e);
                wv[e] = __builtin_amdgcn_exp2f(-(0.60653066f * LOG2E) * fsig(x));
                const float a = fsig(f8g(a0, e) + f8g(al_, e));
                const float kr = k * f8g(kkc, e), k2 = k * (1.0f + (a - 1.0f) * f8g(kac, e));
                nrm += kr * kr; bs += r * k2 * f8g(rkc, e);
                vr[e] = r; vk2[e] = k2; vv[e] = v; vkk[e] = kr; av[e] = a; gv[e] = f8g(gl, e);
            }
            nrm += __shfl_xor(nrm, 1); nrm += __shfl_xor(nrm, 2); nrm += __shfl_xor(nrm, 4);
            bs += __shfl_xor(bs, 1); bs += __shfl_xor(bs, 2); bs += __shfl_xor(bs, 4);
            const float rn = __builtin_amdgcn_rsqf(fmaxf(nrm, 1e-24f));
#pragma unroll
            for (int e = 0; e < 8; ++e) { vkk[e] *= rn; vb[e] = vkk[e] * av[e]; g1[e] = f8g(lw, e) * gv[e]; g2[e] = (f8g(lb, e) + bs * vv[e]) * gv[e]; }
        } else {
#pragma unroll
            for (int e = 0; e < 8; ++e) { vr[e] = 0.f; vk2[e] = 0.f; vv[e] = 0.f; vkk[e] = 0.f; vb[e] = 0.f; wv[e] = 1.0f; g1[e] = 0.f; g2[e] = 0.f; }
        }
        LAS float* gm = (LAS float*)(L + RA_GAM) + t * FP + 8 * j8;
        *(LAS f32x4*)gm = (f32x4){wv[0], wv[1], wv[2], wv[3]}; *(LAS f32x4*)(gm + 4) = (f32x4){wv[4], wv[5], wv[6], wv[7]};
        *(v4u*)((bf16*)(F.ws + WS_G1G) + (size_t)u * UE + t * 64 + 8 * j8) = pk8(g1); *(v4u*)((bf16*)(F.ws + WS_G2G) + (size_t)u * UE + t * 64 + 8 * j8) = pk8(g2);
    }
    LBAR();
    if (dgo) { decs_load(F, DB, D, dc0 + 1, wave, lane); decs_use(DA, D, lane); decs_load(F, DA, D, dc0 + 2, wave, lane); }
    if (uprev >= 0 && tid == 0) __hip_atomic_store(F.ctl + CW_FLAG + 16 * uprev, 1u, __ATOMIC_RELAXED, __HIP_MEMORY_SCOPE_AGENT);
    {
        const int n = tid & 63, seg = tid >> 6; LAS float* G = (LAS float*)(L + RA_GAM); LAS float* SG = (LAS float*)(L + RA_SEG);
        float p = 1.0f, loc[8];
#pragma unroll
        for (int i = 0; i < 8; ++i) { p *= G[(8 * seg + i) * FP + n]; loc[i] = p; }
        SG[seg * 64 + n] = p;
        LBAR();
        float pre = 1.0f;
        for (int s = 0; s < seg; ++s) pre *= SG[s * 64 + n];
#pragma unroll
        for (int i = 0; i < 8; ++i) G[(8 * seg + i) * FP + n] = loc[i] * pre;
        if (seg == 7) ((LAS float*)(L + RA_GC))[n] = loc[7] * pre;
    }
    LBAR();
    {
        const LAS float* G = (const LAS float*)(L + RA_GAM);
        const F8 gt = ld8l(G + t * FP + 8 * j8), gc = ld8l((const LAS float*)(L + RA_GC) + 8 * j8);
        F8 gp; if (t > 0) gp = ld8l(G + (t - 1) * FP + 8 * j8); else { gp.a = (f32x4){1.f, 1.f, 1.f, 1.f}; gp.b = gp.a; }
        float xkk[8], xbb[8], xkt[8], xrt[8], xke[8], xbe[8];
#pragma unroll
        for (int e = 0; e < 8; ++e) { const float g = f8g(gt, e), rg = __builtin_amdgcn_rcpf(g), ce = f8g(gc, e) * rg;
            xkk[e] = vkk[e] * f8g(gp, e); xbb[e] = vb[e] * rg; xkt[e] = vk2[e] * rg; xrt[e] = vr[e] * g; xke[e] = vk2[e] * ce; xbe[e] = vb[e] * ce; }
        const int o = (t * TPB + 8 * j8) * 2;
        *(LAS v4u*)(L + RA_KK + o) = pk8(xkk); *(LAS v4u*)(L + RA_BB + o) = pk8(xbb); *(LAS v4u*)(L + RA_KT + o) = pk8(xkt); *(LAS v4u*)(L + RA_RT + o) = pk8(xrt);
        *(LAS v4u*)(L + RA_AB + o) = pk8(xke); *(LAS v4u*)(L + RA_BM + o) = pk8(xbe); *(LAS v4u*)(L + RA_ARK + o) = pk8(vv);
    }
    LBAR();
    if (un < NUNIT) ra_prefetch(F, un, Pn);
    {
        const int n = tid & 63, t8 = tid >> 6;
#pragma unroll
        for (int q = 0; q < 3; ++q) { const LAS unsigned short* src = (const LAS unsigned short*)(L + (q == 0 ? RA_AB : q == 1 ? RA_BM : RA_ARK)) + (8 * t8) * TPB + n;
            v4u w; w.x = (unsigned)src[0] | ((unsigned)src[TPB] << 16); w.y = (unsigned)src[2 * TPB] | ((unsigned)src[3 * TPB] << 16); w.z = (unsigned)src[4 * TPB] | ((unsigned)src[5 * TPB] << 16); w.w = (unsigned)src[6 * TPB] | ((unsigned)src[7 * TPB] << 16);
            *(LAS v4u*)(L + (q == 0 ? RA_KET : q == 1 ? RA_BET : RA_VMT) + (n * TPB + 8 * t8) * 2) = w; }
    }
    LBAR();
#pragma unroll
    for (int q = 0; q < 2; ++q) { const int c0 = cb + 16 * q, tt = r0 + l15, i0 = c0 + 4 * kg; const f32x4 z = {0.f, 0.f, 0.f, 0.f};
        f32x4 a = prod_ll(L + RA_KK, L + RA_BB, r0, c0, l15, kg, z), bm = prod_ll(L + RA_KK, L + RA_KT, r0, c0, l15, kg, z),
              rk = prod_ll(L + RA_RT, L + RA_KT, r0, c0, l15, kg, z), rb = prod_ll(L + RA_RT, L + RA_BB, r0, c0, l15, kg, z);
#pragma unroll
        for (int e = 0; e < 4; ++e) { const bool st = (i0 + e) < tt, le = (i0 + e) <= tt; a[e] = st ? a[e] : 0.f; bm[e] = st ? bm[e] : 0.f; rk[e] = le ? rk[e] : 0.f; rb[e] = le ? rb[e] : 0.f; }
        const int o = (tt * TPB + i0) * 2;
        *(LAS v2u*)(L + RA_AB + o) = pk4(a); *(LAS v2u*)(L + RA_BM + o) = pk4(bm); *(LAS v2u*)(L + RA_ARK + o) = pk4(rk); *(LAS v2u*)(L + RA_ARB + o) = pk4(rb);
        if (c0 == r0) *(LAS f32x4*)(L + RA_DIAG + (((r0 >> 4) * 16 + l15) * 16 + 4 * kg) * 4) = a;
    }
    for (int i = tid; i < 128 * TPB * 2 / 16; i += NTHR) *(LAS v4u*)(L + RA_XT + i * 16) = (v4u){0u, 0u, 0u, 0u};
    if (dgo) { decs_use(DB, D, lane); decs_load(F, DB, D, dc0 + 3, wave, lane); }
    LBAR();
#pragma unroll
    for (int q = 0; q < 2; ++q) { const int c0 = cb + 16 * q; const f32x4 bv = prod_ll(L + RA_BM, L + RA_VMT, r0, c0, l15, kg, (f32x4){0.f, 0.f, 0.f, 0.f});
        *(LAS f32x4*)(L + RA_BVF + ((r0 + l15) * FP + c0 + 4 * kg) * 4) = bv; }
    LBAR();
    if (wave < 4 && lane < 16) { const LAS float* Dg = (const LAS float*)(L + RA_DIAG) + wave * 256; float x[16];
#pragma unroll
        for (int i = 0; i < 16; ++i) { float s = (i == lane) ? 1.0f : 0.0f;
#pragma unroll
            for (int jj = 0; jj < i; ++jj) s -= Dg[i * 16 + jj] * x[jj];
            x[i] = s; }
#pragma unroll
        for (int i = 0; i < 16; ++i) { LAS unsigned short* tp = (LAS unsigned short*)(L + RA_BM) + (wave * 16 + i) * 32; tp[lane] = (unsigned short)f2bf(x[i]); tp[16 + lane] = 0; } }
    for (int i = tid; i < 128 * 32 * 2 / 16; i += NTHR) *(LAS v4u*)(L + RA_ZS + i * 16) = (v4u){0u, 0u, 0u, 0u};
    if (dgo) { decs_use(DA, D, lane); if (dc0 + 4 < DLIM) decs_load(F, DA, D, dc0 + 4, wave, lane); }
    LBAR();
    for (int p = 0; p < 4; ++p) {
        const int c0 = 16 * wave, tt = 16 * p + l15, cc = c0 + 4 * kg; f32x4 acc = {0.f, 0.f, 0.f, 0.f};
        if (p >= 1) MMA16(acc, FRAG_L(L + RA_XT, TPB, c0 + l15, 8 * kg), FRAG_L(L + RA_AB, TPB, tt, 8 * kg));
        if (p == 3) MMA16(acc, FRAG_L(L + RA_XT, TPB, c0 + l15, 32 + 8 * kg), FRAG_L(L + RA_AB, TPB, tt, 32 + 8 * kg));
        f32x4 rhs; if (wave < 4) rhs = unpk4(*(const LAS v2u*)(L + RA_KK + (tt * TPB + cc) * 2)); else rhs = *(const LAS f32x4*)(L + RA_BVF + (tt * FP + cc - 64) * 4);
        const f32x4 zv = rhs - acc; LAS unsigned short* ZT = (LAS unsigned short*)(L + RA_ZS);
#pragma unroll
        for (int e = 0; e < 4; ++e) ZT[(cc + e) * 32 + l15] = (unsigned short)f2bf(zv[e]);
        asm volatile("s_waitcnt lgkmcnt(0)" ::: "memory");
        f32x4 xa = {0.f, 0.f, 0.f, 0.f};
        MMA16(xa, FRAG_L(L + RA_ZS, 32, c0 + l15, 8 * kg), FRAG_L(L + RA_BM, 32, 16 * p + l15, 8 * kg));
        LAS unsigned short* XTs = (LAS unsigned short*)(L + RA_XT);
#pragma unroll
        for (int e = 0; e < 4; ++e) XTs[(cc + e) * TPB + 16 * p + l15] = (unsigned short)f2bf(xa[e]);
        asm volatile("s_waitcnt lgkmcnt(0)" ::: "memory");
    }
    if (dgo) { decs_use(DB, D, lane); D.c = dc0 + 4; }
    LBAR();
    {
        bf16* W2g = (bf16*)(F.ws + WS_W2G) + (size_t)u * UE; bf16* YLg = (bf16*)(F.ws + WS_YLG) + (size_t)u * UE; float* SLg = (float*)(F.ws + WS_SLG) + (size_t)u * UE;
        bf16* MTh = (bf16*)(F.ws + WS_MTH) + (size_t)u * UE; bf16* MTl = (bf16*)(F.ws + WS_MTL) + (size_t)u * UE;
        const LAS unsigned char* W1T = L + RA_XT; const LAS unsigned char* ULT = L + RA_XT + 64 * TPB * 2;
#pragma unroll
        for (int q = 0; q < 2; ++q) { const int c0 = cb + 16 * q, rr = r0 + l15, cc = c0 + 4 * kg; const f32x4 z = {0.f, 0.f, 0.f, 0.f};
            const f32x4 aw = prod_ll(L + RA_ARB, W1T, r0, c0, l15, kg, z);
            const f32x4 w2 = unpk4(*(const LAS v2u*)(L + RA_RT + (rr * TPB + cc) * 2)) - aw;
            *(v2u*)(W2g + rr * 64 + cc) = pk4(w2);
            const f32x4 yl = prod_ll(L + RA_ARK, L + RA_VMT, r0, c0, l15, kg, z) - prod_ll(L + RA_ARB, ULT, r0, c0, l15, kg, z);
            *(v2u*)(YLg + ((wave * 2 + q) * 64 + lane) * 4) = pk4(yl);
            f32x4 mt = prod_ll(L + RA_BET, W1T, r0, c0, l15, kg, z); const float gcv = ((const LAS float*)(L + RA_GC))[rr];
#pragma unroll
            for (int e = 0; e < 4; ++e) mt[e] = ((cc + e) == rr ? gcv : 0.f) - mt[e];
            const v2u mh = pk4(mt); const f32x4 mres = mt - unpk4(mh);
            { const v2u ml = pk4(mres);
              __hip_atomic_store((unsigned long long*)(MTh + rr * 64 + cc), (unsigned long long)mh.x | ((unsigned long long)mh.y << 32), __ATOMIC_RELAXED, __HIP_MEMORY_SCOPE_AGENT);
              __hip_atomic_store((unsigned long long*)(MTl + rr * 64 + cc), (unsigned long long)ml.x | ((unsigned long long)ml.y << 32), __ATOMIC_RELAXED, __HIP_MEMORY_SCOPE_AGENT); }
            const f32x4 sl = prod_ll(L + RA_VMT, L + RA_KET, r0, c0, l15, kg, z) - prod_ll(ULT, L + RA_BET, r0, c0, l15, kg, z);
            { unsigned long long* sp_ = (unsigned long long*)(SLg + ((wave * 2 + q) * 64 + lane) * 4);
              __hip_atomic_store(sp_, (unsigned long long)__float_as_uint(sl[0]) | ((unsigned long long)__float_as_uint(sl[1]) << 32), __ATOMIC_RELAXED, __HIP_MEMORY_SCOPE_AGENT);
              __hip_atomic_store(sp_ + 1, (unsigned long long)__float_as_uint(sl[2]) | ((unsigned long long)__float_as_uint(sl[3]) << 32), __ATOMIC_RELAXED, __HIP_MEMORY_SCOPE_AGENT); } }
    }
}

constexpr int RB_DEPTH = 4, RB_MT0 = 36864, RB_MTS = 18432;
struct RbSet { v4u mh, ml; f32x4 sl[2]; };
__device__ __forceinline__ void rwkv_chain(Frame& F, int bh) {
    const int tid = tid_fresh(), lane = tid & 63, wave = __builtin_amdgcn_readfirstlane(tid >> 6), l15 = lane & 15, kg = lane >> 4;
    const int r0 = 16 * (wave >> 1), cb = 32 * (wave & 1);
    const int mrow = 8 * wave + (lane >> 3), mpc = lane & 7;
    LAS unsigned char* L = F.lds + RING_OFF;
    bf16* S0g = (bf16*)(F.ws + WS_S0G);
    const bf16* MTh = (const bf16*)(F.ws + WS_MTH); const bf16* MTl = (const bf16*)(F.ws + WS_MTL); const float* SLg = (const float*)(F.ws + WS_SLG);
    __syncthreads();
    for (int i = tid; i < 4 * 9216 / 16; i += NTHR) *(LAS v4u*)(L + i * 16) = (v4u){0u, 0u, 0u, 0u};
    for (int i = tid; i < 4096 / 8; i += NTHR) *(v4u*)(S0g + (size_t)(bh * NCH) * UE + i * 8) = (v4u){0u, 0u, 0u, 0u};
    RbSet R[RB_DEPTH];
#define RB_WAITN(first, n) do { const int cc_ = (first) + (lane & 7); gu32* fl_ = F.ctl + CW_FLAG + 16 * (bh * NCH + (cc_ < NCH ? cc_ : NCH - 1)); unsigned sp_ = 0u; \
        for (;;) { const unsigned v_ = ((lane & 7) < (n) && cc_ < NCH) ? __hip_atomic_load(fl_, __ATOMIC_RELAXED, __HIP_MEMORY_SCOPE_AGENT) : 1u; if (__all(v_ != 0u)) break; __builtin_amdgcn_s_sleep(2); if (++sp_ > (1u << 20)) break; } \
        __builtin_amdgcn_fence(__ATOMIC_ACQUIRE, "agent"); } while (0)
#define RB_LOAD(S, uu) do { S.mh = *(const v4u*)(MTh + (size_t)(uu) * UE + mrow * 64 + mpc * 8); S.ml = *(const v4u*)(MTl + (size_t)(uu) * UE + mrow * 64 + mpc * 8); \
        _Pragma("unroll") for (int q = 0; q < 2; ++q) S.sl[q] = *(const f32x4*)(SLg + (size_t)(uu) * UE + ((wave * 2 + q) * 64 + lane) * 4); } while (0)
#define RB_PUT(S, slot) do { LAS unsigned char* d_ = L + RB_MT0 + (slot) * RB_MTS + (mrow * TPB + mpc * 8) * 2; *(LAS v4u*)d_ = S.mh; *(LAS v4u*)(d_ + 9216) = S.ml; } while (0)
    RB_WAITN(0, RB_DEPTH);
#pragma unroll
    for (int d = 0; d < RB_DEPTH; ++d) RB_LOAD(R[d], bh * NCH + d);
    RB_PUT(R[0], 0);
    __syncthreads();
#define RB_STEP(S, SN, c) do { const int u = bh * NCH + (c), cur = (c) & 1, nxt = cur ^ 1; \
        const LAS unsigned char* SH = L + cur * 18432; const LAS unsigned char* SL = SH + 9216; const LAS unsigned char* MH = L + RB_MT0 + cur * RB_MTS; const LAS unsigned char* ML = MH + 9216; f32x4 acc[2]; \
        _Pragma("unroll") for (int q = 0; q < 2; ++q) { const int c0 = cb + 16 * q; acc[q] = S.sl[q]; \
            _Pragma("unroll") for (int kk = 0; kk < 2; ++kk) { const bf16x8 bh_ = FRAG_L(SH, TPB, r0 + l15, 32 * kk + 8 * kg), bl_ = FRAG_L(SL, TPB, r0 + l15, 32 * kk + 8 * kg); \
                const bf16x8 ah_ = FRAG_L(MH, TPB, c0 + l15, 32 * kk + 8 * kg), al_ = FRAG_L(ML, TPB, c0 + l15, 32 * kk + 8 * kg); \
                MMA16(acc[q], al_, bh_); MMA16(acc[q], ah_, bl_); MMA16(acc[q], ah_, bh_); } } \
        if ((c) + 1 < NCH) RB_PUT(SN, nxt);                         \
        if ((c) + RB_DEPTH < NCH) RB_LOAD(S, u + RB_DEPTH); \
        _Pragma("unroll") for (int q = 0; q < 2; ++q) { const int rr = r0 + l15, cc = cb + 16 * q + 4 * kg; \
            const v2u hi = pk4(acc[q]); const f32x4 res = acc[q] - unpk4(hi); \
            *(LAS v2u*)(L + nxt * 18432 + (rr * TPB + cc) * 2) = hi; *(LAS v2u*)(L + nxt * 18432 + 9216 + (rr * TPB + cc) * 2) = pk4(res); \
            if ((c) + 1 < NCH) *(v2u*)(S0g + (size_t)(u + 1) * UE + rr * 64 + cc) = hi; \
            else *(f32x4*)(F.out + O_WKVP + ((size_t)(bh * 64 + rr) * 64 + cc)) = acc[q]; } \
        asm volatile("s_waitcnt lgkmcnt(0)\n\ts_barrier" ::: "memory"); } while (0)
    int c = 0;
    for (; c + RB_DEPTH <= NCH; c += RB_DEPTH) { if ((c & 7) == 0) RB_WAITN(c + RB_DEPTH, 8);
        RB_STEP(R[0], R[1], c); RB_STEP(R[1], R[2], c + 1); RB_STEP(R[2], R[3], c + 2); RB_STEP(R[3], R[0], c + 3); }
    if (c < NCH) { RB_STEP(R[0], R[1], c); ++c; }
    if (c < NCH) { RB_STEP(R[1], R[2], c); ++c; }
    if (c < NCH) { RB_STEP(R[2], R[3], c); ++c; }
    asm volatile("s_waitcnt vmcnt(0)" ::: "memory");
    __syncthreads();
#undef RB_LOAD
#undef RB_PUT
#undef RB_WAITN
#undef RB_STEP
}

struct RcPre { bf16x8 s0[2][2], w2[2]; v2u yl[2]; v4u g1, g2; };
__device__ __forceinline__ void rc_prefetch(Frame& F, int u, RcPre& P) {
    const int tid = tid_fresh(), lane = tid & 63, wave = __builtin_amdgcn_readfirstlane(tid >> 6), l15 = lane & 15, kg = lane >> 4;
    const int r0 = 16 * (wave >> 1), cb = 32 * (wave & 1), t = tid >> 3, j8 = tid & 7;
    const bf16* W2g = (const bf16*)(F.ws + WS_W2G) + (size_t)u * UE; const bf16* S0g = (const bf16*)(F.ws + WS_S0G) + (size_t)u * UE; const bf16* YLg = (const bf16*)(F.ws + WS_YLG) + (size_t)u * UE;
#pragma unroll
    for (int kk = 0; kk < 2; ++kk) { P.w2[kk] = FRAG_G(W2g, 64, r0 + l15, 32 * kk + 8 * kg);
#pragma unroll
        for (int q = 0; q < 2; ++q) P.s0[q][kk] = FRAG_G(S0g, 64, cb + 16 * q + l15, 32 * kk + 8 * kg); }
#pragma unroll
    for (int q = 0; q < 2; ++q) P.yl[q] = *(const v2u*)(YLg + ((wave * 2 + q) * 64 + lane) * 4);
    P.g1 = *(const v4u*)((const bf16*)(F.ws + WS_G1G) + (size_t)u * UE + t * 64 + 8 * j8); P.g2 = *(const v4u*)((const bf16*)(F.ws + WS_G2G) + (size_t)u * UE + t * 64 + 8 * j8);
}
__device__ __forceinline__ void rwkv_fix_unit(Frame& F, int u, const RcPre& P, int un, RcPre& Pn) {
    const int tid = tid_fresh(), lane = tid & 63, wave = __builtin_amdgcn_readfirstlane(tid >> 6), l15 = lane & 15, kg = lane >> 4;
    const int bh = u / NCH, c = u - bh * NCH, b = bh >> 3, h = bh & 7;
    const int r0 = 16 * (wave >> 1), cb = 32 * (wave & 1);
    LAS unsigned char* L = F.lds + RING_OFF;
    LBAR();
#pragma unroll
    for (int q = 0; q < 2; ++q) { const int c0 = cb + 16 * q; f32x4 acc = unpk4(P.yl[q]);
#pragma unroll
        for (int kk = 0; kk < 2; ++kk) MMA16(acc, P.s0[q][kk], P.w2[kk]);
        *(LAS f32x4*)(L + ((r0 + l15) * FP + c0 + 4 * kg) * 4) = acc; }
    const F8 g1 = unb(P.g1), g2 = unb(P.g2);
    if (un < NUNIT) rc_prefetch(F, un, Pn);
    LBAR();
    const int t = tid >> 3, j8 = tid & 7, row = chunk_row(b, c, t);
    const F8 y = ld8l((const LAS float*)L + t * FP + 8 * j8);
    float s = 0.f;
#pragma unroll
    for (int e = 0; e < 8; ++e) s += f8g(y, e);
    s += __shfl_xor(s, 1); s += __shfl_xor(s, 2); s += __shfl_xor(s, 4);
    const float mu = s * (1.f / 64.f); float q2 = 0.f;
#pragma unroll
    for (int e = 0; e < 8; ++e) { const float d = f8g(y, e) - mu; q2 += d * d; }
    q2 += __shfl_xor(q2, 1); q2 += __shfl_xor(q2, 2); q2 += __shfl_xor(q2, 4);
    const float rstd = 1.0f / sqrtf(q2 * (1.f / 64.f) + GN_EPS);
    float o[8];
#pragma unroll
    for (int e = 0; e < 8; ++e) o[e] = (f8g(y, e) - mu) * rstd * f8g(g1, e) + f8g(g2, e);
    if (row >= 0) *(v4u*)((bf16*)(F.ws + WS_OC) + (size_t)row * 1024 + h * 64 + 8 * j8) = pk8(o);
}


template <class Epi> __device__ __forceinline__ void skinny_gemm(Frame& F, const bf16* A, int lda, const bf16* Bt, int ldb, int K, int cbk, const Epi& epi) {
    const int tid = tid_fresh(), lane = tid & 63, wave = __builtin_amdgcn_readfirstlane(tid >> 6), l15 = lane & 15, kg = lane >> 4;
    LAS unsigned char* L = F.lds + RING_OFF;
    const bf16* Ar = A + (size_t)(ROW_META + l15) * lda + 8 * kg; const bf16* Br = Bt + (size_t)(16 * cbk + l15) * ldb + 8 * kg;
    const int kw = K >> 3, kbeg = wave * kw;
    f32x4 acc[3] = {{0.f, 0.f, 0.f, 0.f}, {0.f, 0.f, 0.f, 0.f}, {0.f, 0.f, 0.f, 0.f}};
#pragma unroll 8
    for (int k0 = kbeg; k0 < kbeg + kw; k0 += 32) {
        const bf16x8 wf = *(const bf16x8*)(Br + k0);
#pragma unroll
        for (int mt = 0; mt < 3; ++mt) { const bf16x8 af = *(const bf16x8*)(Ar + (size_t)(16 * mt) * lda + k0); MMA16(acc[mt], wf, af); }
    }
    __syncthreads();
#pragma unroll
    for (int mt = 0; mt < 3; ++mt) *(LAS f32x4*)(L + ((wave * 3 + mt) * 64 + lane) * 16) = acc[mt];
    __syncthreads();
    if (tid < 192) { const int mt = tid >> 6, ln = tid & 63; f32x4 s = {0.f, 0.f, 0.f, 0.f};
#pragma unroll
        for (int w = 0; w < 8; ++w) s += *(const LAS f32x4*)(L + ((w * 3 + mt) * 64 + ln) * 16);
        epi(16 * mt + (ln & 15), 16 * cbk + 4 * (ln >> 4), s); }
    __syncthreads();
}
struct SkBrA { bf16* TMP; const bf16* GB; __device__ __forceinline__ void operator()(int r, int c, f32x4 v) const { const size_t row = ROW_META + r; const v2u g = *(const v2u*)(GB + row * DG + c);
    v2u w; w.x = pk2(v[0] * bflo(g.x), v[1] * bfhi(g.x)); w.y = pk2(v[2] * bflo(g.y), v[3] * bfhi(g.y)); *(v2u*)(TMP + row * 1024 + c) = w; } };
struct SkBrB { const bf16* TMP; const bf16* GB; bf16* MG; __device__ __forceinline__ void operator()(int r, int c, f32x4 v) const { const size_t row = ROW_META + r; const v2u g = *(const v2u*)(GB + row * DG + 1024 + c);
    const f32x4 t = unpk4(*(const v2u*)(TMP + row * 1024 + c)); v2u w; w.x = pk2(t[0] + v[0] * bflo(g.x), t[1] + v[1] * bfhi(g.x)); w.y = pk2(t[2] + v[2] * bflo(g.y), t[3] + v[3] * bfhi(g.y)); *(v2u*)(MG + row * 1024 + c) = w; } };
struct SkOut { bf16* XB; float* SS48; const float* xm; const float* xs; int cbk; __device__ __forceinline__ void operator()(int r, int c, f32x4 v) const { const size_t row = ROW_META + r;
    const float* x = r < NMETA ? xm + (size_t)r * 1024 : xs + (size_t)(r - NMETA) * 1024; v += *(const f32x4*)(x + c);
    float ssq = (v[0] * v[0] + v[1] * v[1]) + (v[2] * v[2] + v[3] * v[3]); ssq += __shfl_xor(ssq, 16); ssq += __shfl_xor(ssq, 32);
    if ((c & 15) == 0) SS48[r * 64 + cbk] = ssq;
    v2u w; w.x = pk2(v[0], v[1]); w.y = pk2(v[2], v[3]); *(v2u*)(XB + row * 1024 + c) = w; } };
struct SkUp { bf16* HF; const float* SS48; __device__ __forceinline__ void operator()(int r, int c, f32x4 v) const { const size_t row = ROW_META + r;
    const f32x4* sp = (const f32x4*)(SS48 + r * 64); f32x4 s4 = sp[0];
#pragma unroll
    for (int i = 1; i < 16; ++i) s4 += sp[i];
    const float rstd = __builtin_amdgcn_rsqf(((s4[0] + s4[1]) + (s4[2] + s4[3])) * (1.f / 1024.f) + RMS_EPS);
    v = __builtin_elementwise_max(v * rstd, (f32x4){0.f, 0.f, 0.f, 0.f}); v = v * v;
    v2u w; w.x = pk2(v[0], v[1]); w.y = pk2(v[2], v[3]); *(v2u*)(HF + row * FF + c) = w; } };
struct SkDown { bf16* XB; __device__ __forceinline__ void operator()(int r, int c, f32x4 v) const { const size_t row = ROW_META + r; v += unpk4(*(const v2u*)(XB + row * 1024 + c));
    v2u w; w.x = pk2(v[0], v[1]); w.y = pk2(v[2], v[3]); *(v2u*)(XB + row * 1024 + c) = w; } };

__global__ void __launch_bounds__(NTHR, 2) fwd_kernel(Args args) {
    extern __shared__ __attribute__((aligned(16))) unsigned char lds[];
    Frame F;
    F.lds = (LAS unsigned char*)lds;
    F.MISC = (volatile LAS unsigned*)(F.lds + MISC_OFF);
    F.G = gridDim.x; { const int bx = blockIdx.x; F.vcu = (F.G % 8 == 0) ? (bx % 8) * (F.G / 8) + bx / 8 : bx; }
    F.ws = args.ws; F.out = args.out; F.ctl = (gu32*)(args.ws + WS_CTL);
#pragma unroll
    for (int i = 0; i < 30; ++i) F.in[i] = args.in[i];
    for (int u = threadIdx.x; u < (LDS_BYTES - LDSCTL_OFF) / 4; u += NTHR) ((LAS unsigned*)(F.lds + LDSCTL_OFF))[u] = 0u;
    __syncthreads();
    XcdBarrier bar = xcd_barrier_post((unsigned*)(F.ctl + CW_BAR), F.MISC + 8);
    unsigned char* ws = args.ws;
    using namespace pg8;

    p0_prologue(F);
    xcd_barrier(bar);

    if ((int)blockIdx.x >= (int)gridDim.x - 16) p1_cumsum(F, (int)blockIdx.x - ((int)gridDim.x - 16));
    {
        Gemm g{(const bf16_t*)(ws + WS_HN), (const bf16_t*)(ws + WS_WIN), M_PAD, N1, 1024, 1024}; StaticOrder S; S.init(M_PAD, N1, F.G, (int)blockIdx.x);
        EpiIn E{(bf16_t*)(ws + WS_UR), (bf16_t*)(ws + WS_QB), (bf16_t*)(ws + WS_KB), (bf16_t*)(ws + WS_VB), (bf16_t*)(ws + WS_GB), (float*)(ws + WS_QS), F.out};
        gemm_phase<EpiIn, StaticOrder, PG8_ALIGN, PG8_SP2>(F.lds + RING_OFF, g, S, E);
    }
    xcd_barrier(bar);

    {
        const int rank = F.vcu, NW_ = F.G;
#define RA_UNIT(i) (((i) & 15) * NCH + ((i) >> 4))
        RaPre PA, PB; int it = rank;
        DecCtx D; DecS DA;
        const int dlane = (int)threadIdx.x & 63, dwave = __builtin_amdgcn_readfirstlane((int)threadIdx.x >> 6); const bool ditem = F.vcu < NSAMP * NSPLIT;
        { const int bt = ditem ? F.vcu >> 3 : 0, sp = F.vcu & 7;
          D.q4 = *(const f32x4*)((const float*)(ws + WS_QS) + (size_t)bt * 512 + dwave * 64 + 4 * (dlane & 15)) * 0.125f; D.o4 = (f32x4){0.f, 0.f, 0.f, 0.f}; D.m = -1e30f; D.l = 0.f; D.csum = 0.f;
          D.pgv = ((const int*)INP(I_PT))[bt * NPAGES + sp * 8 + (dlane & 7)]; D.c = ditem ? 0 : DLIM;
          decs_load(F, DA, D, 0, dwave, dlane); }
        if (it < NUNIT) ra_prefetch(F, RA_UNIT(it), PA);
        int ulast = -1;
        for (; it < NUNIT; it += 2 * NW_) { rwkv_chunk_unit(F, RA_UNIT(it), PA, it + NW_ < NUNIT ? RA_UNIT(it + NW_) : NUNIT, PB, ulast, D, DA); ulast = RA_UNIT(it);
            if (it + NW_ < NUNIT) { rwkv_chunk_unit(F, RA_UNIT(it + NW_), PB, it + 2 * NW_ < NUNIT ? RA_UNIT(it + 2 * NW_) : NUNIT, PA, ulast, D, DA); ulast = RA_UNIT(it + NW_); } }
#undef RA_UNIT
        {
            while (D.c < DLIM) { decs_use(DA, D, dlane); if (D.c + 1 < DLIM) decs_load(F, DA, D, D.c + 1, dwave, dlane); D.c += 1; }
            if (ditem) { float* PART = (float*)(ws + WS_PART) + (size_t)(F.vcu * NH + dwave) * PART_STRIDE; f32x4 o4 = D.o4;
#pragma unroll
                for (int e = 0; e < 4; ++e) { float t = o4[e]; t += __shfl_xor(t, 16); t += __shfl_xor(t, 32); o4[e] = t; }
                if ((dlane >> 4) == 0) *(f32x4*)(PART + 16 + 4 * (dlane & 15)) = o4;
                if (dlane == 0) { PART[0] = D.m; PART[1] = D.l; PART[2] = D.csum; } }
        }
        asm volatile("s_waitcnt vmcnt(0)" ::: "memory"); __syncthreads();
        if (ulast >= 0 && threadIdx.x == 0) __hip_atomic_store(F.ctl + CW_FLAG + 16 * ulast, 1u, __ATOMIC_RELAXED, __HIP_MEMORY_SCOPE_AGENT);
        if (F.vcu == 1 || F.vcu == 2) { __syncthreads(); p2_prep(F, ROW_SAMP / 16 + F.vcu - 1); }
        if ((F.vcu & 15) == 0) { __syncthreads(); rwkv_chain(F, F.vcu >> 4); }
    }
    __syncthreads();
    if (F.vcu == F.G - 1) p2_meta_attn(F);
    __syncthreads();
    {
        const attn_body::bf16* Qp = (const attn_body::bf16*)(ws + WS_QB); const attn_body::bf16* Kp = (const attn_body::bf16*)(ws + WS_KB); const attn_body::bf16* Vp = (const attn_body::bf16*)(ws + WS_VB);
        attn_body::bf16* Op = (attn_body::bf16*)(ws + WS_OC); const float* NCLp = (const float*)(ws + WS_NCL);
        const int x0 = (int)(xb_xcc_id() & 7u);
        if (threadIdx.x == 0) F.MISC[1] = 0u;
        for (int kx = 0; kx < 8; ++kx) { const int x = (x0 + kx) & 7;
        if (kx == 1) {
            if (threadIdx.x < 8) { const unsigned hq = __hip_atomic_load(F.ctl + CW_QUEUE + 64 * (int)threadIdx.x, __ATOMIC_RELAXED, __HIP_MEMORY_SCOPE_AGENT);
                const unsigned long long bm = __ballot(hq >= 96u); if (threadIdx.x == 0) F.MISC[1] = (unsigned)(bm & 0xffull); }
        }
        __syncthreads();
        if (__builtin_amdgcn_readfirstlane((int)((F.MISC[1] >> x) & 1u))) { __syncthreads(); continue; }
        for (;;) {
            if (threadIdx.x == 0) F.MISC[0] = __hip_atomic_fetch_add(F.ctl + CW_QUEUE + 64 * x, 1u, __ATOMIC_RELAXED, __HIP_MEMORY_SCOPE_AGENT);
            __syncthreads();
            const int item = __builtin_amdgcn_readfirstlane((int)F.MISC[0]);
            __syncthreads();
            if (item >= 96) break;
            int ai; bool dec;
            if (item < 64) { dec = (item & 1) == 0; ai = item >> 1; } else { dec = false; ai = item - 32; }
            if (dec) { if (32 * x + ai >= F.G) p2_decode_split(F, 32 * x + ai, 0); p2_decode_split(F, 32 * x + ai, 1); }
            else { const int qb = 31 - (ai >> 1), bhh = 2 * x + (ai & 1);
                attn_body::attn_unit<8>(bhh >> 3, bhh & 7, qb, Qp, Kp, Vp, Op, NCLp + (size_t)bhh * attn_body::BIASN, (char*)lds + RING_OFF); }
        } }
    }
    xcd_barrier(bar);

    if (F.vcu >= NSAMP) {
        RcPre QA, QB, QC; const int NR_ = F.G - NSAMP; int u = F.vcu - NSAMP;
        if (u < NUNIT) rc_prefetch(F, u, QA);
        if (u + NR_ < NUNIT) rc_prefetch(F, u + NR_, QB);
        for (; u < NUNIT; u += 3 * NR_) { rwkv_fix_unit(F, u, QA, u + 2 * NR_, QC);
            if (u + NR_ < NUNIT) rwkv_fix_unit(F, u + NR_, QB, u + 3 * NR_, QA);
            if (u + 2 * NR_ < NUNIT) rwkv_fix_unit(F, u + 2 * NR_, QC, u + 4 * NR_, QB); }
        asm volatile("s_waitcnt vmcnt(0)" ::: "memory"); __syncthreads();
    }
    if (F.vcu < NSAMP) {
        for (int hh = 0; hh < NH; ++hh) p2_scan_sample(F, F.vcu * NH + hh);
        asm volatile("s_waitcnt vmcnt(0)" ::: "memory"); __syncthreads();
        p2_post(F); p2_decode_combine(F, F.vcu); }
    xcd_barrier(bar);

    {
    if (F.vcu < 64) {
        skinny_gemm(F, (const bf16*)(ws + WS_OC), 1024, (const bf16*)(ws + WS_WBR), 1024, 512, F.vcu, SkBrA{(bf16*)(ws + WS_TMP), (const bf16*)(ws + WS_GB)});
        skinny_gemm(F, (const bf16*)(ws + WS_OC) + 512, 1024, (const bf16*)(ws + WS_WBR) + 512, 1024, 512, F.vcu, SkBrB{(const bf16*)(ws + WS_TMP), (const bf16*)(ws + WS_GB), (bf16*)(ws + WS_MG)});
    }
    {
        Gemm g{(const bf16_t*)(ws + WS_OC), (const bf16_t*)(ws + WS_WBR), M_REAL, 1024, 512, 1024}; StaticOrder S; S.init(M_REAL, 1024, F.G, (int)blockIdx.x);
        EpiBrA E{(bf16_t*)(ws + WS_TMP), (const bf16_t*)(ws + WS_GB)};
        gemm_phase<EpiBrA, StaticOrder, PG8_ALIGN, PG8_SP2>(F.lds + RING_OFF, g, S, E);
    }
    {
        Gemm g{(const bf16_t*)(ws + WS_OC) + 512, (const bf16_t*)(ws + WS_WBR) + 512, M_REAL, 1024, 512, 1024}; StaticOrder S; S.init(M_REAL, 1024, F.G, (int)blockIdx.x);
        EpiBrB E{(const bf16_t*)(ws + WS_TMP), (const bf16_t*)(ws + WS_GB), (bf16_t*)(ws + WS_MG)};
        gemm_phase<EpiBrB, StaticOrder, PG8_ALIGN, PG8_SP2>(F.lds + RING_OFF, g, S, E);
    }
        }
    xcd_barrier(bar);

    if (F.vcu < 64) skinny_gemm(F, (const bf16*)(ws + WS_MG), 1024, (const bf16*)(ws + WS_WOUT), 1024, 1024, F.vcu, SkOut{(bf16*)(ws + WS_X1), (float*)(ws + WS_SS48), INP(I_META), INP(I_XS), F.vcu});
    {
        Gemm g{(const bf16_t*)(ws + WS_MG), (const bf16_t*)(ws + WS_WOUT), M_REAL, 1024, 1024, 1024}; StaticOrder S; S.init(M_REAL, 1024, F.G, (int)blockIdx.x);
        EpiRes<false> E{(bf16_t*)(ws + WS_X1), (float*)(ws + WS_SS), INP(I_XP)};
        gemm_phase<EpiRes<false>, StaticOrder, PG8_ALIGN, PG8_SP2>(F.lds + RING_OFF, g, S, E);
    }
    xcd_barrier(bar);

    for (int cbk = F.vcu; cbk < FF / 16; cbk += F.G) skinny_gemm(F, (const bf16*)(ws + WS_X1), 1024, (const bf16*)(ws + WS_WUP), 1024, 1024, cbk, SkUp{(bf16*)(ws + WS_HF), (const float*)(ws + WS_SS48)});
    {
        Gemm g{(const bf16_t*)(ws + WS_X1), (const bf16_t*)(ws + WS_WUP), M_REAL, FF, 1024, 1024}; StaticOrder S; S.init(M_REAL, FF, F.G, (int)blockIdx.x);
        EpiUp E{(bf16_t*)(ws + WS_HF), (const float*)(ws + WS_SS)};
        gemm_phase<EpiUp, StaticOrder, PG8_ALIGN, PG8_SP2>(F.lds + RING_OFF, g, S, E);
    }
    xcd_barrier(bar);

    if (F.vcu < 64) skinny_gemm(F, (const bf16*)(ws + WS_HF), FF, (const bf16*)(ws + WS_WDN), FF, FF, F.vcu, SkDown{(bf16*)(ws + WS_X1)});
    {
        Gemm g{(const bf16_t*)(ws + WS_HF), (const bf16_t*)(ws + WS_WDN), M_REAL, 1024, FF, FF}; StaticOrder S; S.init(M_REAL, 1024, F.G, (int)blockIdx.x);
        EpiRes<true> E{(bf16_t*)(ws + WS_X1), nullptr, nullptr};
        gemm_phase<EpiRes<true>, StaticOrder, PG8_ALIGN, PG8_SP2>(F.lds + RING_OFF, g, S, E);
    }
    xcd_barrier(bar);

    p6_norm_final(F);
}

extern "C" void kernel_launch(void* const* d_in, const int* in_sizes, int n_in, void* d_out, int out_size, void* d_ws, size_t ws_size, hipStream_t stream) {
    static int grid = 0;
    if (grid == 0) {
        if (n_in != 30 || (size_t)out_size != O_END || ws_size < WS_END) { fprintf(stderr, "kernel_launch: unexpected sizes: n_in %d out %d ws %zu (need %zu)\n", n_in, out_size, ws_size, (size_t)WS_END); grid = -1; return; }
        int dev = 0, cus = 0, per_cu = 0;
        if (hipGetDevice(&dev) != hipSuccess || hipDeviceGetAttribute(&cus, hipDeviceAttributeMultiprocessorCount, dev) != hipSuccess) { grid = -1; return; }
        if (hipFuncSetAttribute((const void*)fwd_kernel, hipFuncAttributeMaxDynamicSharedMemorySize, LDS_BYTES) != hipSuccess) { fprintf(stderr, "kernel_launch: hipFuncSetAttribute failed\n"); grid = -1; return; }
        if (hipOccupancyMaxActiveBlocksPerMultiprocessor(&per_cu, (const void*)fwd_kernel, NTHR, LDS_BYTES) != hipSuccess || per_cu < 1) { fprintf(stderr, "kernel_launch: occupancy query says %d\n", per_cu); }
        (void)hipGetLastError();
        grid = cus;
        if (grid != 256) fprintf(stderr, "kernel_launch: grid %d (built for 256)\n", grid);
    }
    if (grid < 0) return;
    (void)in_sizes;
    if (hipMemsetAsync((char*)d_ws + WS_CTL, 0, CTL_ZERO_BYTES, stream) != hipSuccess) return;
    Args a{};
    for (int i = 0; i < 30; ++i) a.in[i] = (const float*)d_in[i];
    a.out = (float*)d_out; a.ws = (unsigned char*)d_ws;
    hipLaunchKernelGGL(fwd_kernel, dim3(grid), dim3(NTHR), LDS_BYTES, stream, a);
}
```
